# Optimizing an MI355X kernel written in HIP

```python
import math
import jax, jax.numpy as jnp
from jax import lax
import numpy as np

D_MODEL = 1024
BATCH = 1
SEQ = 16384
DEPTH = 4

N_MIXERS = 4
RMS_EPS = 1e-6
D_FF = 4 * D_MODEL

CHUNK = 128
GMLP_HEADS = 8
GMLP_DIM = D_MODEL
GMLP_HEAD_DIM = GMLP_DIM // GMLP_HEADS

POOL_WINDOWS = (2, 4, 8, 16)
POOL_GROUP = D_MODEL // len(POOL_WINDOWS)

MLA_HEADS = 8
Q_LORA = 384
KV_LORA = 256
QK_NOPE = 128
QK_ROPE = 64
V_HEAD = 128
ROPE_THETA = 10000.0
Q_BLOCK = 128

S5_GROUP_CH = 16
S5_GROUPS = D_MODEL // S5_GROUP_CH
S5_STATE = 64
DT_MIN = 1e-3
DT_MAX = 1e-1

N_A = (DEPTH + 3) // 4
N_B = (DEPTH + 2) // 4
N_C = (DEPTH + 1) // 4
N_D = DEPTH // 4

kernel_name = "hybrid_interleaved_gmlp_pool_mla_s5"


def rmsnorm(x, g):
    xf = x.astype(jnp.float32)
    y = xf * lax.rsqrt(jnp.mean(xf * xf, axis=-1, keepdims=True) + RMS_EPS)
    return (y * g.astype(jnp.float32)).astype(x.dtype)


def layernorm(x, g, b):
    xf = x.astype(jnp.float32)
    mu = jnp.mean(xf, axis=-1, keepdims=True)
    xc = xf - mu
    y = xc * lax.rsqrt(jnp.mean(xc * xc, axis=-1, keepdims=True) + RMS_EPS)
    return (y * g.astype(jnp.float32) + b.astype(jnp.float32)).astype(x.dtype)


def gmlp_mixer(h, w_in, b_in, g_v, b_v, w_s, b_s, w_out):
    B_, S, _ = h.shape
    uv = jax.nn.gelu(h @ w_in + b_in)
    u, v = jnp.split(uv, 2, axis=-1)
    v = layernorm(v, g_v, b_v)
    v = v.reshape(B_, S // CHUNK, CHUNK, GMLP_HEADS, GMLP_HEAD_DIM)
    mask = jnp.tril(jnp.ones((CHUNK, CHUNK), dtype=bool))
    ws = jnp.where(mask[None], w_s, jnp.zeros_like(w_s))
    sv = jnp.einsum('hts,bcshd->bcthd', ws, v) + b_s.T[None, None, :, :, None]
    y = u * sv.reshape(B_, S, GMLP_DIM)
    return y @ w_out


def pool_mixer(h, w_grp, scale):
    B_, S, _ = h.shape
    hf = h.astype(jnp.float32)
    cs_all = jnp.cumsum(hf, axis=1)
    count = jnp.arange(1, S + 1, dtype=jnp.float32)[None, :, None]
    outs = []
    for g, w in enumerate(POOL_WINDOWS):
        sl = slice(g * POOL_GROUP, (g + 1) * POOL_GROUP)
        xg = hf[..., sl]
        cs = cs_all[..., sl]
        cs_lag = jnp.pad(cs, ((0, 0), (w, 0), (0, 0)))[:, :S]
        mean = (cs - cs_lag) / jnp.minimum(count, float(w))
        outs.append(jnp.einsum('bsc,cd->bsd', (mean - xg).astype(h.dtype), w_grp[g]))
    return jnp.concatenate(outs, axis=-1) * scale


def rope(x, cos, sin):
    x1, x2 = jnp.split(x, 2, axis=-1)
    return jnp.concatenate([x1 * cos - x2 * sin, x1 * sin + x2 * cos], axis=-1)


def mla_mixer(h, positions, w_dq, g_q, w_uq, w_dkv, g_kv, w_uk, w_uv, w_o):
    B_, S, _ = h.shape
    inv_freq = ROPE_THETA ** (-jnp.arange(0, QK_ROPE, 2, dtype=jnp.float32) / QK_ROPE)
    ang = positions.astype(jnp.float32)[..., None] * inv_freq
    cos = jnp.cos(ang).astype(h.dtype)
    sin = jnp.sin(ang).astype(h.dtype)

    q = (rmsnorm(h @ w_dq, g_q) @ w_uq).reshape(B_, S, MLA_HEADS, QK_NOPE + QK_ROPE)
    q_nope, q_rope = q[..., :QK_NOPE], q[..., QK_NOPE:]
    q_rope = rope(q_rope, cos[:, :, None, :], sin[:, :, None, :])

    ckv = h @ w_dkv
    c = rmsnorm(ckv[..., :KV_LORA], g_kv)
    k_rope = rope(ckv[..., KV_LORA:], cos, sin)
    k_nope = (c @ w_uk).reshape(B_, S, MLA_HEADS, QK_NOPE)
    v = (c @ w_uv).reshape(B_, S, MLA_HEADS, V_HEAD)

    scale = (QK_NOPE + QK_ROPE) ** -0.5
    nb = S // Q_BLOCK
    qn_b = q_nope.reshape(B_, nb, Q_BLOCK, MLA_HEADS, QK_NOPE).transpose(1, 0, 2, 3, 4)
    qr_b = q_rope.reshape(B_, nb, Q_BLOCK, MLA_HEADS, QK_ROPE).transpose(1, 0, 2, 3, 4)
    k_pos = jnp.arange(S)

    def block(args):
        i, qn, qr = args
        s = (jnp.einsum('bqhd,bkhd->bhqk', qn, k_nope)
             + jnp.einsum('bqhd,bkd->bhqk', qr, k_rope)).astype(jnp.float32) * scale
        q_pos = i * Q_BLOCK + jnp.arange(Q_BLOCK)
        s = jnp.where(k_pos[None, :] <= q_pos[:, None], s, jnp.finfo(jnp.float32).min)
        p = jax.nn.softmax(s, axis=-1).astype(v.dtype)
        return jnp.einsum('bhqk,bkhd->bqhd', p, v)

    o = lax.map(block, (jnp.arange(nb), qn_b, qr_b))
    o = o.transpose(1, 0, 2, 3, 4).reshape(B_, S, MLA_HEADS * V_HEAD)
    return o @ w_o


def s5_mixer(h, lam_re, lam_im, log_dt, b_re, b_im, c_re, c_im, d_skip, w_glu_a, w_glu_b):
    B_, S, _ = h.shape
    u = h.astype(jnp.float32).reshape(B_, S, S5_GROUPS, S5_GROUP_CH)
    dt = jnp.exp(log_dt.astype(jnp.float32))[:, None]
    lr = lam_re.astype(jnp.float32)
    li = lam_im.astype(jnp.float32)
    mag = jnp.exp(lr * dt)
    ab_re = mag * jnp.cos(li * dt)
    ab_im = mag * jnp.sin(li * dt)
    den = lr * lr + li * li
    f_re = ((ab_re - 1.0) * lr + ab_im * li) / den
    f_im = (ab_im * lr - (ab_re - 1.0) * li) / den
    br = b_re.astype(jnp.float32)
    bi = b_im.astype(jnp.float32)
    bb_re = f_re[..., None] * br - f_im[..., None] * bi
    bb_im = f_re[..., None] * bi + f_im[..., None] * br
    bu_re = jnp.einsum('bsgc,gpc->bsgp', u, bb_re)
    bu_im = jnp.einsum('bsgc,gpc->bsgp', u, bb_im)
    a_re = jnp.broadcast_to(ab_re, bu_re.shape)
    a_im = jnp.broadcast_to(ab_im, bu_im.shape)

    def combine(e1, e2):
        a1r, a1i, b1r, b1i = e1
        a2r, a2i, b2r, b2i = e2
        return (a2r * a1r - a2i * a1i,
                a2r * a1i + a2i * a1r,
                a2r * b1r - a2i * b1i + b2r,
                a2r * b1i + a2i * b1r + b2i)

    _, _, xr, xi = lax.associative_scan(combine, (a_re, a_im, bu_re, bu_im), axis=1)
    y = (jnp.einsum('bsgp,gcp->bsgc', xr, c_re.astype(jnp.float32))
         - jnp.einsum('bsgp,gcp->bsgc', xi, c_im.astype(jnp.float32)))
    y = y + d_skip.astype(jnp.float32) * u
    y = jax.nn.gelu(y.reshape(B_, S, D_MODEL)).astype(h.dtype)
    return (y @ w_glu_a) * jax.nn.sigmoid(y @ w_glu_b)


def setup_inputs(seed: int = 0) -> dict:
    key = jax.random.key(seed)
    ks = iter(jax.random.split(key, 40))
    nrm = lambda shape, s: jax.random.normal(next(ks), shape, jnp.float32) * s
    d = D_MODEL
    inp = {}
    inp["x"] = nrm((BATCH, SEQ, d), 1.0)
    inp["positions"] = jnp.broadcast_to(jnp.arange(SEQ, dtype=jnp.int32), (BATCH, SEQ))
    inp["norm_g"] = 1.0 + nrm((DEPTH, 4, d), 0.02)
    inp["w_up"] = nrm((DEPTH, d, D_FF), d ** -0.5)
    inp["w_down"] = nrm((DEPTH, D_FF, d), D_FF ** -0.5)
    inp["a_w_in"] = nrm((N_A, d, 2 * GMLP_DIM), d ** -0.5)
    inp["a_b_in"] = nrm((N_A, 2 * GMLP_DIM), 0.01)
    inp["a_g_v"] = 1.0 + nrm((N_A, GMLP_DIM), 0.02)
    inp["a_b_v"] = nrm((N_A, GMLP_DIM), 0.01)
    inp["a_w_s"] = nrm((N_A, GMLP_HEADS, CHUNK, CHUNK), CHUNK ** -0.5)
    inp["a_b_s"] = 1.0 + nrm((N_A, GMLP_HEADS, CHUNK), 0.01)
    inp["a_w_out"] = nrm((N_A, GMLP_DIM, d), GMLP_DIM ** -0.5)
    inp["b_w_grp"] = nrm((N_B, len(POOL_WINDOWS), POOL_GROUP, POOL_GROUP), POOL_GROUP ** -0.5)
    inp["b_scale"] = 1.0 + nrm((N_B, d), 0.1)
    inp["c_w_dq"] = nrm((N_C, d, Q_LORA), d ** -0.5)
    inp["c_g_q"] = 1.0 + nrm((N_C, Q_LORA), 0.02)
    inp["c_w_uq"] = nrm((N_C, Q_LORA, MLA_HEADS * (QK_NOPE + QK_ROPE)), Q_LORA ** -0.5)
    inp["c_w_dkv"] = nrm((N_C, d, KV_LORA + QK_ROPE), d ** -0.5)
    inp["c_g_kv"] = 1.0 + nrm((N_C, KV_LORA), 0.02)
    inp["c_w_uk"] = nrm((N_C, KV_LORA, MLA_HEADS * QK_NOPE), KV_LORA ** -0.5)
    inp["c_w_uv"] = nrm((N_C, KV_LORA, MLA_HEADS * V_HEAD), KV_LORA ** -0.5)
    inp["c_w_o"] = nrm((N_C, MLA_HEADS * V_HEAD, d), (MLA_HEADS * V_HEAD) ** -0.5)
    G, P, C = S5_GROUPS, S5_STATE, S5_GROUP_CH
    inp["d_lam_re"] = -0.5 + nrm((N_D, G, P), 0.01)
    inp["d_lam_im"] = jnp.pi * jnp.arange(P, dtype=jnp.float32) + nrm((N_D, G, P), 0.01)
    inp["d_log_dt"] = jax.random.uniform(next(ks), (N_D, G), jnp.float32,
                                          math.log(DT_MIN), math.log(DT_MAX))
    inp["d_b_re"] = nrm((N_D, G, P, C), (2 * C) ** -0.5)
    inp["d_b_im"] = nrm((N_D, G, P, C), (2 * C) ** -0.5)
    inp["d_c_re"] = nrm((N_D, G, C, P), (2 * P) ** -0.5)
    inp["d_c_im"] = nrm((N_D, G, C, P), (2 * P) ** -0.5)
    inp["d_skip"] = nrm((N_D, G, C), 1.0)
    inp["d_w_glu_a"] = nrm((N_D, d, d), d ** -0.5)
    inp["d_w_glu_b"] = nrm((N_D, d, d), d ** -0.5)
    return inp


def reference(x, positions, norm_g, w_up, w_down,
              a_w_in, a_b_in, a_g_v, a_b_v, a_w_s, a_b_s, a_w_out,
              b_w_grp, b_scale,
              c_w_dq, c_g_q, c_w_uq, c_w_dkv, c_g_kv, c_w_uk, c_w_uv, c_w_o,
              d_lam_re, d_lam_im, d_log_dt, d_b_re, d_b_im, d_c_re, d_c_im, d_skip,
              d_w_glu_a, d_w_glu_b):
    h = x
    for i in range(DEPTH):
        m, j = i % N_MIXERS, i // N_MIXERS
        z = rmsnorm(h, norm_g[i, 0])
        if m == 0:
            z = gmlp_mixer(z, a_w_in[j], a_b_in[j], a_g_v[j], a_b_v[j], a_w_s[j], a_b_s[j], a_w_out[j])
        elif m == 1:
            z = pool_mixer(z, b_w_grp[j], b_scale[j])
        elif m == 2:
            z = mla_mixer(z, positions, c_w_dq[j], c_g_q[j], c_w_uq[j], c_w_dkv[j], c_g_kv[j],
                          c_w_uk[j], c_w_uv[j], c_w_o[j])
        else:
            z = s5_mixer(z, d_lam_re[j], d_lam_im[j], d_log_dt[j], d_b_re[j], d_b_im[j],
                         d_c_re[j], d_c_im[j], d_skip[j], d_w_glu_a[j], d_w_glu_b[j])
        h = h + rmsnorm(z, norm_g[i, 1])
        z = rmsnorm(h, norm_g[i, 2])
        z = jnp.square(jax.nn.relu(z @ w_up[i])) @ w_down[i]
        h = h + rmsnorm(z, norm_g[i, 3])
    return h
```

```cpp
#include <hip/hip_runtime.h>
#include <hip/hip_cooperative_groups.h>
#include <cstdio>
namespace cg = cooperative_groups;

#define DI __device__ __forceinline__
#define LAS __attribute__((address_space(3)))
typedef unsigned short bf16_t;
typedef short bf16x8 __attribute__((ext_vector_type(8)));
typedef float f32x2 __attribute__((ext_vector_type(2)));
typedef float f32x4 __attribute__((ext_vector_type(4)));
typedef float f32x16 __attribute__((ext_vector_type(16)));
typedef unsigned u32x2 __attribute__((ext_vector_type(2)));
typedef unsigned u32x4 __attribute__((ext_vector_type(4)));
typedef __bf16 bf16v2 __attribute__((ext_vector_type(2)));

namespace {
constexpr int S = 16384;
constexpr size_t MiB = (size_t)1 << 20;
constexpr size_t O_CS = 0, O_WUP = 4 * MiB, O_WDN = 12 * MiB, O_WMIX = 20 * MiB, O_XN = 28 * MiB, O_Z = 60 * MiB, O_AR = 92 * MiB;
constexpr int LDS_BYTES = 131072;
constexpr int NSTEPS = 34;
constexpr float RMS_EPS = 1e-6f;
constexpr float QSCALE = 0.07216878364870322f * 1.4426950408889634f;

enum { E_Z = 0, E_HID, E_UV, E_POOL, E_LAT, E_Q, E_KN, E_VT, E_XE, E_S5Y, E_GLU };

struct Params { const float* in[32]; float* out; unsigned char* ws; };

DI unsigned pk_bf16(float a, float b) { f32x2 f = {a, b}; bf16v2 h = __builtin_convertvector(f, bf16v2); return __builtin_bit_cast(unsigned, h); }
DI bf16_t f2bf(float x) { return (bf16_t)(pk_bf16(x, 0.f) & 0xffffu); }
DI float bf2f(bf16_t b) { return __uint_as_float(((unsigned)b) << 16); }
DI float bflo(unsigned u) { return __uint_as_float(u << 16); }
DI float bfhi(unsigned u) { return __uint_as_float(u & 0xffff0000u); }
DI float shx(float v, int o, int lane) { return __int_as_float(__builtin_amdgcn_ds_bpermute((lane ^ o) << 2, __float_as_int(v))); }
DI float wave_sum(float v, int lane) {
#pragma unroll
    for (int o = 1; o < 64; o <<= 1) v += shx(v, o, lane);
    return v;
}
DI void store_bf4(bf16_t* p, f32x4 v) { u32x2 w; w.x = pk_bf16(v[0], v[1]); w.y = pk_bf16(v[2], v[3]); *(u32x2*)p = w; }
DI float gelu_tanh(float x) {
    const float u = 0.7978845608028654f * (x + 0.044715f * x * x * x);
    const float e = __expf(-2.f * u);
    return x / (1.f + e);
}

constexpr int BM = 256, BK = 64, HALF = 128, HTB = HALF * BK * 2, NXCD = 8, WGM = 8;
DI int lds_byte(int r, int c) { const int st = (r >> 4) * 2 + (c >> 5), rr = r & 15, cc = c & 31, ob = rr * 64 + cc * 2; return st * 1024 + (ob ^ (((ob >> 9) & 1) << 5)); }
DI void stage_rc(int b, int& R, int& C) { const int st = b / 1024, sb = b % 1024, swz = sb ^ (((sb >> 9) & 1) << 5); R = (st >> 1) * 16 + swz / 64; C = (st & 1) * 32 + (swz % 64) / 2; }

struct GemmDesc { const bf16_t* A; const bf16_t* Bt; long a_gs, b_gs; int K, lda, ldb, nM, nN, ngrp, mode; };
struct Unit { int pm, pn, grp; };

DI bool unit_next(const GemmDesc& g, int i, int G, int c, Unit& u) {
    const int nper = g.nM * g.nN;
    const long L = (long)i * G + c;
    const bool ok = L < (long)nper * g.ngrp;
    const int grp2 = (int)(L / nper), w = (int)(L - (long)grp2 * nper);
    const int nwg = nper, nM = g.nM, nN = g.nN;
    int wgid = w;
    { const int q = nwg / NXCD, r = nwg % NXCD, xcd = wgid % NXCD, off = wgid / NXCD; wgid = (xcd < r ? xcd * (q + 1) : r * (q + 1) + (xcd - r) * q) + off; }
    const int nig = WGM * nN, gid = wgid / nig, fm = gid * WGM, gsz = (nM - fm) < WGM ? (nM - fm) : WGM;
    const int gszc = gsz > 0 ? gsz : 1;
    const int pm1 = fm + ((wgid % nig) % gszc), pn1 = (wgid % nig) / gszc;
    const int pm2 = w % nM, pn2 = w / nM;
    const bool single = (g.ngrp == 1);
    Unit r; r.pm = single ? pm1 : pm2; r.pn = single ? pn1 : pn2; r.grp = single ? 0 : grp2;
    u = r;
    return ok;
}

#define EPI_LOOP(...) \
    _Pragma("unroll") for (int ai = 0; ai < 2; ++ai) _Pragma("unroll") for (int m = 0; m < 4; ++m) { const int row = row0 + ai * HALF + m * 16; \
        _Pragma("unroll") for (int bj = 0; bj < 2; ++bj) _Pragma("unroll") for (int n = 0; n < 2; ++n) { const int col = col0 + bj * HALF + n * 16; f32x4 v = acc[ai][bj][m][n]; __VA_ARGS__ } }

DI void epilogue(const Params& P, const GemmDesc& g, const f32x4 (&acc)[2][2][4][2], const Unit& u, int wr, int wc, int fr, int fq) {
    unsigned char* ws_ = P.ws; asm volatile("" : "+s"(ws_));
    unsigned char* ws = ws_;
    const int row0 = u.pm * BM + wr * 64 + fr, col0 = u.pn * BM + wc * 32 + 4 * fq;
    bf16_t* Zb = (bf16_t*)(ws + O_Z);
    bf16_t* AR = (bf16_t*)(ws + O_AR);
    switch (g.mode) {
    case E_Z: { EPI_LOOP( store_bf4(Zb + (size_t)row * 1024 + col, v); ) } break;
    case E_HID: { EPI_LOOP( _Pragma("unroll") for (int j = 0; j < 4; ++j) { const float t = fmaxf(v[j], 0.f); v[j] = t * t; } store_bf4(AR + (size_t)row * 4096 + col, v); ) } break;
    case E_UV: { const float* bin = P.in[6];
        EPI_LOOP( const f32x4 b = *(const f32x4*)(bin + col); _Pragma("unroll") for (int j = 0; j < 4; ++j) v[j] = gelu_tanh(v[j] + b[j]);
                  bf16_t* dst = (col < 1024) ? (AR + (size_t)row * 1024 + col) : (AR + 16 * MiB + (size_t)row * 1024 + (col - 1024)); store_bf4(dst, v); ) } break;
    case E_POOL: { const float* sc = P.in[13];
        EPI_LOOP( const int cgc = 256 * u.grp + col; const f32x4 s4 = *(const f32x4*)(sc + cgc); store_bf4(Zb + (size_t)row * 1024 + cgc, v * s4); ) } break;
    case E_LAT: { EPI_LOOP( store_bf4(AR + (size_t)row * 768 + col, v); ) } break;
    case E_Q: { const float* CS = (const float*)(ws + O_CS); bf16_t* Qb = AR + 24 * MiB;
        EPI_LOOP( const int w = col % 192;
                  if (w >= 128) { const int j = (w - 128) >> 1; const f32x4 cs = *(const f32x4*)(CS + ((size_t)row * 32 + j) * 2);
                      const float a0 = v[0] * cs[0] - v[1] * cs[1], a1 = v[0] * cs[1] + v[1] * cs[0], a2 = v[2] * cs[2] - v[3] * cs[3], a3 = v[2] * cs[3] + v[3] * cs[2];
                      v[0] = a0; v[1] = a1; v[2] = a2; v[3] = a3; }
                  store_bf4(Qb + (size_t)row * 1536 + col, v * QSCALE); ) } break;
    case E_KN: { bf16_t* KN = AR + 48 * MiB; EPI_LOOP( store_bf4(KN + (size_t)row * 1024 + col, v); ) } break;
    case E_VT: { bf16_t* VT = AR + 64 * MiB; EPI_LOOP( store_bf4(VT + (size_t)row * 16384 + col, v); ) } break;
    case E_XE: { float* XE = (float*)(ws + O_AR + 96 * MiB);
        EPI_LOOP( if (col < 128) *(f32x4*)(XE + ((size_t)(u.grp * 512 + row)) * 128 + col) = v; ) } break;
    case E_S5Y: { bf16_t* Y5 = AR + 56 * MiB;
        EPI_LOOP( const int l = col >> 4, c = col & 15; const int token = row * 32 + l; _Pragma("unroll") for (int j = 0; j < 4; ++j) v[j] = gelu_tanh(v[j]);
                  store_bf4(Y5 + (size_t)token * 1024 + u.grp * 16 + c, v); ) } break;
    case E_GLU: {
#pragma unroll
        for (int ai = 0; ai < 2; ++ai)
#pragma unroll
            for (int m = 0; m < 4; ++m) { const int row = row0 + ai * HALF + m * 16;
#pragma unroll
                for (int n = 0; n < 2; ++n) { const int oc = u.pn * 128 + wc * 32 + n * 16 + 4 * fq; const f32x4 a = acc[ai][0][m][n], b = acc[ai][1][m][n]; f32x4 v;
#pragma unroll
                    for (int j = 0; j < 4; ++j) v[j] = a[j] / (1.f + __expf(-b[j]));
                    store_bf4(Zb + (size_t)row * 1024 + oc, v); } }
    } break;
    default: break;
    }
}

DI void gemm_phase(LAS unsigned char* lds, const Params& P, const GemmDesc g, const int G, const int cidx, int tid) {
    asm volatile("" : "+v"(tid));
    const int wid = __builtin_amdgcn_readfirstlane(tid >> 6), lane = tid & 63, wr = wid >> 2, wc = wid & 3, fr = lane & 15, fq = lane >> 4;
    const int K = g.K, nt = K / BK;
    unsigned voffA[2], voffB[2];
#pragma unroll
    for (int i = 0; i < 2; ++i) { int R, C; stage_rc(tid * 16 + i * 8192, R, C); voffA[i] = (unsigned)(R * g.lda + C) * 2u; voffB[i] = (unsigned)(R * g.ldb + C) * 2u; }
    const size_t kstep = (size_t)(BK * 2);
    const size_t hstepA = (size_t)HALF * g.lda * 2, hstepB = (size_t)HALF * g.ldb * 2;
    const unsigned ldsw = (unsigned)wid * 1024u;
    const int aoff = lds_byte(wr * 64 + fr, fq * 8), boff = lds_byte(wc * 32 + fr, fq * 8);
#define PG8_SA(b, h) (((b) * 2 + (h)) * HTB)
#define PG8_SB(b, h) ((4 + (b) * 2 + (h)) * HTB)
#define PG8_STAGE(bufoff, gbase, voff) do { _Pragma("unroll") for (int _i = 0; _i < 2; ++_i) \
        __builtin_amdgcn_global_load_lds((const unsigned*)((const char*)(gbase) + (voff)[_i]), (LAS unsigned*)(lds + (bufoff) + ldsw + _i * 8192), 16, 0, 0); } while (0)
#define PG8_LDA(dst, b, h) do { _Pragma("unroll") for (int m = 0; m < 4; ++m) _Pragma("unroll") for (int k = 0; k < 2; ++k) dst[m][k] = *(const LAS bf16x8*)(lds + PG8_SA(b, h) + aoff + m * 2048 + k * 1024); } while (0)
#define PG8_LDB(dst, b, h) do { _Pragma("unroll") for (int n = 0; n < 2; ++n) _Pragma("unroll") for (int k = 0; k < 2; ++k) dst[n][k] = *(const LAS bf16x8*)(lds + PG8_SB(b, h) + boff + n * 2048 + k * 1024); } while (0)
#define PG8_MMA(ai, bj, At, Bt) do { __builtin_amdgcn_s_setprio(1); _Pragma("unroll") for (int m = 0; m < 4; ++m) _Pragma("unroll") for (int n = 0; n < 2; ++n) _Pragma("unroll") for (int k = 0; k < 2; ++k) \
        acc[ai][bj][m][n] = __builtin_amdgcn_mfma_f32_16x16x32_bf16(Bt[n][k], At[m][k], acc[ai][bj][m][n], 0, 0, 0); __builtin_amdgcn_s_setprio(0); } while (0)
#define PG8_WAIT_V(n) asm volatile("s_waitcnt vmcnt(" #n ")" ::: "memory")
#define PG8_WAIT_L(n) asm volatile("s_waitcnt lgkmcnt(" #n ")" ::: "memory")
#define PG8_BAR __builtin_amdgcn_s_barrier()
#define PG8_SCHED __builtin_amdgcn_sched_barrier(0)
    Unit cur, nxt; int ui = 0;
    if (!unit_next(g, 0, G, cidx, cur)) return;
    f32x4 acc[2][2][4][2];
#pragma unroll
    for (int a = 0; a < 2; ++a)
#pragma unroll
        for (int b = 0; b < 2; ++b)
#pragma unroll
            for (int m = 0; m < 4; ++m)
#pragma unroll
                for (int n = 0; n < 2; ++n) acc[a][b][m][n] = (f32x4){0.f, 0.f, 0.f, 0.f};
    bf16x8 At[4][2], B0[2][2], B1[2][2];
    const char* cA = (const char*)g.A + ((size_t)cur.grp * g.a_gs + (size_t)cur.pm * BM * g.lda) * 2;
    const char* cB = (const char*)g.Bt + ((size_t)cur.grp * g.b_gs + (size_t)cur.pn * BM * g.ldb) * 2;
    PG8_STAGE(PG8_SB(0, 0), cB, voffB); PG8_STAGE(PG8_SA(0, 0), cA, voffA); PG8_STAGE(PG8_SB(0, 1), cB + hstepB, voffB); PG8_STAGE(PG8_SA(0, 1), cA + hstepA, voffA);
    if (wr == 1) PG8_BAR;
    PG8_WAIT_V(4); PG8_BAR;
    PG8_STAGE(PG8_SB(1, 0), cB + kstep, voffB); PG8_STAGE(PG8_SA(1, 0), cA + kstep, voffA); PG8_STAGE(PG8_SB(1, 1), cB + hstepB + kstep, voffB);
    PG8_WAIT_V(6); PG8_BAR;
    for (;;) {
        const bool has_next = unit_next(g, ui + 1, G, cidx, nxt);
        const char* nA = has_next ? (const char*)g.A + ((size_t)nxt.grp * g.a_gs + (size_t)nxt.pm * BM * g.lda) * 2 : cA;
        const char* nB = has_next ? (const char*)g.Bt + ((size_t)nxt.grp * g.b_gs + (size_t)nxt.pn * BM * g.ldb) * 2 : cB;
        for (int t = 0; t < nt; t += 2) {
            const bool last = (t == nt - 2);
            const char* a1 = cA + (size_t)(t + 1) * kstep;
            const char* a2 = last ? nA : cA + (size_t)(t + 2) * kstep; const char* b2 = last ? nB : cB + (size_t)(t + 2) * kstep;
            const char* a3 = a2 + kstep; const char* b3 = b2 + kstep;
            PG8_LDB(B0, 0, 0); PG8_SCHED; PG8_LDA(At, 0, 0); PG8_STAGE(PG8_SA(1, 1), a1 + hstepA, voffA);
            PG8_WAIT_L(8); PG8_BAR; PG8_WAIT_L(0); PG8_MMA(0, 0, At, B0); PG8_BAR; PG8_SCHED;
            PG8_LDB(B1, 0, 1); PG8_STAGE(PG8_SB(0, 0), b2, voffB);
            PG8_BAR; PG8_WAIT_L(0); PG8_MMA(0, 1, At, B1); PG8_BAR;
            PG8_LDA(At, 0, 1); PG8_STAGE(PG8_SA(0, 0), a2, voffA);
            PG8_BAR; PG8_WAIT_L(0); PG8_MMA(1, 0, At, B0); PG8_BAR; PG8_SCHED;
            PG8_STAGE(PG8_SB(0, 1), b2 + hstepB, voffB);
            PG8_WAIT_V(6); PG8_BAR; PG8_MMA(1, 1, At, B1); PG8_BAR;
            PG8_LDB(B0, 1, 0); PG8_SCHED; PG8_LDA(At, 1, 0); PG8_STAGE(PG8_SA(0, 1), a2 + hstepA, voffA);
            PG8_WAIT_L(8); PG8_BAR; PG8_WAIT_L(0); PG8_MMA(0, 0, At, B0); PG8_BAR; PG8_SCHED;
            PG8_LDB(B1, 1, 1); PG8_STAGE(PG8_SB(1, 0), b3, voffB);
            PG8_BAR; PG8_WAIT_L(0); PG8_MMA(0, 1, At, B1); PG8_BAR;
            PG8_LDA(At, 1, 1); PG8_STAGE(PG8_SA(1, 0), a3, voffA);
            PG8_BAR; PG8_WAIT_L(0); PG8_MMA(1, 0, At, B0); PG8_BAR; PG8_SCHED;
            PG8_STAGE(PG8_SB(1, 1), b3 + hstepB, voffB);
            PG8_WAIT_V(6); PG8_BAR; PG8_MMA(1, 1, At, B1); PG8_BAR;
        }
        epilogue(P, g, acc, cur, wr, wc, fr, fq);
        if (!has_next) break;
#pragma unroll
        for (int a = 0; a < 2; ++a)
#pragma unroll
            for (int b = 0; b < 2; ++b)
#pragma unroll
                for (int m = 0; m < 4; ++m)
#pragma unroll
                    for (int n = 0; n < 2; ++n) acc[a][b][m][n] = (f32x4){0.f, 0.f, 0.f, 0.f};
        cur = nxt; cA = nA; cB = nB; ++ui;
    }
    PG8_WAIT_V(0);
    if (wr == 0) PG8_BAR;
    PG8_BAR;
}

DI bool get_gemm(const Params& P, int st, GemmDesc& g) {
    unsigned char* ws_ = P.ws; asm volatile("" : "+s"(ws_));
    unsigned char* ws = ws_;
    const bf16_t* XN = (const bf16_t*)(ws + O_XN);
    const bf16_t* WMIX = (const bf16_t*)(ws + O_WMIX);
    const bf16_t* AR = (const bf16_t*)(ws + O_AR);
    g.a_gs = 0; g.b_gs = 0; g.ngrp = 1; g.nM = 64; g.K = 1024; g.lda = 1024; g.ldb = 1024; g.A = XN; g.Bt = WMIX; g.nN = 4; g.mode = E_Z;
    switch (st) {
    case 1: g.nN = 8; g.mode = E_UV; return true;
    case 4: g.A = AR + 32 * MiB; g.Bt = WMIX + 2 * MiB; return true;
    case 6: case 12: case 23: case 31: g.Bt = (const bf16_t*)(ws + O_WUP); g.nN = 16; g.mode = E_HID; return true;
    case 7: case 13: case 24: case 32: g.A = AR; g.Bt = (const bf16_t*)(ws + O_WDN); g.K = 4096; g.lda = 4096; g.ldb = 4096; return true;
    case 10: g.A = AR + 32 * MiB; g.K = 256; g.ldb = 256; g.nN = 1; g.ngrp = 4; g.a_gs = 256; g.b_gs = 65536; g.mode = E_POOL; return true;
    case 15: g.nN = 3; g.mode = E_LAT; return true;
    case 17: g.A = AR + 12 * MiB; g.Bt = WMIX + 1 * MiB; g.K = 384; g.lda = 384; g.ldb = 384; g.nN = 6; g.mode = E_Q; return true;
    case 18: g.A = AR + 18 * MiB; g.Bt = WMIX + 2 * MiB; g.K = 256; g.lda = 256; g.ldb = 256; g.nN = 4; g.mode = E_KN; return true;
    case 19: g.A = WMIX + (5 * MiB) / 2; g.Bt = AR + 18 * MiB; g.K = 256; g.lda = 256; g.ldb = 256; g.nM = 4; g.nN = 64; g.mode = E_VT; return true;
    case 21: g.Bt = WMIX + 3 * MiB; return true;
    case 26: g.A = AR; g.Bt = AR + 40 * MiB; g.K = 512; g.lda = 640; g.ldb = 512; g.nM = 2; g.nN = 1; g.ngrp = 64; g.a_gs = 512 * 640; g.b_gs = 256 * 512; g.mode = E_XE; return true;
    case 28: g.A = AR; g.Bt = AR + 20 * MiB; g.K = 640; g.lda = 640; g.ldb = 640; g.nM = 2; g.nN = 2; g.ngrp = 64; g.a_gs = 512 * 640; g.b_gs = 512 * 640; g.mode = E_S5Y; return true;
    case 29: g.A = AR + 56 * MiB; g.nN = 8; g.mode = E_GLU; return true;
    default: return false;
    }
}

enum { RP_BF = 0, RP_F32 = 1, RP_S5 = 2, RP_FINAL = 3 };
template <int MODE>
DI void row_pass(const float* hin, float* hout, const bf16_t* z, const float* gpost, const float* gpre, void* outp, int gw, int NGW, int lane) {
    asm volatile("" : "+v"(lane));
    for (int row = gw; row < S; row += NGW) {
        f32x4 h[4];
#pragma unroll
        for (int j = 0; j < 4; ++j) { const int cb = (MODE == RP_S5) ? 16 * lane + 4 * j : 4 * lane + 256 * j; h[j] = *(const f32x4*)(hin + (size_t)row * 1024 + cb); }
        if (z) {
            f32x4 zz[4]; float ss = 0.f;
#pragma unroll
            for (int j = 0; j < 4; ++j) { const int cb = (MODE == RP_S5) ? 16 * lane + 4 * j : 4 * lane + 256 * j; const u32x2 w = *(const u32x2*)(z + (size_t)row * 1024 + cb);
                zz[j] = (f32x4){bflo(w.x), bfhi(w.x), bflo(w.y), bfhi(w.y)}; ss += zz[j][0] * zz[j][0] + zz[j][1] * zz[j][1] + zz[j][2] * zz[j][2] + zz[j][3] * zz[j][3]; }
            ss = wave_sum(ss, lane); const float rz = rsqrtf(ss * (1.f / 1024.f) + RMS_EPS);
#pragma unroll
            for (int j = 0; j < 4; ++j) { const int cb = (MODE == RP_S5) ? 16 * lane + 4 * j : 4 * lane + 256 * j; const f32x4 gp = *(const f32x4*)(gpost + cb); h[j] += zz[j] * rz * gp;
                *(f32x4*)(hout + (size_t)row * 1024 + cb) = h[j]; }
        }
        if (MODE != RP_FINAL) {
            float s2 = 0.f;
#pragma unroll
            for (int j = 0; j < 4; ++j) s2 += h[j][0] * h[j][0] + h[j][1] * h[j][1] + h[j][2] * h[j][2] + h[j][3] * h[j][3];
            s2 = wave_sum(s2, lane); const float rn = rsqrtf(s2 * (1.f / 1024.f) + RMS_EPS);
#pragma unroll
            for (int j = 0; j < 4; ++j) { const int cb = (MODE == RP_S5) ? 16 * lane + 4 * j : 4 * lane + 256 * j; const f32x4 gq = *(const f32x4*)(gpre + cb); const f32x4 xn = h[j] * rn * gq;
                if (MODE == RP_BF) store_bf4((bf16_t*)outp + (size_t)row * 1024 + cb, xn);
                if (MODE == RP_F32) *(f32x4*)((float*)outp + (size_t)row * 1024 + cb) = xn;
                if (MODE == RP_S5) store_bf4((bf16_t*)outp + ((size_t)(lane * 512 + (row >> 5))) * 640 + (row & 31) * 16 + 4 * j, xn); }
        }
    }
}

enum { MAP_ID = 0, MAP_UQ = 1, MAP_GLUA = 2, MAP_GLUB = 3 };
DI int dstrow(int mode, int n) {
    if (mode == MAP_UQ) { const int hd = n / 192, w = n - hd * 192; if (w < 128) return n; const int r = w - 128; return hd * 192 + 128 + 2 * (r & 31) + (r >> 5); }
    if (mode == MAP_GLUA) return (n >> 7) * 256 + (n & 127);
    if (mode == MAP_GLUB) return (n >> 7) * 256 + 128 + (n & 127);
    return n;
}
DI void convT(const float* src, int K, int N, bf16_t* dst, int ldT, int mapmode, int gw, int NGW, int lane) {
    asm volatile("" : "+v"(lane));
    const int nnb = N >> 4, nitems = nnb * (K >> 5);
    for (int it = gw; it < nitems; it += NGW) {
        const int kb = it / nnb, nb = it - kb * nnb;
        const int n = nb * 16 + (lane >> 2), k = kb * 32 + 8 * (lane & 3);
        const float* s = src + (size_t)k * N + n;
        float v[8];
#pragma unroll
        for (int i = 0; i < 8; ++i) v[i] = s[(size_t)i * N];
        u32x4 o; o.x = pk_bf16(v[0], v[1]); o.y = pk_bf16(v[2], v[3]); o.z = pk_bf16(v[4], v[5]); o.w = pk_bf16(v[6], v[7]);
        *(u32x4*)(dst + (size_t)dstrow(mapmode, n) * ldT + k) = o;
    }
}
DI void conv_layer(const Params& P, int L, int gw, int NGW, int lane) {
    unsigned char* ws_ = P.ws; asm volatile("" : "+s"(ws_));
    unsigned char* ws = ws_;
    bf16_t* WMIX = (bf16_t*)(ws + O_WMIX);
    convT(P.in[3] + (size_t)L * 1024 * 4096, 1024, 4096, (bf16_t*)(ws + O_WUP), 1024, MAP_ID, gw, NGW, lane);
    convT(P.in[4] + (size_t)L * 1024 * 4096, 4096, 1024, (bf16_t*)(ws + O_WDN), 4096, MAP_ID, gw, NGW, lane);
    if (L == 0) {
        convT(P.in[5], 1024, 2048, WMIX, 1024, MAP_ID, gw, NGW, lane);
        convT(P.in[11], 1024, 1024, WMIX + 2 * MiB, 1024, MAP_ID, gw, NGW, lane);
        const float* wsrc = P.in[9]; bf16_t* wd = WMIX + 3 * MiB;
        for (int e = gw * 64 + lane; e < 8 * 128 * 128 / 4; e += NGW * 64) { const int s0 = (e * 4) & 127, t = ((e * 4) >> 7) & 127; f32x4 w = *(const f32x4*)(wsrc + (size_t)e * 4);
#pragma unroll
            for (int j = 0; j < 4; ++j) if (s0 + j > t) w[j] = 0.f;
            store_bf4(wd + (size_t)e * 4, w); }
    } else if (L == 1) {
        for (int gg = 0; gg < 4; ++gg) convT(P.in[12] + gg * 65536, 256, 256, WMIX + gg * 65536, 256, MAP_ID, gw, NGW, lane);
    } else if (L == 2) {
        convT(P.in[14], 1024, 384, WMIX, 1024, MAP_ID, gw, NGW, lane);
        convT(P.in[17], 1024, 320, WMIX + 384 * 1024, 1024, MAP_ID, gw, NGW, lane);
        convT(P.in[16], 384, 1536, WMIX + 1 * MiB, 384, MAP_UQ, gw, NGW, lane);
        convT(P.in[19], 256, 1024, WMIX + 2 * MiB, 256, MAP_ID, gw, NGW, lane);
        convT(P.in[20], 256, 1024, WMIX + (5 * MiB) / 2, 256, MAP_ID, gw, NGW, lane);
        convT(P.in[21], 1024, 1024, WMIX + 3 * MiB, 1024, MAP_ID, gw, NGW, lane);
    } else {
        convT(P.in[30], 1024, 1024, WMIX, 1024, MAP_GLUA, gw, NGW, lane);
        convT(P.in[31], 1024, 1024, WMIX, 1024, MAP_GLUB, gw, NGW, lane);
    }
}

DI void lnv_phase(const Params& P, int gw, int NGW, int lane) {
    unsigned char* ws_ = P.ws; asm volatile("" : "+s"(ws_));
    asm volatile("" : "+v"(lane));
    bf16_t* V = (bf16_t*)(ws_ + O_AR + 32 * MiB);
    const float* gv = P.in[7]; const float* bv = P.in[8];
    for (int row = gw; row < S; row += NGW) {
        f32x4 x[4]; float s = 0.f;
#pragma unroll
        for (int j = 0; j < 4; ++j) { const u32x2 w = *(const u32x2*)(V + (size_t)row * 1024 + 4 * lane + 256 * j); x[j] = (f32x4){bflo(w.x), bfhi(w.x), bflo(w.y), bfhi(w.y)}; s += x[j][0] + x[j][1] + x[j][2] + x[j][3]; }
        const float mu = wave_sum(s, lane) * (1.f / 1024.f); float s2 = 0.f;
#pragma unroll
        for (int j = 0; j < 4; ++j) { x[j] = x[j] - mu; s2 += x[j][0] * x[j][0] + x[j][1] * x[j][1] + x[j][2] * x[j][2] + x[j][3] * x[j][3]; }
        const float rs = rsqrtf(wave_sum(s2, lane) * (1.f / 1024.f) + RMS_EPS);
#pragma unroll
        for (int j = 0; j < 4; ++j) { const int cb = 4 * lane + 256 * j; const f32x4 g4 = *(const f32x4*)(gv + cb), b4 = *(const f32x4*)(bv + cb); store_bf4(V + (size_t)row * 1024 + cb, x[j] * rs * g4 + b4); }
    }
}

DI void gate_phase(const Params& P, LAS unsigned char* lds, int tid, int wid, int lane, int bid) {
    unsigned char* ws_ = P.ws; asm volatile("" : "+s"(ws_));
    asm volatile("" : "+v"(tid)); lane = tid & 63; wid = __builtin_amdgcn_readfirstlane(tid >> 6);
    LAS bf16_t* Wt = (LAS bf16_t*)lds;
    LAS bf16_t* Vt = Wt + 128 * 136;
    const bf16_t* Wsb = (const bf16_t*)(ws_ + O_WMIX + 6 * MiB);
    const bf16_t* U = (const bf16_t*)(ws_ + O_AR);
    const bf16_t* V = (const bf16_t*)(ws_ + O_AR + 32 * MiB);
    bf16_t* Y = (bf16_t*)(ws_ + O_AR + 64 * MiB);
    const float* bs = P.in[10];
    const int r16 = lane & 15, quad = lane >> 4;
    for (int item = bid; item < 1024; item += gridDim.x) {
        const int hd = item & 7, c = item >> 3;
        __syncthreads();
#pragma unroll
        for (int i = 0; i < 4; ++i) { const int cid = tid + 512 * i, t = cid >> 4, sc = cid & 15;
            const u32x4 w = *(const u32x4*)(Wsb + ((size_t)(hd * 128 + t)) * 128 + 8 * sc); *(LAS u32x4*)(Wt + t * 136 + 8 * sc) = w; }
#pragma unroll
        for (int i = 0; i < 4; ++i) { const int cid = tid + 512 * i, s = cid >> 4, dc = cid & 15;
            const u32x4 w = *(const u32x4*)(V + ((size_t)(c * 128 + s)) * 1024 + hd * 128 + 8 * dc);
#pragma unroll
            for (int e = 0; e < 8; ++e) Vt[(8 * dc + e) * 136 + s] = (bf16_t)((e & 1) ? (w[e >> 1] >> 16) : (w[e >> 1] & 0xffffu)); }
        __syncthreads();
        const int t = 16 * wid + r16;
        const int nks = (16 * wid + 15) / 32 + 1;
        bf16x8 bw[4];
#pragma unroll
        for (int ks = 0; ks < 4; ++ks) bw[ks] = *(const LAS bf16x8*)(Wt + t * 136 + 32 * ks + 8 * quad);
        const int token = c * 128 + t;
        const float bias = bs[hd * 128 + t];
#pragma unroll
        for (int dt = 0; dt < 8; ++dt) {
            f32x4 acc = {0.f, 0.f, 0.f, 0.f};
#pragma unroll
            for (int ks = 0; ks < 4; ++ks) if (ks < nks) {
                const bf16x8 a = *(const LAS bf16x8*)(Vt + (16 * dt + r16) * 136 + 32 * ks + 8 * quad);
                acc = __builtin_amdgcn_mfma_f32_16x16x32_bf16(a, bw[ks], acc, 0, 0, 0); }
            const int col = hd * 128 + 16 * dt + 4 * quad;
            const u32x2 uu = *(const u32x2*)(U + (size_t)token * 1024 + col);
            f32x4 y; y[0] = (acc[0] + bias) * bflo(uu.x); y[1] = (acc[1] + bias) * bfhi(uu.x); y[2] = (acc[2] + bias) * bflo(uu.y); y[3] = (acc[3] + bias) * bfhi(uu.y);
            store_bf4(Y + (size_t)token * 1024 + col, y);
        }
    }
}

DI void pool_phase(const Params& P, int gtid, int nthreads) {
    unsigned char* ws_ = P.ws; asm volatile("" : "+s"(ws_));
    asm volatile("" : "+v"(gtid));
    const float* ZF = (const float*)(ws_ + O_AR);
    bf16_t* Pb = (bf16_t*)(ws_ + O_AR + 64 * MiB);
    for (int e = gtid; e < 1024 * 256; e += nthreads) {
        const int cgi = e & 255, tb = e >> 8, col = 4 * cgi, w = 2 << (cgi >> 6), t0 = 16 * tb;
        f32x4 W = {0.f, 0.f, 0.f, 0.f};
        for (int j = 1; j < w; ++j) if (t0 - j >= 0) W += *(const f32x4*)(ZF + (size_t)(t0 - j) * 1024 + col);
        for (int i = 0; i < 16; ++i) { const int t = t0 + i; const f32x4 z = *(const f32x4*)(ZF + (size_t)t * 1024 + col); W += z;
            const float cnt = (float)((t + 1 < w) ? (t + 1) : w); const f32x4 o = W / cnt - z; store_bf4(Pb + (size_t)t * 1024 + col, o);
            if (t - w + 1 >= 0) W -= *(const f32x4*)(ZF + (size_t)(t - w + 1) * 1024 + col); }
    }
}

DI void mla_rows(const Params& P, int gw, int NGW, int lane) {
    unsigned char* ws_ = P.ws; asm volatile("" : "+s"(ws_));
    asm volatile("" : "+v"(lane));
    unsigned char* ar = ws_ + O_AR;
    const bf16_t* LAT = (const bf16_t*)ar; bf16_t* QL = (bf16_t*)(ar + 24 * MiB); bf16_t* Cb = (bf16_t*)(ar + 36 * MiB); bf16_t* KR = (bf16_t*)(ar + 44 * MiB);
    const float* CS = (const float*)(ws_ + O_CS); const float* gq = P.in[15]; const float* gkv = P.in[18];
    for (int row = gw; row < S; row += NGW) {
        const bf16_t* lat = LAT + (size_t)row * 768;
        float q[6]; float ss = 0.f;
#pragma unroll
        for (int i = 0; i < 3; ++i) { const unsigned w = *(const unsigned*)(lat + 2 * lane + 128 * i); q[2 * i] = bflo(w); q[2 * i + 1] = bfhi(w); ss += q[2 * i] * q[2 * i] + q[2 * i + 1] * q[2 * i + 1]; }
        ss = wave_sum(ss, lane); const float rq = rsqrtf(ss * (1.f / 384.f) + RMS_EPS);
#pragma unroll
        for (int i = 0; i < 3; ++i) { const f32x2 g2 = *(const f32x2*)(gq + 2 * lane + 128 * i); *(unsigned*)(QL + (size_t)row * 384 + 2 * lane + 128 * i) = pk_bf16(q[2 * i] * rq * g2.x, q[2 * i + 1] * rq * g2.y); }
        float cc[4]; float s2 = 0.f;
#pragma unroll
        for (int i = 0; i < 2; ++i) { const unsigned w = *(const unsigned*)(lat + 384 + 2 * lane + 128 * i); cc[2 * i] = bflo(w); cc[2 * i + 1] = bfhi(w); s2 += cc[2 * i] * cc[2 * i] + cc[2 * i + 1] * cc[2 * i + 1]; }
        s2 = wave_sum(s2, lane); const float rc = rsqrtf(s2 * (1.f / 256.f) + RMS_EPS);
#pragma unroll
        for (int i = 0; i < 2; ++i) { const f32x2 g2 = *(const f32x2*)(gkv + 2 * lane + 128 * i); *(unsigned*)(Cb + (size_t)row * 256 + 2 * lane + 128 * i) = pk_bf16(cc[2 * i] * rc * g2.x, cc[2 * i + 1] * rc * g2.y); }
        if (lane < 32) { const float x1 = bf2f(lat[640 + lane]), x2 = bf2f(lat[672 + lane]); const f32x2 cs = *(const f32x2*)(CS + ((size_t)row * 32 + lane) * 2);
            *(unsigned*)(KR + (size_t)row * 64 + 2 * lane) = pk_bf16(x1 * cs.x - x2 * cs.y, x1 * cs.y + x2 * cs.x); }
    }
}

#define MFMA32(a, b, c) __builtin_amdgcn_mfma_f32_32x32x16_bf16((a), (b), (c), 0, 0, 0)
DI int crow(int reg, int h) { return (reg & 3) + 8 * (reg >> 2) + 4 * h; }

DI void attn_phase(const Params& P, LAS unsigned char* lds, int tid, int wid, int lane, int bid) {
    unsigned char* ws_ = P.ws; asm volatile("" : "+s"(ws_));
    asm volatile("" : "+v"(tid)); lane = tid & 63; wid = __builtin_amdgcn_readfirstlane(tid >> 6);
    unsigned char* ar = ws_ + O_AR;
    const bf16_t* Q = (const bf16_t*)(ar + 48 * MiB); const bf16_t* KN = (const bf16_t*)(ar + 96 * MiB); const bf16_t* VT = (const bf16_t*)(ar + 128 * MiB); const bf16_t* KR = (const bf16_t*)(ar + 44 * MiB);
    bf16_t* AO = (bf16_t*)(ws_ + O_XN);
    const int l32 = lane & 31, h2 = lane >> 5;
    constexpr int BUFB = 43008, VOFF = 25600;
    const unsigned kn_off0 = (unsigned)(((tid >> 4) * 1024 + 8 * (tid & 15)) * 2);
    const unsigned kr_off = (unsigned)(((tid >> 3) * 64 + 8 * (tid & 7)) * 2);
    const unsigned vt_off0 = (unsigned)(((tid >> 3) * 16384 + 8 * (tid & 7)) * 2);
    const unsigned kn_l0 = (unsigned)((tid >> 4) * 400 + 16 * (tid & 15));
    const unsigned kr_l = (unsigned)((tid >> 3) * 400 + 256 + 16 * (tid & 7));
    const unsigned vt_l0 = (unsigned)(25600 + (tid >> 3) * 136 + 16 * (tid & 7));
    for (int item = bid; item < 256; item += gridDim.x) {
        const int head = item & 7, pair = item >> 3;
        for (int half = 0; half < 2; ++half) {
            const int qb = half ? 63 - pair : pair;
            const int wrow0 = qb * 256 + wid * 32, qrow = wrow0 + l32;
            bf16x8 Qf[12];
#pragma unroll
            for (int s = 0; s < 12; ++s) Qf[s] = *(const bf16x8*)(Q + (size_t)qrow * 1536 + head * 192 + 16 * s + 8 * h2);
            f32x16 o[4];
#pragma unroll
            for (int d = 0; d < 4; ++d)
#pragma unroll
                for (int r = 0; r < 16; ++r) o[d][r] = 0.f;
            float mrun = -INFINITY, lsum = 0.f;
            const int ntiles = 4 * (qb + 1);
            u32x4 kreg[3], vreg[2];
#define ATT_ISSUE(kt) do { \
    unsigned o0_ = kn_off0, o1_ = kr_off, o2_ = vt_off0; asm volatile("" : "+v"(o0_), "+v"(o1_), "+v"(o2_)); \
    const char* knb = (const char*)(KN + (size_t)(kt) * 65536 + head * 128); const char* krb = (const char*)(KR + (size_t)(kt) * 4096); \
    const char* vtb = (const char*)(VT + (size_t)head * 128 * 16384 + 64 * (kt)); \
    kreg[0] = *(const u32x4*)(knb + o0_); kreg[1] = *(const u32x4*)(knb + 65536 + o0_); kreg[2] = *(const u32x4*)(krb + o1_); \
    vreg[0] = *(const u32x4*)(vtb + o2_); vreg[1] = *(const u32x4*)(vtb + 2097152 + o2_); } while (0)
#define ATT_WRITE(b) do { LAS unsigned char* base = lds + (b) * BUFB; \
    *(LAS u32x4*)(base + kn_l0) = kreg[0]; *(LAS u32x4*)(base + kn_l0 + 12800) = kreg[1]; *(LAS u32x4*)(base + kr_l) = kreg[2]; \
    *(LAS u32x2*)(base + vt_l0) = (u32x2){vreg[0].x, vreg[0].y}; *(LAS u32x2*)(base + vt_l0 + 8) = (u32x2){vreg[0].z, vreg[0].w}; \
    *(LAS u32x2*)(base + vt_l0 + 8704) = (u32x2){vreg[1].x, vreg[1].y}; *(LAS u32x2*)(base + vt_l0 + 8712) = (u32x2){vreg[1].z, vreg[1].w}; } while (0)
            ATT_ISSUE(0); ATT_WRITE(0); __syncthreads();
            for (int kt = 0; kt < ntiles; ++kt) {
                const bool more = (kt + 1 < ntiles);
                if (more) ATT_ISSUE(kt + 1);
                if (64 * kt <= wrow0 + 31) {
                    LAS unsigned char* base = lds + (kt & 1) * BUFB;
                    f32x16 st0, st1;
#pragma unroll
                    for (int r = 0; r < 16; ++r) { st0[r] = 0.f; st1[r] = 0.f; }
#pragma unroll
                    for (int s = 0; s < 12; ++s) {
                        const bf16x8 a0 = *(const LAS bf16x8*)(base + l32 * 400 + (16 * s + 8 * h2) * 2);
                        const bf16x8 a1 = *(const LAS bf16x8*)(base + (32 + l32) * 400 + (16 * s + 8 * h2) * 2);
                        st0 = MFMA32(a0, Qf[s], st0); st1 = MFMA32(a1, Qf[s], st1); if ((s & 3) == 3) __builtin_amdgcn_sched_barrier(0); }
                    if (64 * kt + 63 > wrow0) {
#pragma unroll
                        for (int r = 0; r < 16; ++r) { const int key0 = 64 * kt + crow(r, h2); if (key0 > qrow) st0[r] = -INFINITY; if (key0 + 32 > qrow) st1[r] = -INFINITY; }
                    }
                    float mx = st0[0];
#pragma unroll
                    for (int r = 1; r < 16; ++r) mx = fmaxf(mx, st0[r]);
#pragma unroll
                    for (int r = 0; r < 16; ++r) mx = fmaxf(mx, st1[r]);
                    mx = fmaxf(mx, shx(mx, 32, lane));
                    const float mn = fmaxf(mrun, mx);
                    const float alpha = __builtin_amdgcn_exp2f(mrun - mn);
                    mrun = mn;
                    float psum = 0.f;
#pragma unroll
                    for (int r = 0; r < 16; ++r) { st0[r] = __builtin_amdgcn_exp2f(st0[r] - mn); st1[r] = __builtin_amdgcn_exp2f(st1[r] - mn); psum += st0[r] + st1[r]; }
                    lsum = lsum * alpha + psum;
#pragma unroll
                    for (int d = 0; d < 4; ++d)
#pragma unroll
                        for (int r = 0; r < 16; ++r) o[d][r] *= alpha;
#pragma unroll
                    for (int kk = 0; kk < 2; ++kk)
#pragma unroll
                        for (int sp = 0; sp < 2; ++sp) {
                            u32x4 pw;
                            if (kk == 0) { pw.x = pk_bf16(st0[8 * sp], st0[8 * sp + 1]); pw.y = pk_bf16(st0[8 * sp + 2], st0[8 * sp + 3]); pw.z = pk_bf16(st0[8 * sp + 4], st0[8 * sp + 5]); pw.w = pk_bf16(st0[8 * sp + 6], st0[8 * sp + 7]); }
                            else { pw.x = pk_bf16(st1[8 * sp], st1[8 * sp + 1]); pw.y = pk_bf16(st1[8 * sp + 2], st1[8 * sp + 3]); pw.z = pk_bf16(st1[8 * sp + 4], st1[8 * sp + 5]); pw.w = pk_bf16(st1[8 * sp + 6], st1[8 * sp + 7]); }
                            const bf16x8 pf = __builtin_bit_cast(bf16x8, pw);
#pragma unroll
                            for (int d = 0; d < 4; ++d) {
                                const LAS unsigned char* vp = base + VOFF + (d * 32 + l32) * 136 + (32 * kk + 16 * sp + 4 * h2) * 2;
                                const u32x2 lo = *(const LAS u32x2*)vp, hi = *(const LAS u32x2*)(vp + 16);
                                const u32x4 vw = {lo.x, lo.y, hi.x, hi.y};
                                o[d] = MFMA32(__builtin_bit_cast(bf16x8, vw), pf, o[d]); }
                        }
                }
                if (more) ATT_WRITE((kt + 1) & 1);
                __syncthreads();
            }
            int t2_ = tid; asm volatile("" : "+v"(t2_));
            const int qrow2 = qb * 256 + (t2_ >> 6) * 32 + (t2_ & 31), h2b = (t2_ >> 5) & 1;
            const float ltot = lsum + shx(lsum, 32, lane);
            const float inv = 1.f / ltot;
#pragma unroll
            for (int d = 0; d < 4; ++d)
#pragma unroll
                for (int rg = 0; rg < 4; ++rg) { f32x4 v = {o[d][4 * rg] * inv, o[d][4 * rg + 1] * inv, o[d][4 * rg + 2] * inv, o[d][4 * rg + 3] * inv};
                    store_bf4(AO + (size_t)qrow2 * 1024 + head * 128 + d * 32 + 8 * rg + 4 * h2b, v); }
        }
    }
#undef ATT_ISSUE
#undef ATT_WRITE
}

DI void s5_precompute(const Params& P, LAS unsigned char* lds, int tid, int bid) {
    unsigned char* ws_ = P.ws; asm volatile("" : "+s"(ws_));
    asm volatile("" : "+v"(tid));
    LAS float* PWr = (LAS float*)lds;
    LAS float* PWi = PWr + 33 * 64;
    LAS float* BBr = PWi + 33 * 64;
    LAS float* BBi = BBr + 1024;
    LAS float* CRe = BBi + 1024;
    LAS float* CIm = CRe + 1024;
    LAS float* KT = CIm + 1024;
    const float* lam_re = P.in[22]; const float* lam_im = P.in[23]; const float* log_dt = P.in[24];
    const float* b_re = P.in[25]; const float* b_im = P.in[26]; const float* c_re = P.in[27]; const float* c_im = P.in[28]; const float* dsk = P.in[29];
    bf16_t* TF = (bf16_t*)(ws_ + O_AR + 40 * MiB); bf16_t* Eb = (bf16_t*)(ws_ + O_AR + 80 * MiB);
    for (int item = bid; item < 256; item += gridDim.x) {
        const int g = item >> 2, q = item & 3;
        __syncthreads();
        const float dt = expf(log_dt[g]);
        for (int e = tid; e < 33 * 64; e += 512) { const int j = e >> 6, p = e & 63; const float lr = lam_re[g * 64 + p], li = lam_im[g * 64 + p];
            const float mag = expf((float)j * (lr * dt)); float sn, cs; sincosf((float)j * (li * dt), &sn, &cs); PWr[e] = mag * cs; PWi[e] = mag * sn; }
        for (int e = tid; e < 1024; e += 512) { const int p = e >> 4; const float lr = lam_re[g * 64 + p], li = lam_im[g * 64 + p];
            const float mag = expf(lr * dt); float sn, cs; sincosf(li * dt, &sn, &cs); const float ar = mag * cs, ai = mag * sn;
            const float den = lr * lr + li * li; const float fre = ((ar - 1.f) * lr + ai * li) / den, fim = (ai * lr - (ar - 1.f) * li) / den;
            const float br = b_re[(size_t)g * 1024 + e], bi = b_im[(size_t)g * 1024 + e];
            BBr[e] = fre * br - fim * bi; BBi[e] = fre * bi + fim * br; }
        for (int e = tid; e < 1024; e += 512) { CRe[e] = c_re[(size_t)g * 1024 + e]; CIm[e] = c_im[(size_t)g * 1024 + e]; }
        __syncthreads();
        for (int e = tid; e < 8192; e += 512) { const int j = e >> 8, co = (e >> 4) & 15, ci = e & 15; float a = 0.f;
            for (int p = 0; p < 64; ++p) { const float cr = CRe[co * 64 + p], cm = CIm[co * 64 + p], pr = PWr[j * 64 + p], pi = PWi[j * 64 + p];
                const float wr_ = cr * pr - cm * pi, wi_ = cr * pi + cm * pr; a += wr_ * BBr[p * 16 + ci] - wi_ * BBi[p * 16 + ci]; }
            if (j == 0 && co == ci) a += dsk[g * 16 + co];
            KT[e] = a; }
        __syncthreads();
        for (int e = tid; e < 128 * 80; e += 512) { const int rr = e / 80, kc = e - rr * 80, n = 128 * q + rr, l = n >> 4, co = n & 15; float v[8];
            if (kc < 64) { const int lp = kc >> 1;
#pragma unroll
                for (int i = 0; i < 8; ++i) v[i] = (lp <= l) ? KT[((l - lp) * 16 + co) * 16 + 8 * (kc & 1) + i] : 0.f;
            } else {
                const bool im = kc >= 72; const int p0 = 8 * (kc - (im ? 72 : 64));
#pragma unroll
                for (int i = 0; i < 8; ++i) { const int p = p0 + i; const float cr = CRe[co * 64 + p], cm = CIm[co * 64 + p], pr = PWr[(l + 1) * 64 + p], pi = PWi[(l + 1) * 64 + p];
                    v[i] = im ? -(cr * pi + cm * pr) : (cr * pr - cm * pi); }
            }
            u32x4 o; o.x = pk_bf16(v[0], v[1]); o.y = pk_bf16(v[2], v[3]); o.z = pk_bf16(v[4], v[5]); o.w = pk_bf16(v[6], v[7]);
            *(u32x4*)(TF + ((size_t)(g * 512 + n)) * 640 + 8 * kc) = o; }
        for (int e = tid; e < 32 * 64; e += 512) { const int n = 32 * q + (e >> 6), kc = e & 63, p = n & 63, im = n >> 6, lp = kc >> 1; float v[8];
            const float pr = PWr[(31 - lp) * 64 + p], pi = PWi[(31 - lp) * 64 + p];
#pragma unroll
            for (int i = 0; i < 8; ++i) { const int ci = 8 * (kc & 1) + i; const float br = BBr[p * 16 + ci], bi = BBi[p * 16 + ci]; v[i] = im ? (pr * bi + pi * br) : (pr * br - pi * bi); }
            u32x4 o; o.x = pk_bf16(v[0], v[1]); o.y = pk_bf16(v[2], v[3]); o.z = pk_bf16(v[4], v[5]); o.w = pk_bf16(v[6], v[7]);
            *(u32x4*)(Eb + ((size_t)(g * 256 + n)) * 512 + 8 * kc) = o; }
    }
}

DI void s5_scan(const Params& P, int wid, int lane, int bid) {
    unsigned char* ws_ = P.ws; asm volatile("" : "+s"(ws_));
    asm volatile("" : "+v"(lane));
    if (wid != 0) return;
    const float* lam_re = P.in[22]; const float* lam_im = P.in[23]; const float* log_dt = P.in[24];
    const float* XE = (const float*)(ws_ + O_AR + 96 * MiB); bf16_t* UG = (bf16_t*)(ws_ + O_AR);
    for (int g = bid; g < 64; g += gridDim.x) {
        const int p = lane; const float dt = expf(log_dt[g]); const float lr = lam_re[g * 64 + p], li = lam_im[g * 64 + p];
        const float mag = expf(32.f * (lr * dt)); float sn, cs; sincosf(32.f * (li * dt), &sn, &cs); const float ar = mag * cs, ai = mag * sn;
        float cr = 0.f, ci = 0.f;
        const float* xe = XE + (size_t)g * 512 * 128; bf16_t* ug = UG + (size_t)g * 512 * 640;
        for (int c0 = 0; c0 < 512; c0 += 16) {
            float xr[16], xi[16];
#pragma unroll
            for (int i = 0; i < 16; ++i) { xr[i] = xe[(size_t)(c0 + i) * 128 + p]; xi[i] = xe[(size_t)(c0 + i) * 128 + 64 + p]; }
#pragma unroll
            for (int i = 0; i < 16; ++i) { ug[(size_t)(c0 + i) * 640 + 512 + p] = f2bf(cr); ug[(size_t)(c0 + i) * 640 + 576 + p] = f2bf(ci);
                const float nr = ar * cr - ai * ci + xr[i], ni = ar * ci + ai * cr + xi[i]; cr = nr; ci = ni; }
        }
    }
}

DI void cs_table(const Params& P, int gtid, int nthreads) {
    unsigned char* ws_ = P.ws; asm volatile("" : "+s"(ws_));
    asm volatile("" : "+v"(gtid));
    const int* pos = (const int*)P.in[1]; float* CS = (float*)(ws_ + O_CS);
    for (int e = gtid; e < S * 32; e += nthreads) { const int row = e >> 5, j = e & 31;
        const float invf = exp2f(-(float)j * (13.287712379549449f / 32.f)); const float ang = (float)pos[row] * invf; float sn, cs; sincosf(ang, &sn, &cs);
        *(f32x2*)(CS + (size_t)e * 2) = (f32x2){cs, sn}; }
}

__global__ void __launch_bounds__(512, 2) mega_fwd(Params P) {
    extern __shared__ __attribute__((aligned(16))) unsigned char smem[];
    LAS unsigned char* lds = (LAS unsigned char*)smem;
    cg::grid_group grid = cg::this_grid();
    const int G = gridDim.x, nthreads = G * 512, NGW = G * 8;
#pragma nounroll
    for (int st = 0; st < NSTEPS; ++st) {
        int tid = threadIdx.x; asm volatile("" : "+v"(tid));
        int bid = blockIdx.x; asm volatile("" : "+s"(bid));
        unsigned char* ws = P.ws; asm volatile("" : "+s"(ws));
        float* outp_ = P.out; asm volatile("" : "+s"(outp_));
        const int lane = tid & 63, wid = __builtin_amdgcn_readfirstlane(tid >> 6);
        const int gw = bid * 8 + wid, gtid = bid * 512 + tid;
        const float* ng = P.in[2];
        bf16_t* XN = (bf16_t*)(ws + O_XN); const bf16_t* Zb = (const bf16_t*)(ws + O_Z);
        GemmDesc g;
        if (get_gemm(P, st, g)) gemm_phase(lds, P, g, G, bid, tid);
        else switch (st) {
        case 0: conv_layer(P, 0, gw, NGW, lane); cs_table(P, gtid, nthreads);
                row_pass<RP_BF>(P.in[0], outp_, nullptr, nullptr, ng, XN, gw, NGW, lane); break;
        case 2: lnv_phase(P, gw, NGW, lane); break;
        case 3: gate_phase(P, lds, tid, wid, lane, bid); break;
        case 5: case 11: case 14: case 22: case 30: {
            const int L = (st == 5) ? 0 : (st <= 14 ? 1 : (st == 22 ? 2 : 3)); const bool mlp = (st == 14);
            const float* hin = (st == 5) ? P.in[0] : outp_;
            const float* gpost = ng + (L * 4 + (mlp ? 3 : 1)) * 1024; const float* gpre = mlp ? ng + ((L + 1) * 4) * 1024 : ng + (L * 4 + 2) * 1024;
            row_pass<RP_BF>(hin, outp_, Zb, gpost, gpre, XN, gw, NGW, lane);
            if (mlp) conv_layer(P, L + 1, gw, NGW, lane);
        } break;
        case 8: row_pass<RP_F32>(outp_, outp_, Zb, ng + 3 * 1024, ng + 4 * 1024, ws + O_AR, gw, NGW, lane); conv_layer(P, 1, gw, NGW, lane); break;
        case 9: pool_phase(P, gtid, nthreads); break;
        case 16: mla_rows(P, gw, NGW, lane); break;
        case 20: attn_phase(P, lds, tid, wid, lane, bid); break;
        case 25: row_pass<RP_S5>(outp_, outp_, Zb, ng + 11 * 1024, ng + 12 * 1024, ws + O_AR, gw, NGW, lane); conv_layer(P, 3, gw, NGW, lane); s5_precompute(P, lds, tid, bid); break;
        case 27: s5_scan(P, wid, lane, bid); break;
        case 33: row_pass<RP_FINAL>(outp_, outp_, Zb, ng + 15 * 1024, nullptr, nullptr, gw, NGW, lane); break;
        default: break;
        }
        if (st != 17 && st != 18 && st != NSTEPS - 1) grid.sync();
    }
}
}

extern "C" void kernel_launch(void* const* d_in, const int* in_sizes, int n_in, void* d_out, int out_size, void* d_ws, size_t ws_size, hipStream_t stream) {
    static int grid = 0;
    if (grid == 0) {
        int dev = 0, cus = 0, per_cu = 0;
        hipGetDevice(&dev);
        hipDeviceGetAttribute(&cus, hipDeviceAttributeMultiprocessorCount, dev);
        hipFuncSetAttribute((const void*)mega_fwd, hipFuncAttributeMaxDynamicSharedMemorySize, LDS_BYTES);
        if (hipOccupancyMaxActiveBlocksPerMultiprocessor(&per_cu, (const void*)mega_fwd, 512, LDS_BYTES) != hipSuccess || per_cu < 1) per_cu = 1;
        (void)hipGetLastError();
        grid = cus * per_cu;
        if (grid <= 0) grid = 256;
    }
    Params p{};
    for (int i = 0; i < 32 && i < n_in; ++i) p.in[i] = (const float*)d_in[i];
    p.out = (float*)d_out; p.ws = (unsigned char*)d_ws;
    void* args[] = {&p};
    hipError_t e = hipLaunchCooperativeKernel((const void*)mega_fwd, dim3(grid), dim3(512), args, LDS_BYTES, stream);
    if (e != hipSuccess) fprintf(stderr, "cooperative launch failed: %s (grid %d)\n", hipGetErrorString(e), grid);
}
```

```cpp
#include <hip/hip_runtime.h>
#include <hip/hip_cooperative_groups.h>
#include <cstdio>
namespace cg = cooperative_groups;

#define DI __device__ __forceinline__
#define LAS __attribute__((address_space(3)))
typedef unsigned short bf16_t;
typedef short bf16x8 __attribute__((ext_vector_type(8)));
typedef float f32x2 __attribute__((ext_vector_type(2)));
typedef float f32x4 __attribute__((ext_vector_type(4)));
typedef float f32x16 __attribute__((ext_vector_type(16)));
typedef unsigned u32x2 __attribute__((ext_vector_type(2)));
typedef unsigned u32x4 __attribute__((ext_vector_type(4)));
typedef __bf16 bf16v2 __attribute__((ext_vector_type(2)));

#define LANE_ (tid & 63)
#define WID_ (__builtin_amdgcn_readfirstlane(tid >> 6))
#define GW_ (bid * 8 + WID_)
#define GTID_ (bid * 512 + tid)
namespace {
constexpr int S = 16384;
constexpr size_t MiB = (size_t)1 << 20;
constexpr size_t O_CS = 0, O_WUP = 4 * MiB, O_WDN = 12 * MiB, O_WMIX = 20 * MiB, O_XN = 28 * MiB, O_Z = 60 * MiB, O_AR = 92 * MiB;
constexpr int LDS_BYTES = 131072;
constexpr int NSTEPS = 34;
constexpr float RMS_EPS = 1e-6f;
constexpr float QSCALE = 0.07216878364870322f * 1.4426950408889634f;

enum { E_Z = 0, E_HID, E_UV, E_POOL, E_LAT, E_Q, E_KN, E_VT, E_XE, E_S5Y, E_GLU };

struct Params { const float* in[32]; float* out; unsigned char* ws; };

DI unsigned pk_bf16(float a, float b) { f32x2 f = {a, b}; bf16v2 h = __builtin_convertvector(f, bf16v2); return __builtin_bit_cast(unsigned, h); }
DI bf16_t f2bf(float x) { return (bf16_t)(pk_bf16(x, 0.f) & 0xffffu); }
DI float bf2f(bf16_t b) { return __uint_as_float(((unsigned)b) << 16); }
DI float bflo(unsigned u) { return __uint_as_float(u << 16); }
DI float bfhi(unsigned u) { return __uint_as_float(u & 0xffff0000u); }
DI float shx(float v, int o, int lane) { return __int_as_float(__builtin_amdgcn_ds_bpermute((lane ^ o) << 2, __float_as_int(v))); }
DI float wave_sum(float v, int lane) {
#pragma unroll
    for (int o = 1; o < 64; o <<= 1) v += shx(v, o, lane);
    return v;
}
DI void store_bf4(bf16_t* p, f32x4 v) { u32x2 w; w.x = pk_bf16(v[0], v[1]); w.y = pk_bf16(v[2], v[3]); *(u32x2*)p = w; }
DI float gelu_tanh(float x) {
    const float u = 0.7978845608028654f * (x + 0.044715f * x * x * x);
    const float e = __expf(-2.f * u);
    return x / (1.f + e);
}

constexpr int BM = 256, BK = 64, HALF = 128, HTB = HALF * BK * 2, NXCD = 8, WGM = 8;
DI int lds_byte(int r, int c) { const int st = (r >> 4) * 2 + (c >> 5), rr = r & 15, cc = c & 31, ob = rr * 64 + cc * 2; return st * 1024 + (ob ^ (((ob >> 9) & 1) << 5)); }
DI void stage_rc(int b, int& R, int& C) { const int st = b / 1024, sb = b % 1024, swz = sb ^ (((sb >> 9) & 1) << 5); R = (st >> 1) * 16 + swz / 64; C = (st & 1) * 32 + (swz % 64) / 2; }

struct GemmDesc { const bf16_t* A; const bf16_t* Bt; long a_gs, b_gs; int K, lda, ldb, nM, nN, ngrp, mode; };
struct Unit { int pm, pn, grp; };

DI bool unit_next(const GemmDesc& g, int i, int G, int c, Unit& u) {
    const int nper = g.nM * g.nN;
    const long L = (long)i * G + c;
    const bool ok = L < (long)nper * g.ngrp;
    const int grp2 = (int)(L / nper), w = (int)(L - (long)grp2 * nper);
    const int nwg = nper, nM = g.nM, nN = g.nN;
    int wgid = w;
    { const int q = nwg / NXCD, r = nwg % NXCD, xcd = wgid % NXCD, off = wgid / NXCD; wgid = (xcd < r ? xcd * (q + 1) : r * (q + 1) + (xcd - r) * q) + off; }
    const int nig = WGM * nN, gid = wgid / nig, fm = gid * WGM, gsz = (nM - fm) < WGM ? (nM - fm) : WGM;
    const int gszc = gsz > 0 ? gsz : 1;
    const int pm1 = fm + ((wgid % nig) % gszc), pn1 = (wgid % nig) / gszc;
    const int pm2 = w % nM, pn2 = w / nM;
    const bool single = (g.ngrp == 1);
    Unit r; r.pm = single ? pm1 : pm2; r.pn = single ? pn1 : pn2; r.grp = single ? 0 : grp2;
    u = r;
    return ok;
}

#define EPI_LOOP(...) \
    _Pragma("unroll") for (int ai = 0; ai < 2; ++ai) _Pragma("unroll") for (int m = 0; m < 4; ++m) { const int row = row0 + ai * HALF + m * 16; \
        _Pragma("unroll") for (int bj = 0; bj < 2; ++bj) _Pragma("unroll") for (int n = 0; n < 2; ++n) { const int col = col0 + bj * HALF + n * 16; f32x4 v = acc[ai][bj][m][n]; __VA_ARGS__ } }

DI void epilogue(const Params& P, const GemmDesc& g, const f32x4 (&acc)[2][2][4][2], const Unit& u, int wr, int wc, int fr, int fq) {
    unsigned char* ws_ = P.ws; asm volatile("" : "+s"(ws_));
    unsigned char* ws = ws_;
    const int row0 = u.pm * BM + wr * 64 + fr, col0 = u.pn * BM + wc * 32 + 4 * fq;
    bf16_t* Zb = (bf16_t*)(ws + O_Z);
    bf16_t* AR = (bf16_t*)(ws + O_AR);
    switch (g.mode) {
    case E_Z: { EPI_LOOP( store_bf4(Zb + (size_t)row * 1024 + col, v); ) } break;
    case E_HID: { EPI_LOOP( _Pragma("unroll") for (int j = 0; j < 4; ++j) { const float t = fmaxf(v[j], 0.f); v[j] = t * t; } store_bf4(AR + (size_t)row * 4096 + col, v); ) } break;
    case E_UV: { const float* bin = P.in[6];
        EPI_LOOP( const f32x4 b = *(const f32x4*)(bin + col); _Pragma("unroll") for (int j = 0; j < 4; ++j) v[j] = gelu_tanh(v[j] + b[j]);
                  bf16_t* dst = (col < 1024) ? (AR + (size_t)row * 1024 + col) : (AR + 16 * MiB + (size_t)row * 1024 + (col - 1024)); store_bf4(dst, v); ) } break;
    case E_POOL: { const float* sc = P.in[13];
        EPI_LOOP( const int cgc = 256 * u.grp + col; const f32x4 s4 = *(const f32x4*)(sc + cgc); store_bf4(Zb + (size_t)row * 1024 + cgc, v * s4); ) } break;
    case E_LAT: { EPI_LOOP( store_bf4(AR + (size_t)row * 768 + col, v); ) } break;
    case E_Q: { const float* CS = (const float*)(ws + O_CS); bf16_t* Qb = AR + 24 * MiB;
        EPI_LOOP( const int w = col % 192;
                  if (w >= 128) { const int j = (w - 128) >> 1; const f32x4 cs = *(const f32x4*)(CS + ((size_t)row * 32 + j) * 2);
                      const float a0 = v[0] * cs[0] - v[1] * cs[1], a1 = v[0] * cs[1] + v[1] * cs[0], a2 = v[2] * cs[2] - v[3] * cs[3], a3 = v[2] * cs[3] + v[3] * cs[2];
                      v[0] = a0; v[1] = a1; v[2] = a2; v[3] = a3; }
                  store_bf4(Qb + (size_t)row * 1536 + col, v * QSCALE); ) } break;
    case E_KN: { bf16_t* KN = AR + 48 * MiB; EPI_LOOP( store_bf4(KN + (size_t)row * 1024 + col, v); ) } break;
    case E_VT: { bf16_t* VT = AR + 64 * MiB; EPI_LOOP( store_bf4(VT + (size_t)row * 16384 + col, v); ) } break;
    case E_XE: { float* XE = (float*)(ws + O_AR + 96 * MiB);
        EPI_LOOP( if (col < 128) *(f32x4*)(XE + ((size_t)(u.grp * 512 + row)) * 128 + col) = v; ) } break;
    case E_S5Y: { bf16_t* Y5 = AR + 56 * MiB;
        EPI_LOOP( const int l = col >> 4, c = col & 15; const int token = row * 32 + l; _Pragma("unroll") for (int j = 0; j < 4; ++j) v[j] = gelu_tanh(v[j]);
                  store_bf4(Y5 + (size_t)token * 1024 + u.grp * 16 + c, v); ) } break;
    case E_GLU: {
#pragma unroll
        for (int ai = 0; ai < 2; ++ai)
#pragma unroll
            for (int m = 0; m < 4; ++m) { const int row = row0 + ai * HALF + m * 16;
#pragma unroll
                for (int n = 0; n < 2; ++n) { const int oc = u.pn * 128 + wc * 32 + n * 16 + 4 * fq; const f32x4 a = acc[ai][0][m][n], b = acc[ai][1][m][n]; f32x4 v;
#pragma unroll
                    for (int j = 0; j < 4; ++j) v[j] = a[j] / (1.f + __expf(-b[j]));
                    store_bf4(Zb + (size_t)row * 1024 + oc, v); } }
    } break;
    default: break;
    }
}

DI void gemm_phase(LAS unsigned char* lds, const Params& P, const GemmDesc g, const int G, const int cidx, int tid) {
    asm volatile("" : "+v"(tid));
    const int wid = __builtin_amdgcn_readfirstlane(tid >> 6), lane = tid & 63, wr = wid >> 2, wc = wid & 3, fr = lane & 15, fq = lane >> 4;
    const int K = g.K, nt = K / BK;
    unsigned voffA[2], voffB[2];
#pragma unroll
    for (int i = 0; i < 2; ++i) { int R, C; stage_rc(tid * 16 + i * 8192, R, C); voffA[i] = (unsigned)(R * g.lda + C) * 2u; voffB[i] = (unsigned)(R * g.ldb + C) * 2u; }
    const size_t kstep = (size_t)(BK * 2);
    const size_t hstepA = (size_t)HALF * g.lda * 2, hstepB = (size_t)HALF * g.ldb * 2;
    const unsigned ldsw = (unsigned)wid * 1024u;
    const int aoff = lds_byte(wr * 64 + fr, fq * 8), boff = lds_byte(wc * 32 + fr, fq * 8);
#define PG8_SA(b, h) (((b) * 2 + (h)) * HTB)
#define PG8_SB(b, h) ((4 + (b) * 2 + (h)) * HTB)
#define PG8_STAGE(bufoff, gbase, voff) do { _Pragma("unroll") for (int _i = 0; _i < 2; ++_i) \
        __builtin_amdgcn_global_load_lds((const unsigned*)((const char*)(gbase) + (voff)[_i]), (LAS unsigned*)(lds + (bufoff) + ldsw + _i * 8192), 16, 0, 0); } while (0)
#define PG8_LDA(dst, b, h) do { _Pragma("unroll") for (int m = 0; m < 4; ++m) _Pragma("unroll") for (int k = 0; k < 2; ++k) dst[m][k] = *(const LAS bf16x8*)(lds + PG8_SA(b, h) + aoff + m * 2048 + k * 1024); } while (0)
#define PG8_LDB(dst, b, h) do { _Pragma("unroll") for (int n = 0; n < 2; ++n) _Pragma("unroll") for (int k = 0; k < 2; ++k) dst[n][k] = *(const LAS bf16x8*)(lds + PG8_SB(b, h) + boff + n * 2048 + k * 1024); } while (0)
#define PG8_MMA(ai, bj, At, Bt) do { __builtin_amdgcn_s_setprio(1); _Pragma("unroll") for (int m = 0; m < 4; ++m) _Pragma("unroll") for (int n = 0; n < 2; ++n) _Pragma("unroll") for (int k = 0; k < 2; ++k) \
        acc[ai][bj][m][n] = __builtin_amdgcn_mfma_f32_16x16x32_bf16(Bt[n][k], At[m][k], acc[ai][bj][m][n], 0, 0, 0); __builtin_amdgcn_s_setprio(0); } while (0)
#define PG8_WAIT_V(n) asm volatile("s_waitcnt vmcnt(" #n ")" ::: "memory")
#define PG8_WAIT_L(n) asm volatile("s_waitcnt lgkmcnt(" #n ")" ::: "memory")
#define PG8_BAR __builtin_amdgcn_s_barrier()
#define PG8_SCHED __builtin_amdgcn_sched_barrier(0)
    Unit cur, nxt; int ui = 0;
    if (!unit_next(g, 0, G, cidx, cur)) return;
    f32x4 acc[2][2][4][2];
#pragma unroll
    for (int a = 0; a < 2; ++a)
#pragma unroll
        for (int b = 0; b < 2; ++b)
#pragma unroll
            for (int m = 0; m < 4; ++m)
#pragma unroll
                for (int n = 0; n < 2; ++n) acc[a][b][m][n] = (f32x4){0.f, 0.f, 0.f, 0.f};
    bf16x8 At[4][2], B0[2][2], B1[2][2];
    const char* cA = (const char*)g.A + ((size_t)cur.grp * g.a_gs + (size_t)cur.pm * BM * g.lda) * 2;
    const char* cB = (const char*)g.Bt + ((size_t)cur.grp * g.b_gs + (size_t)cur.pn * BM * g.ldb) * 2;
    PG8_STAGE(PG8_SB(0, 0), cB, voffB); PG8_STAGE(PG8_SA(0, 0), cA, voffA); PG8_STAGE(PG8_SB(0, 1), cB + hstepB, voffB); PG8_STAGE(PG8_SA(0, 1), cA + hstepA, voffA);
    if (wr == 1) PG8_BAR;
    PG8_WAIT_V(4); PG8_BAR;
    PG8_STAGE(PG8_SB(1, 0), cB + kstep, voffB); PG8_STAGE(PG8_SA(1, 0), cA + kstep, voffA); PG8_STAGE(PG8_SB(1, 1), cB + hstepB + kstep, voffB);
    PG8_WAIT_V(6); PG8_BAR;
    for (;;) {
        const bool has_next = unit_next(g, ui + 1, G, cidx, nxt);
        const char* nA = has_next ? (const char*)g.A + ((size_t)nxt.grp * g.a_gs + (size_t)nxt.pm * BM * g.lda) * 2 : cA;
        const char* nB = has_next ? (const char*)g.Bt + ((size_t)nxt.grp * g.b_gs + (size_t)nxt.pn * BM * g.ldb) * 2 : cB;
        for (int t = 0; t < nt; t += 2) {
            const bool last = (t == nt - 2);
            const char* a1 = cA + (size_t)(t + 1) * kstep;
            const char* a2 = last ? nA : cA + (size_t)(t + 2) * kstep; const char* b2 = last ? nB : cB + (size_t)(t + 2) * kstep;
            const char* a3 = a2 + kstep; const char* b3 = b2 + kstep;
            PG8_LDB(B0, 0, 0); PG8_SCHED; PG8_LDA(At, 0, 0); PG8_STAGE(PG8_SA(1, 1), a1 + hstepA, voffA);
            PG8_WAIT_L(8); PG8_BAR; PG8_WAIT_L(0); PG8_MMA(0, 0, At, B0); PG8_BAR; PG8_SCHED;
            PG8_LDB(B1, 0, 1); PG8_STAGE(PG8_SB(0, 0), b2, voffB);
            PG8_BAR; PG8_WAIT_L(0); PG8_MMA(0, 1, At, B1); PG8_BAR;
            PG8_LDA(At, 0, 1); PG8_STAGE(PG8_SA(0, 0), a2, voffA);
            PG8_BAR; PG8_WAIT_L(0); PG8_MMA(1, 0, At, B0); PG8_BAR; PG8_SCHED;
            PG8_STAGE(PG8_SB(0, 1), b2 + hstepB, voffB);
            PG8_WAIT_V(6); PG8_BAR; PG8_MMA(1, 1, At, B1); PG8_BAR;
            PG8_LDB(B0, 1, 0); PG8_SCHED; PG8_LDA(At, 1, 0); PG8_STAGE(PG8_SA(0, 1), a2 + hstepA, voffA);
            PG8_WAIT_L(8); PG8_BAR; PG8_WAIT_L(0); PG8_MMA(0, 0, At, B0); PG8_BAR; PG8_SCHED;
            PG8_LDB(B1, 1, 1); PG8_STAGE(PG8_SB(1, 0), b3, voffB);
            PG8_BAR; PG8_WAIT_L(0); PG8_MMA(0, 1, At, B1); PG8_BAR;
            PG8_LDA(At, 1, 1); PG8_STAGE(PG8_SA(1, 0), a3, voffA);
            PG8_BAR; PG8_WAIT_L(0); PG8_MMA(1, 0, At, B0); PG8_BAR; PG8_SCHED;
            PG8_STAGE(PG8_SB(1, 1), b3 + hstepB, voffB);
            PG8_WAIT_V(6); PG8_BAR; PG8_MMA(1, 1, At, B1); PG8_BAR;
        }
        epilogue(P, g, acc, cur, wr, wc, fr, fq);
        if (!has_next) break;
#pragma unroll
        for (int a = 0; a < 2; ++a)
#pragma unroll
            for (int b = 0; b < 2; ++b)
#pragma unroll
                for (int m = 0; m < 4; ++m)
#pragma unroll
                    for (int n = 0; n < 2; ++n) acc[a][b][m][n] = (f32x4){0.f, 0.f, 0.f, 0.f};
        cur = nxt; cA = nA; cB = nB; ++ui;
    }
    PG8_WAIT_V(0);
    if (wr == 0) PG8_BAR;
    PG8_BAR;
}

DI bool get_gemm(const Params& P, int st, GemmDesc& g) {
    unsigned char* ws_ = P.ws; asm volatile("" : "+s"(ws_));
    unsigned char* ws = ws_;
    const bf16_t* XN = (const bf16_t*)(ws + O_XN);
    const bf16_t* WMIX = (const bf16_t*)(ws + O_WMIX);
    const bf16_t* AR = (const bf16_t*)(ws + O_AR);
    g.a_gs = 0; g.b_gs = 0; g.ngrp = 1; g.nM = 64; g.K = 1024; g.lda = 1024; g.ldb = 1024; g.A = XN; g.Bt = WMIX; g.nN = 4; g.mode = E_Z;
    switch (st) {
    case 1: g.nN = 8; g.mode = E_UV; return true;
    case 4: g.A = AR + 32 * MiB; g.Bt = WMIX + 2 * MiB; return true;
    case 6: case 12: case 23: case 31: g.Bt = (const bf16_t*)(ws + O_WUP); g.nN = 16; g.mode = E_HID; return true;
    case 7: case 13: case 24: case 32: g.A = AR; g.Bt = (const bf16_t*)(ws + O_WDN); g.K = 4096; g.lda = 4096; g.ldb = 4096; return true;
    case 10: g.A = AR + 32 * MiB; g.K = 256; g.ldb = 256; g.nN = 1; g.ngrp = 4; g.a_gs = 256; g.b_gs = 65536; g.mode = E_POOL; return true;
    case 15: g.nN = 3; g.mode = E_LAT; return true;
    case 17: g.A = AR + 12 * MiB; g.Bt = WMIX + 1 * MiB; g.K = 384; g.lda = 384; g.ldb = 384; g.nN = 6; g.mode = E_Q; return true;
    case 18: g.A = AR + 18 * MiB; g.Bt = WMIX + 2 * MiB; g.K = 256; g.lda = 256; g.ldb = 256; g.nN = 4; g.mode = E_KN; return true;
    case 19: g.A = WMIX + (5 * MiB) / 2; g.Bt = AR + 18 * MiB; g.K = 256; g.lda = 256; g.ldb = 256; g.nM = 4; g.nN = 64; g.mode = E_VT; return true;
    case 21: g.Bt = WMIX + 3 * MiB; return true;
    case 26: g.A = AR; g.Bt = AR + 40 * MiB; g.K = 512; g.lda = 640; g.ldb = 512; g.nM = 2; g.nN = 1; g.ngrp = 64; g.a_gs = 512 * 640; g.b_gs = 256 * 512; g.mode = E_XE; return true;
    case 28: g.A = AR; g.Bt = AR + 20 * MiB; g.K = 640; g.lda = 640; g.ldb = 640; g.nM = 2; g.nN = 2; g.ngrp = 64; g.a_gs = 512 * 640; g.b_gs = 512 * 640; g.mode = E_S5Y; return true;
    case 29: g.A = AR + 56 * MiB; g.nN = 8; g.mode = E_GLU; return true;
    default: return false;
    }
}

enum { RP_BF = 0, RP_F32 = 1, RP_S5 = 2, RP_FINAL = 3 };
template <int MODE>
DI void row_pass(const float* hin, float* hout, const bf16_t* z, const float* gpost, const float* gpre, void* outp, int gw, int NGW, int lane) {
    asm volatile("" : "+v"(lane));
    for (int row = gw; row < S; row += NGW) {
        f32x4 h[4];
#pragma unroll
        for (int j = 0; j < 4; ++j) { const int cb = (MODE == RP_S5) ? 16 * lane + 4 * j : 4 * lane + 256 * j; h[j] = *(const f32x4*)(hin + (size_t)row * 1024 + cb); }
        if (z) {
            f32x4 zz[4]; float ss = 0.f;
#pragma unroll
            for (int j = 0; j < 4; ++j) { const int cb = (MODE == RP_S5) ? 16 * lane + 4 * j : 4 * lane + 256 * j; const u32x2 w = *(const u32x2*)(z + (size_t)row * 1024 + cb);
                zz[j] = (f32x4){bflo(w.x), bfhi(w.x), bflo(w.y), bfhi(w.y)}; ss += zz[j][0] * zz[j][0] + zz[j][1] * zz[j][1] + zz[j][2] * zz[j][2] + zz[j][3] * zz[j][3]; }
            ss = wave_sum(ss, lane); const float rz = rsqrtf(ss * (1.f / 1024.f) + RMS_EPS);
#pragma unroll
            for (int j = 0; j < 4; ++j) { const int cb = (MODE == RP_S5) ? 16 * lane + 4 * j : 4 * lane + 256 * j; const f32x4 gp = *(const f32x4*)(gpost + cb); h[j] += zz[j] * rz * gp;
                *(f32x4*)(hout + (size_t)row * 1024 + cb) = h[j]; }
        }
        if (MODE != RP_FINAL) {
            float s2 = 0.f;
#pragma unroll
            for (int j = 0; j < 4; ++j) s2 += h[j][0] * h[j][0] + h[j][1] * h[j][1] + h[j][2] * h[j][2] + h[j][3] * h[j][3];
            s2 = wave_sum(s2, lane); const float rn = rsqrtf(s2 * (1.f / 1024.f) + RMS_EPS);
#pragma unroll
            for (int j = 0; j < 4; ++j) { const int cb = (MODE == RP_S5) ? 16 * lane + 4 * j : 4 * lane + 256 * j; const f32x4 gq = *(const f32x4*)(gpre + cb); const f32x4 xn = h[j] * rn * gq;
                if (MODE == RP_BF) store_bf4((bf16_t*)outp + (size_t)row * 1024 + cb, xn);
                if (MODE == RP_F32) *(f32x4*)((float*)outp + (size_t)row * 1024 + cb) = xn;
                if (MODE == RP_S5) store_bf4((bf16_t*)outp + ((size_t)(lane * 512 + (row >> 5))) * 640 + (row & 31) * 16 + 4 * j, xn); }
        }
    }
}

enum { MAP_ID = 0, MAP_UQ = 1, MAP_GLUA = 2, MAP_GLUB = 3 };
DI int dstrow(int mode, int n) {
    if (mode == MAP_UQ) { const int hd = n / 192, w = n - hd * 192; if (w < 128) return n; const int r = w - 128; return hd * 192 + 128 + 2 * (r & 31) + (r >> 5); }
    if (mode == MAP_GLUA) return (n >> 7) * 256 + (n & 127);
    if (mode == MAP_GLUB) return (n >> 7) * 256 + 128 + (n & 127);
    return n;
}
DI void convT(const float* src, int K, int N, bf16_t* dst, int ldT, int mapmode, int gw, int NGW, int lane) {
    asm volatile("" : "+v"(lane));
    const int nnb = N >> 4, nitems = nnb * (K >> 5);
    for (int it = gw; it < nitems; it += NGW) {
        const int kb = it / nnb, nb = it - kb * nnb;
        const int n = nb * 16 + (lane >> 2), k = kb * 32 + 8 * (lane & 3);
        const float* s = src + (size_t)k * N + n;
        float v[8];
#pragma unroll
        for (int i = 0; i < 8; ++i) v[i] = s[(size_t)i * N];
        u32x4 o; o.x = pk_bf16(v[0], v[1]); o.y = pk_bf16(v[2], v[3]); o.z = pk_bf16(v[4], v[5]); o.w = pk_bf16(v[6], v[7]);
        *(u32x4*)(dst + (size_t)dstrow(mapmode, n) * ldT + k) = o;
    }
}
DI void conv_layer(const Params& P, int L, int gw, int NGW, int lane) {
    unsigned char* ws_ = P.ws; asm volatile("" : "+s"(ws_));
    unsigned char* ws = ws_;
    bf16_t* WMIX = (bf16_t*)(ws + O_WMIX);
    convT(P.in[3] + (size_t)L * 1024 * 4096, 1024, 4096, (bf16_t*)(ws + O_WUP), 1024, MAP_ID, gw, NGW, lane);
    convT(P.in[4] + (size_t)L * 1024 * 4096, 4096, 1024, (bf16_t*)(ws + O_WDN), 4096, MAP_ID, gw, NGW, lane);
    if (L == 0) {
        convT(P.in[5], 1024, 2048, WMIX, 1024, MAP_ID, gw, NGW, lane);
        convT(P.in[11], 1024, 1024, WMIX + 2 * MiB, 1024, MAP_ID, gw, NGW, lane);
        const float* wsrc = P.in[9]; bf16_t* wd = WMIX + 3 * MiB;
        for (int e = gw * 64 + lane; e < 8 * 128 * 128 / 4; e += NGW * 64) { const int s0 = (e * 4) & 127, t = ((e * 4) >> 7) & 127; f32x4 w = *(const f32x4*)(wsrc + (size_t)e * 4);
#pragma unroll
            for (int j = 0; j < 4; ++j) if (s0 + j > t) w[j] = 0.f;
            store_bf4(wd + (size_t)e * 4, w); }
    } else if (L == 1) {
        for (int gg = 0; gg < 4; ++gg) convT(P.in[12] + gg * 65536, 256, 256, WMIX + gg * 65536, 256, MAP_ID, gw, NGW, lane);
    } else if (L == 2) {
        convT(P.in[14], 1024, 384, WMIX, 1024, MAP_ID, gw, NGW, lane);
        convT(P.in[17], 1024, 320, WMIX + 384 * 1024, 1024, MAP_ID, gw, NGW, lane);
        convT(P.in[16], 384, 1536, WMIX + 1 * MiB, 384, MAP_UQ, gw, NGW, lane);
        convT(P.in[19], 256, 1024, WMIX + 2 * MiB, 256, MAP_ID, gw, NGW, lane);
        convT(P.in[20], 256, 1024, WMIX + (5 * MiB) / 2, 256, MAP_ID, gw, NGW, lane);
        convT(P.in[21], 1024, 1024, WMIX + 3 * MiB, 1024, MAP_ID, gw, NGW, lane);
    } else {
        convT(P.in[30], 1024, 1024, WMIX, 1024, MAP_GLUA, gw, NGW, lane);
        convT(P.in[31], 1024, 1024, WMIX, 1024, MAP_GLUB, gw, NGW, lane);
    }
}

DI void lnv_phase(const Params& P, int gw, int NGW, int lane) {
    unsigned char* ws_ = P.ws; asm volatile("" : "+s"(ws_));
    asm volatile("" : "+v"(lane));
    bf16_t* V = (bf16_t*)(ws_ + O_AR + 32 * MiB);
    const float* gv = P.in[7]; const float* bv = P.in[8];
    for (int row = gw; row < S; row += NGW) {
        f32x4 x[4]; float s = 0.f;
#pragma unroll
        for (int j = 0; j < 4; ++j) { const u32x2 w = *(const u32x2*)(V + (size_t)row * 1024 + 4 * lane + 256 * j); x[j] = (f32x4){bflo(w.x), bfhi(w.x), bflo(w.y), bfhi(w.y)}; s += x[j][0] + x[j][1] + x[j][2] + x[j][3]; }
        const float mu = wave_sum(s, lane) * (1.f / 1024.f); float s2 = 0.f;
#pragma unroll
        for (int j = 0; j < 4; ++j) { x[j] = x[j] - mu; s2 += x[j][0] * x[j][0] + x[j][1] * x[j][1] + x[j][2] * x[j][2] + x[j][3] * x[j][3]; }
        const float rs = rsqrtf(wave_sum(s2, lane) * (1.f / 1024.f) + RMS_EPS);
#pragma unroll
        for (int j = 0; j < 4; ++j) { const int cb = 4 * lane + 256 * j; const f32x4 g4 = *(const f32x4*)(gv + cb), b4 = *(const f32x4*)(bv + cb); store_bf4(V + (size_t)row * 1024 + cb, x[j] * rs * g4 + b4); }
    }
}

DI void gate_phase(const Params& P, LAS unsigned char* lds, int tid, int wid, int lane, int bid) {
    unsigned char* ws_ = P.ws; asm volatile("" : "+s"(ws_));
    asm volatile("" : "+v"(tid)); lane = tid & 63; wid = __builtin_amdgcn_readfirstlane(tid >> 6);
    LAS bf16_t* Wt = (LAS bf16_t*)lds;
    LAS bf16_t* Vt = Wt + 128 * 136;
    const bf16_t* Wsb = (const bf16_t*)(ws_ + O_WMIX + 6 * MiB);
    const bf16_t* U = (const bf16_t*)(ws_ + O_AR);
    const bf16_t* V = (const bf16_t*)(ws_ + O_AR + 32 * MiB);
    bf16_t* Y = (bf16_t*)(ws_ + O_AR + 64 * MiB);
    const float* bs = P.in[10];
    const int r16 = lane & 15, quad = lane >> 4;
    for (int item = bid; item < 1024; item += gridDim.x) {
        const int hd = item & 7, c = item >> 3;
        __syncthreads();
#pragma unroll
        for (int i = 0; i < 4; ++i) { const int cid = tid + 512 * i, t = cid >> 4, sc = cid & 15;
            const u32x4 w = *(const u32x4*)(Wsb + ((size_t)(hd * 128 + t)) * 128 + 8 * sc); *(LAS u32x4*)(Wt + t * 136 + 8 * sc) = w; }
#pragma unroll
        for (int i = 0; i < 4; ++i) { const int cid = tid + 512 * i, s = cid >> 4, dc = cid & 15;
            const u32x4 w = *(const u32x4*)(V + ((size_t)(c * 128 + s)) * 1024 + hd * 128 + 8 * dc);
#pragma unroll
            for (int e = 0; e < 8; ++e) Vt[(8 * dc + e) * 136 + s] = (bf16_t)((e & 1) ? (w[e >> 1] >> 16) : (w[e >> 1] & 0xffffu)); }
        __syncthreads();
        const int t = 16 * wid + r16;
        const int nks = (16 * wid + 15) / 32 + 1;
        bf16x8 bw[4];
#pragma unroll
        for (int ks = 0; ks < 4; ++ks) bw[ks] = *(const LAS bf16x8*)(Wt + t * 136 + 32 * ks + 8 * quad);
        const int token = c * 128 + t;
        const float bias = bs[hd * 128 + t];
#pragma unroll
        for (int dt = 0; dt < 8; ++dt) {
            f32x4 acc = {0.f, 0.f, 0.f, 0.f};
#pragma unroll
            for (int ks = 0; ks < 4; ++ks) if (ks < nks) {
                const bf16x8 a = *(const LAS bf16x8*)(Vt + (16 * dt + r16) * 136 + 32 * ks + 8 * quad);
                acc = __builtin_amdgcn_mfma_f32_16x16x32_bf16(a, bw[ks], acc, 0, 0, 0); }
            const int col = hd * 128 + 16 * dt + 4 * quad;
            const u32x2 uu = *(const u32x2*)(U + (size_t)token * 1024 + col);
            f32x4 y; y[0] = (acc[0] + bias) * bflo(uu.x); y[1] = (acc[1] + bias) * bfhi(uu.x); y[2] = (acc[2] + bias) * bflo(uu.y); y[3] = (acc[3] + bias) * bfhi(uu.y);
            store_bf4(Y + (size_t)token * 1024 + col, y);
        }
    }
}

DI void pool_phase(const Params& P, int gtid, int nthreads) {
    unsigned char* ws_ = P.ws; asm volatile("" : "+s"(ws_));
    asm volatile("" : "+v"(gtid));
    const float* ZF = (const float*)(ws_ + O_AR);
    bf16_t* Pb = (bf16_t*)(ws_ + O_AR + 64 * MiB);
    for (int e = gtid; e < 1024 * 256; e += nthreads) {
        const int cgi = e & 255, tb = e >> 8, col = 4 * cgi, w = 2 << (cgi >> 6), t0 = 16 * tb;
        f32x4 W = {0.f, 0.f, 0.f, 0.f};
        for (int j = 1; j < w; ++j) if (t0 - j >= 0) W += *(const f32x4*)(ZF + (size_t)(t0 - j) * 1024 + col);
        for (int i = 0; i < 16; ++i) { const int t = t0 + i; const f32x4 z = *(const f32x4*)(ZF + (size_t)t * 1024 + col); W += z;
            const float cnt = (float)((t + 1 < w) ? (t + 1) : w); const f32x4 o = W / cnt - z; store_bf4(Pb + (size_t)t * 1024 + col, o);
            if (t - w + 1 >= 0) W -= *(const f32x4*)(ZF + (size_t)(t - w + 1) * 1024 + col); }
    }
}

DI void mla_rows(const Params& P, int gw, int NGW, int lane) {
    unsigned char* ws_ = P.ws; asm volatile("" : "+s"(ws_));
    asm volatile("" : "+v"(lane));
    unsigned char* ar = ws_ + O_AR;
    const bf16_t* LAT = (const bf16_t*)ar; bf16_t* QL = (bf16_t*)(ar + 24 * MiB); bf16_t* Cb = (bf16_t*)(ar + 36 * MiB); bf16_t* KR = (bf16_t*)(ar + 44 * MiB);
    const float* CS = (const float*)(ws_ + O_CS); const float* gq = P.in[15]; const float* gkv = P.in[18];
    for (int row = gw; row < S; row += NGW) {
        const bf16_t* lat = LAT + (size_t)row * 768;
        float q[6]; float ss = 0.f;
#pragma unroll
        for (int i = 0; i < 3; ++i) { const unsigned w = *(const unsigned*)(lat + 2 * lane + 128 * i); q[2 * i] = bflo(w); q[2 * i + 1] = bfhi(w); ss += q[2 * i] * q[2 * i] + q[2 * i + 1] * q[2 * i + 1]; }
        ss = wave_sum(ss, lane); const float rq = rsqrtf(ss * (1.f / 384.f) + RMS_EPS);
#pragma unroll
        for (int i = 0; i < 3; ++i) { const f32x2 g2 = *(const f32x2*)(gq + 2 * lane + 128 * i); *(unsigned*)(QL + (size_t)row * 384 + 2 * lane + 128 * i) = pk_bf16(q[2 * i] * rq * g2.x, q[2 * i + 1] * rq * g2.y); }
        float cc[4]; float s2 = 0.f;
#pragma unroll
        for (int i = 0; i < 2; ++i) { const unsigned w = *(const unsigned*)(lat + 384 + 2 * lane + 128 * i); cc[2 * i] = bflo(w); cc[2 * i + 1] = bfhi(w); s2 += cc[2 * i] * cc[2 * i] + cc[2 * i + 1] * cc[2 * i + 1]; }
        s2 = wave_sum(s2, lane); const float rc = rsqrtf(s2 * (1.f / 256.f) + RMS_EPS);
#pragma unroll
        for (int i = 0; i < 2; ++i) { const f32x2 g2 = *(const f32x2*)(gkv + 2 * lane + 128 * i); *(unsigned*)(Cb + (size_t)row * 256 + 2 * lane + 128 * i) = pk_bf16(cc[2 * i] * rc * g2.x, cc[2 * i + 1] * rc * g2.y); }
        if (lane < 32) { const float x1 = bf2f(lat[640 + lane]), x2 = bf2f(lat[672 + lane]); const f32x2 cs = *(const f32x2*)(CS + ((size_t)row * 32 + lane) * 2);
            *(unsigned*)(KR + (size_t)row * 64 + 2 * lane) = pk_bf16(x1 * cs.x - x2 * cs.y, x1 * cs.y + x2 * cs.x); }
    }
}

#define MFMA32(a, b, c) __builtin_amdgcn_mfma_f32_32x32x16_bf16((a), (b), (c), 0, 0, 0)
DI int crow(int reg, int h) { return (reg & 3) + 8 * (reg >> 2) + 4 * h; }

DI void attn_phase(const Params& P, LAS unsigned char* lds, int tid, int wid, int lane, int bid) {
    unsigned char* ws_ = P.ws; asm volatile("" : "+s"(ws_));
    asm volatile("" : "+v"(tid)); lane = tid & 63; wid = __builtin_amdgcn_readfirstlane(tid >> 6);
    unsigned char* ar = ws_ + O_AR;
    const bf16_t* Q = (const bf16_t*)(ar + 48 * MiB); const bf16_t* KN = (const bf16_t*)(ar + 96 * MiB); const bf16_t* VT = (const bf16_t*)(ar + 128 * MiB); const bf16_t* KR = (const bf16_t*)(ar + 44 * MiB);
    bf16_t* AO = (bf16_t*)(ws_ + O_XN);
    const int l32 = lane & 31, h2 = lane >> 5;
    constexpr int BUFB = 43008, VOFF = 25600;
    const unsigned kn_off0 = (unsigned)(((tid >> 4) * 1024 + 8 * (tid & 15)) * 2);
    const unsigned kr_off = (unsigned)(((tid >> 3) * 64 + 8 * (tid & 7)) * 2);
    const unsigned vt_off0 = (unsigned)(((tid >> 3) * 16384 + 8 * (tid & 7)) * 2);
    const unsigned kn_l0 = (unsigned)((tid >> 4) * 400 + 16 * (tid & 15));
    const unsigned kr_l = (unsigned)((tid >> 3) * 400 + 256 + 16 * (tid & 7));
    const unsigned vt_l0 = (unsigned)(25600 + (tid >> 3) * 136 + 16 * (tid & 7));
    for (int item = bid; item < 256; item += gridDim.x) {
        const int head = item & 7, pair = item >> 3;
        for (int half = 0; half < 2; ++half) {
            const int qb = half ? 63 - pair : pair;
            const int wrow0 = qb * 256 + wid * 32, qrow = wrow0 + l32;
            bf16x8 Qf[12];
#pragma unroll
            for (int s = 0; s < 12; ++s) Qf[s] = *(const bf16x8*)(Q + (size_t)qrow * 1536 + head * 192 + 16 * s + 8 * h2);
            f32x16 o[4];
#pragma unroll
            for (int d = 0; d < 4; ++d)
#pragma unroll
                for (int r = 0; r < 16; ++r) o[d][r] = 0.f;
            float mrun = -INFINITY, lsum = 0.f;
            const int ntiles = 4 * (qb + 1);
            u32x4 kreg[3], vreg[2];
#define ATT_ISSUE(kt) do { \
    unsigned o0_ = kn_off0, o1_ = kr_off, o2_ = vt_off0; asm volatile("" : "+v"(o0_), "+v"(o1_), "+v"(o2_)); \
    const char* knb = (const char*)(KN + (size_t)(kt) * 65536 + head * 128); const char* krb = (const char*)(KR + (size_t)(kt) * 4096); \
    const char* vtb = (const char*)(VT + (size_t)head * 128 * 16384 + 64 * (kt)); \
    kreg[0] = *(const u32x4*)(knb + o0_); kreg[1] = *(const u32x4*)(knb + 65536 + o0_); kreg[2] = *(const u32x4*)(krb + o1_); \
    vreg[0] = *(const u32x4*)(vtb + o2_); vreg[1] = *(const u32x4*)(vtb + 2097152 + o2_); } while (0)
#define ATT_WRITE(b) do { LAS unsigned char* base = lds + (b) * BUFB; \
    *(LAS u32x4*)(base + kn_l0) = kreg[0]; *(LAS u32x4*)(base + kn_l0 + 12800) = kreg[1]; *(LAS u32x4*)(base + kr_l) = kreg[2]; \
    *(LAS u32x2*)(base + vt_l0) = (u32x2){vreg[0].x, vreg[0].y}; *(LAS u32x2*)(base + vt_l0 + 8) = (u32x2){vreg[0].z, vreg[0].w}; \
    *(LAS u32x2*)(base + vt_l0 + 8704) = (u32x2){vreg[1].x, vreg[1].y}; *(LAS u32x2*)(base + vt_l0 + 8712) = (u32x2){vreg[1].z, vreg[1].w}; } while (0)
            ATT_ISSUE(0); ATT_WRITE(0); __syncthreads();
            for (int kt = 0; kt < ntiles; ++kt) {
                const bool more = (kt + 1 < ntiles);
                if (more) ATT_ISSUE(kt + 1);
                if (64 * kt <= wrow0 + 31) {
                    LAS unsigned char* base = lds + (kt & 1) * BUFB;
                    f32x16 st0, st1;
#pragma unroll
                    for (int r = 0; r < 16; ++r) { st0[r] = 0.f; st1[r] = 0.f; }
                    {
                        const LAS unsigned char* kp = base + l32 * 400 + 16 * h2;
                        bf16x8 ka[2][4];
#define ATT_LDK(bf, gq) do { _Pragma("unroll") for (int sl = 0; sl < 2; ++sl) { ka[bf][2 * sl] = *(const LAS bf16x8*)(kp + 32 * (2 * (gq) + sl)); ka[bf][2 * sl + 1] = *(const LAS bf16x8*)(kp + 12800 + 32 * (2 * (gq) + sl)); } } while (0)
#define ATT_MMK(bf, gq) do { _Pragma("unroll") for (int sl = 0; sl < 2; ++sl) { st0 = MFMA32(ka[bf][2 * sl], Qf[2 * (gq) + sl], st0); st1 = MFMA32(ka[bf][2 * sl + 1], Qf[2 * (gq) + sl], st1); } } while (0)
                        ATT_LDK(0, 0); __builtin_amdgcn_sched_barrier(0);
                        ATT_LDK(1, 1); __builtin_amdgcn_sched_barrier(0);
                        ATT_MMK(0, 0); __builtin_amdgcn_sched_barrier(0);
                        ATT_LDK(0, 2); __builtin_amdgcn_sched_barrier(0);
                        ATT_MMK(1, 1); __builtin_amdgcn_sched_barrier(0);
                        ATT_LDK(1, 3); __builtin_amdgcn_sched_barrier(0);
                        ATT_MMK(0, 2); __builtin_amdgcn_sched_barrier(0);
                        ATT_LDK(0, 4); __builtin_amdgcn_sched_barrier(0);
                        ATT_MMK(1, 3); __builtin_amdgcn_sched_barrier(0);
                        ATT_LDK(1, 5); __builtin_amdgcn_sched_barrier(0);
                        ATT_MMK(0, 4); __builtin_amdgcn_sched_barrier(0);
                        ATT_MMK(1, 5); __builtin_amdgcn_sched_barrier(0);
#undef ATT_LDK
#undef ATT_MMK
                    }
                    if (64 * kt + 63 > wrow0) {
#pragma unroll
                        for (int r = 0; r < 16; ++r) { const int key0 = 64 * kt + crow(r, h2); if (key0 > qrow) st0[r] = -INFINITY; if (key0 + 32 > qrow) st1[r] = -INFINITY; }
                    }
                    float mx = st0[0];
#pragma unroll
                    for (int r = 1; r < 16; ++r) mx = fmaxf(mx, st0[r]);
#pragma unroll
                    for (int r = 0; r < 16; ++r) mx = fmaxf(mx, st1[r]);
                    mx = fmaxf(mx, shx(mx, 32, lane));
                    const float mn = fmaxf(mrun, mx);
                    const float alpha = __builtin_amdgcn_exp2f(mrun - mn);
                    mrun = mn;
                    float psum = 0.f;
#pragma unroll
                    for (int r = 0; r < 16; ++r) { st0[r] = __builtin_amdgcn_exp2f(st0[r] - mn); st1[r] = __builtin_amdgcn_exp2f(st1[r] - mn); psum += st0[r] + st1[r]; }
                    lsum = lsum * alpha + psum;
#pragma unroll
                    for (int d = 0; d < 4; ++d)
#pragma unroll
                        for (int r = 0; r < 16; ++r) o[d][r] *= alpha;
                    {
                        const LAS unsigned char* vb = base + VOFF + l32 * 136 + 8 * h2;
                        u32x4 va[2][4];
#define ATT_LDV(bf, stp) do { _Pragma("unroll") for (int d = 0; d < 4; ++d) { const LAS unsigned char* vp = vb + d * 4352 + 32 * (stp); \
        const u32x2 lo = *(const LAS u32x2*)vp, hi = *(const LAS u32x2*)(vp + 16); va[bf][d] = (u32x4){lo.x, lo.y, hi.x, hi.y}; } } while (0)
#define ATT_MMV(bf, stv, sp) do { u32x4 pw; pw.x = pk_bf16(stv[8 * (sp)], stv[8 * (sp) + 1]); pw.y = pk_bf16(stv[8 * (sp) + 2], stv[8 * (sp) + 3]); pw.z = pk_bf16(stv[8 * (sp) + 4], stv[8 * (sp) + 5]); pw.w = pk_bf16(stv[8 * (sp) + 6], stv[8 * (sp) + 7]); \
        const bf16x8 pf = __builtin_bit_cast(bf16x8, pw); _Pragma("unroll") for (int d = 0; d < 4; ++d) o[d] = MFMA32(__builtin_bit_cast(bf16x8, va[bf][d]), pf, o[d]); } while (0)
                        ATT_LDV(0, 0); __builtin_amdgcn_sched_barrier(0);
                        ATT_LDV(1, 1); __builtin_amdgcn_sched_barrier(0);
                        ATT_MMV(0, st0, 0); __builtin_amdgcn_sched_barrier(0);
                        ATT_LDV(0, 2); __builtin_amdgcn_sched_barrier(0);
                        ATT_MMV(1, st0, 1); __builtin_amdgcn_sched_barrier(0);
                        ATT_LDV(1, 3); __builtin_amdgcn_sched_barrier(0);
                        ATT_MMV(0, st1, 0); __builtin_amdgcn_sched_barrier(0);
                        ATT_MMV(1, st1, 1); __builtin_amdgcn_sched_barrier(0);
#undef ATT_LDV
#undef ATT_MMV
                    }
                }
                if (more) ATT_WRITE((kt + 1) & 1);
                __syncthreads();
            }
            int t2_ = tid; asm volatile("" : "+v"(t2_));
            const int qrow2 = qb * 256 + (t2_ >> 6) * 32 + (t2_ & 31), h2b = (t2_ >> 5) & 1;
            const float ltot = lsum + shx(lsum, 32, lane);
            const float inv = 1.f / ltot;
#pragma unroll
            for (int d = 0; d < 4; ++d)
#pragma unroll
                for (int rg = 0; rg < 4; ++rg) { f32x4 v = {o[d][4 * rg] * inv, o[d][4 * rg + 1] * inv, o[d][4 * rg + 2] * inv, o[d][4 * rg + 3] * inv};
                    store_bf4(AO + (size_t)qrow2 * 1024 + head * 128 + d * 32 + 8 * rg + 4 * h2b, v); }
        }
    }
#undef ATT_ISSUE
#undef ATT_WRITE
}

DI void s5_precompute(const Params& P, LAS unsigned char* lds, int tid, int bid) {
    unsigned char* ws_ = P.ws; asm volatile("" : "+s"(ws_));
    asm volatile("" : "+v"(tid));
    LAS float* PWr = (LAS float*)lds;
    LAS float* PWi = PWr + 33 * 64;
    LAS float* BBr = PWi + 33 * 64;
    LAS float* BBi = BBr + 1024;
    LAS float* CRe = BBi + 1024;
    LAS float* CIm = CRe + 1024;
    LAS float* KT = CIm + 1024;
    const float* lam_re = P.in[22]; const float* lam_im = P.in[23]; const float* log_dt = P.in[24];
    const float* b_re = P.in[25]; const float* b_im = P.in[26]; const float* c_re = P.in[27]; const float* c_im = P.in[28]; const float* dsk = P.in[29];
    bf16_t* TF = (bf16_t*)(ws_ + O_AR + 40 * MiB); bf16_t* Eb = (bf16_t*)(ws_ + O_AR + 80 * MiB);
    for (int item = bid; item < 256; item += gridDim.x) {
        const int g = item >> 2, q = item & 3;
        __syncthreads();
        const float dt = expf(log_dt[g]);
        for (int e = tid; e < 33 * 64; e += 512) { const int j = e >> 6, p = e & 63; const float lr = lam_re[g * 64 + p], li = lam_im[g * 64 + p];
            const float mag = expf((float)j * (lr * dt)); float sn, cs; sincosf((float)j * (li * dt), &sn, &cs); PWr[e] = mag * cs; PWi[e] = mag * sn; }
        for (int e = tid; e < 1024; e += 512) { const int p = e >> 4; const float lr = lam_re[g * 64 + p], li = lam_im[g * 64 + p];
            const float mag = expf(lr * dt); float sn, cs; sincosf(li * dt, &sn, &cs); const float ar = mag * cs, ai = mag * sn;
            const float den = lr * lr + li * li; const float fre = ((ar - 1.f) * lr + ai * li) / den, fim = (ai * lr - (ar - 1.f) * li) / den;
            const float br = b_re[(size_t)g * 1024 + e], bi = b_im[(size_t)g * 1024 + e];
            BBr[e] = fre * br - fim * bi; BBi[e] = fre * bi + fim * br; }
        for (int e = tid; e < 1024; e += 512) { CRe[e] = c_re[(size_t)g * 1024 + e]; CIm[e] = c_im[(size_t)g * 1024 + e]; }
        __syncthreads();
        for (int e = tid; e < 8192; e += 512) { const int j = e >> 8, co = (e >> 4) & 15, ci = e & 15; float a = 0.f;
            for (int p = 0; p < 64; ++p) { const float cr = CRe[co * 64 + p], cm = CIm[co * 64 + p], pr = PWr[j * 64 + p], pi = PWi[j * 64 + p];
                const float wr_ = cr * pr - cm * pi, wi_ = cr * pi + cm * pr; a += wr_ * BBr[p * 16 + ci] - wi_ * BBi[p * 16 + ci]; }
            if (j == 0 && co == ci) a += dsk[g * 16 + co];
            KT[e] = a; }
        __syncthreads();
        for (int e = tid; e < 128 * 80; e += 512) { const int rr = e / 80, kc = e - rr * 80, n = 128 * q + rr, l = n >> 4, co = n & 15; float v[8];
            if (kc < 64) { const int lp = kc >> 1;
#pragma unroll
                for (int i = 0; i < 8; ++i) v[i] = (lp <= l) ? KT[((l - lp) * 16 + co) * 16 + 8 * (kc & 1) + i] : 0.f;
            } else {
                const bool im = kc >= 72; const int p0 = 8 * (kc - (im ? 72 : 64));
#pragma unroll
                for (int i = 0; i < 8; ++i) { const int p = p0 + i; const float cr = CRe[co * 64 + p], cm = CIm[co * 64 + p], pr = PWr[(l + 1) * 64 + p], pi = PWi[(l + 1) * 64 + p];
                    v[i] = im ? -(cr * pi + cm * pr) : (cr * pr - cm * pi); }
            }
            u32x4 o; o.x = pk_bf16(v[0], v[1]); o.y = pk_bf16(v[2], v[3]); o.z = pk_bf16(v[4], v[5]); o.w = pk_bf16(v[6], v[7]);
            *(u32x4*)(TF + ((size_t)(g * 512 + n)) * 640 + 8 * kc) = o; }
        for (int e = tid; e < 32 * 64; e += 512) { const int n = 32 * q + (e >> 6), kc = e & 63, p = n & 63, im = n >> 6, lp = kc >> 1; float v[8];
            const float pr = PWr[(31 - lp) * 64 + p], pi = PWi[(31 - lp) * 64 + p];
#pragma unroll
            for (int i = 0; i < 8; ++i) { const int ci = 8 * (kc & 1) + i; const float br = BBr[p * 16 + ci], bi = BBi[p * 16 + ci]; v[i] = im ? (pr * bi + pi * br) : (pr * br - pi * bi); }
            u32x4 o; o.x = pk_bf16(v[0], v[1]); o.y = pk_bf16(v[2], v[3]); o.z = pk_bf16(v[4], v[5]); o.w = pk_bf16(v[6], v[7]);
            *(u32x4*)(Eb + ((size_t)(g * 256 + n)) * 512 + 8 * kc) = o; }
    }
}

DI void s5_scan(const Params& P, int wid, int lane, int bid) {
    unsigned char* ws_ = P.ws; asm volatile("" : "+s"(ws_));
    asm volatile("" : "+v"(lane));
    if (wid != 0) return;
    const float* lam_re = P.in[22]; const float* lam_im = P.in[23]; const float* log_dt = P.in[24];
    const float* XE = (const float*)(ws_ + O_AR + 96 * MiB); bf16_t* UG = (bf16_t*)(ws_ + O_AR);
    for (int g = bid; g < 64; g += gridDim.x) {
        const int p = lane; const float dt = expf(log_dt[g]); const float lr = lam_re[g * 64 + p], li = lam_im[g * 64 + p];
        const float mag = expf(32.f * (lr * dt)); float sn, cs; sincosf(32.f * (li * dt), &sn, &cs); const float ar = mag * cs, ai = mag * sn;
        float cr = 0.f, ci = 0.f;
        const float* xe = XE + (size_t)g * 512 * 128; bf16_t* ug = UG + (size_t)g * 512 * 640;
        for (int c0 = 0; c0 < 512; c0 += 16) {
            float xr[16], xi[16];
#pragma unroll
            for (int i = 0; i < 16; ++i) { xr[i] = xe[(size_t)(c0 + i) * 128 + p]; xi[i] = xe[(size_t)(c0 + i) * 128 + 64 + p]; }
#pragma unroll
            for (int i = 0; i < 16; ++i) { ug[(size_t)(c0 + i) * 640 + 512 + p] = f2bf(cr); ug[(size_t)(c0 + i) * 640 + 576 + p] = f2bf(ci);
                const float nr = ar * cr - ai * ci + xr[i], ni = ar * ci + ai * cr + xi[i]; cr = nr; ci = ni; }
        }
    }
}

DI void cs_table(const Params& P, int gtid, int nthreads) {
    unsigned char* ws_ = P.ws; asm volatile("" : "+s"(ws_));
    asm volatile("" : "+v"(gtid));
    const int* pos = (const int*)P.in[1]; float* CS = (float*)(ws_ + O_CS);
    for (int e = gtid; e < S * 32; e += nthreads) { const int row = e >> 5, j = e & 31;
        const float invf = exp2f(-(float)j * (13.287712379549449f / 32.f)); const float ang = (float)pos[row] * invf; float sn, cs; sincosf(ang, &sn, &cs);
        *(f32x2*)(CS + (size_t)e * 2) = (f32x2){cs, sn}; }
}

__global__ void __launch_bounds__(512, 2) __attribute__((amdgpu_waves_per_eu(2, 2))) mega_fwd(Params P) {
    extern __shared__ __attribute__((aligned(16))) unsigned char smem[];
    LAS unsigned char* lds = (LAS unsigned char*)smem;
    cg::grid_group grid = cg::this_grid();
    const int G = gridDim.x, nthreads = G * 512, NGW = G * 8;
#pragma nounroll
    for (int st = 0; st < NSTEPS; ++st) {
        int tid = threadIdx.x; asm volatile("" : "+v"(tid));
        int bid = blockIdx.x; asm volatile("" : "+s"(bid));
        unsigned char* ws = P.ws; asm volatile("" : "+s"(ws));
        float* outp_ = P.out; asm volatile("" : "+s"(outp_));
        const float* ng = P.in[2];
        bf16_t* XN = (bf16_t*)(ws + O_XN); const bf16_t* Zb = (const bf16_t*)(ws + O_Z);
        GemmDesc g;
        if (get_gemm(P, st, g)) gemm_phase(lds, P, g, G, bid, tid);
        else switch (st) {
        case 0: conv_layer(P, 0, GW_, NGW, LANE_); cs_table(P, GTID_, nthreads);
                row_pass<RP_BF>(P.in[0], outp_, nullptr, nullptr, ng, XN, GW_, NGW, LANE_); break;
        case 2: lnv_phase(P, GW_, NGW, LANE_); break;
        case 3: gate_phase(P, lds, tid, WID_, LANE_, bid); break;
        case 5: case 11: case 14: case 22: case 30: {
            const int L = (st == 5) ? 0 : (st <= 14 ? 1 : (st == 22 ? 2 : 3)); const bool mlp = (st == 14);
            const float* hin = (st == 5) ? P.in[0] : outp_;
            const float* gpost = ng + (L * 4 + (mlp ? 3 : 1)) * 1024; const float* gpre = mlp ? ng + ((L + 1) * 4) * 1024 : ng + (L * 4 + 2) * 1024;
            row_pass<RP_BF>(hin, outp_, Zb, gpost, gpre, XN, GW_, NGW, LANE_);
            if (mlp) conv_layer(P, L + 1, GW_, NGW, LANE_);
        } break;
        case 8: row_pass<RP_F32>(outp_, outp_, Zb, ng + 3 * 1024, ng + 4 * 1024, ws + O_AR, GW_, NGW, LANE_); conv_layer(P, 1, GW_, NGW, LANE_); break;
        case 9: pool_phase(P, GTID_, nthreads); break;
        case 16: mla_rows(P, GW_, NGW, LANE_); break;
        case 20: attn_phase(P, lds, tid, WID_, LANE_, bid); break;
        case 25: row_pass<RP_S5>(outp_, outp_, Zb, ng + 11 * 1024, ng + 12 * 1024, ws + O_AR, GW_, NGW, LANE_); conv_layer(P, 3, GW_, NGW, LANE_); s5_precompute(P, lds, tid, bid); break;
        case 27: s5_scan(P, WID_, LANE_, bid); break;
        case 33: row_pass<RP_FINAL>(outp_, outp_, Zb, ng + 15 * 1024, nullptr, nullptr, GW_, NGW, LANE_); break;
        default: break;
        }
        if (st != 17 && st != 18 && st != NSTEPS - 1) grid.sync();
    }
}
}

extern "C" void kernel_launch(void* const* d_in, const int* in_sizes, int n_in, void* d_out, int out_size, void* d_ws, size_t ws_size, hipStream_t stream) {
    static int grid = 0;
    if (grid == 0) {
        int dev = 0, cus = 0, per_cu = 0;
        hipGetDevice(&dev);
        hipDeviceGetAttribute(&cus, hipDeviceAttributeMultiprocessorCount, dev);
        hipFuncSetAttribute((const void*)mega_fwd, hipFuncAttributeMaxDynamicSharedMemorySize, LDS_BYTES);
        if (hipOccupancyMaxActiveBlocksPerMultiprocessor(&per_cu, (const void*)mega_fwd, 512, LDS_BYTES) != hipSuccess || per_cu < 1) per_cu = 1;
        (void)hipGetLastError();
        grid = cus * per_cu;
        if (grid <= 0) grid = 256;
    }
    Params p{};
    for (int i = 0; i < 32 && i < n_in; ++i) p.in[i] = (const float*)d_in[i];
    p.out = (float*)d_out; p.ws = (unsigned char*)d_ws;
    void* args[] = {&p};
    hipError_t e = hipLaunchCooperativeKernel((const void*)mega_fwd, dim3(grid), dim3(512), args, LDS_BYTES, stream);
    if (e != hipSuccess) fprintf(stderr, "cooperative launch failed: %s (grid %d)\n", hipGetErrorString(e), grid);
}
```

```cpp
#include <hip/hip_runtime.h>
#include <hip/hip_cooperative_groups.h>
#include <cstdio>
namespace cg = cooperative_groups;

#define DI __device__ __forceinline__
#define LAS __attribute__((address_space(3)))
typedef unsigned short bf16_t;
typedef short bf16x8 __attribute__((ext_vector_type(8)));
typedef float f32x2 __attribute__((ext_vector_type(2)));
typedef float f32x4 __attribute__((ext_vector_type(4)));
typedef float f32x16 __attribute__((ext_vector_type(16)));
typedef unsigned u32x2 __attribute__((ext_vector_type(2)));
typedef unsigned u32x4 __attribute__((ext_vector_type(4)));
typedef __bf16 bf16v2 __attribute__((ext_vector_type(2)));

#define LANE_ (tid & 63)
#define WID_ (__builtin_amdgcn_readfirstlane(tid >> 6))
#define GW_ (bid * 8 + WID_)
#define GTID_ (bid * 512 + tid)
#ifndef PROBE_REP
#define PROBE_REP(st) 1
#endif
#ifndef PROBE_SYNC
#define PROBE_SYNC 0
#endif
#define IS_GEMM_STEP(st) ((st)==1||(st)==4||(st)==6||(st)==7||(st)==10||(st)==12||(st)==13||(st)==15||(st)==17||(st)==18||(st)==19||(st)==21||(st)==23||(st)==24||(st)==26||(st)==28||(st)==29||(st)==31||(st)==32)
#define IS_MLP_STEP(st) ((st)==6||(st)==7||(st)==12||(st)==13||(st)==23||(st)==24||(st)==31||(st)==32)
namespace {
constexpr int S = 16384;
constexpr size_t MiB = (size_t)1 << 20;
constexpr size_t O_CS = 0, O_WUP = 4 * MiB, O_WDN = 12 * MiB, O_WMIX = 20 * MiB, O_XN = 28 * MiB, O_Z = 60 * MiB, O_AR = 92 * MiB;
constexpr int LDS_BYTES = 131072;
constexpr size_t O_BAR = 254 * MiB;
constexpr int NSTEPS = 34;
constexpr float RMS_EPS = 1e-6f;
constexpr float QSCALE = 0.07216878364870322f * 1.4426950408889634f;

enum { E_Z = 0, E_HID, E_UV, E_POOL, E_LAT, E_Q, E_KN, E_VT, E_XE, E_S5Y, E_GLU };

struct Params { const float* in[32]; float* out; unsigned char* ws; };

DI unsigned pk_bf16(float a, float b) { f32x2 f = {a, b}; bf16v2 h = __builtin_convertvector(f, bf16v2); return __builtin_bit_cast(unsigned, h); }
DI bf16_t f2bf(float x) { return (bf16_t)(pk_bf16(x, 0.f) & 0xffffu); }
DI float bf2f(bf16_t b) { return __uint_as_float(((unsigned)b) << 16); }
DI float bflo(unsigned u) { return __uint_as_float(u << 16); }
DI float bfhi(unsigned u) { return __uint_as_float(u & 0xffff0000u); }
DI float shx(float v, int o, int lane) { return __int_as_float(__builtin_amdgcn_ds_bpermute((lane ^ o) << 2, __float_as_int(v))); }
DI float wave_sum(float v, int lane) {
#pragma unroll
    for (int o = 1; o < 64; o <<= 1) v += shx(v, o, lane);
    return v;
}
DI void store_bf4(bf16_t* p, f32x4 v) { u32x2 w; w.x = pk_bf16(v[0], v[1]); w.y = pk_bf16(v[2], v[3]); *(u32x2*)p = w; }
DI float gelu_tanh(float x) {
    const float u = 0.7978845608028654f * (x + 0.044715f * x * x * x);
    const float e = __expf(-2.f * u);
    return x / (1.f + e);
}

constexpr int BM = 256, BK = 64, HALF = 128, HTB = HALF * BK * 2, NXCD = 8, WGM = 8;
DI int lds_byte(int r, int c) { const int st = (r >> 4) * 2 + (c >> 5), rr = r & 15, cc = c & 31, ob = rr * 64 + cc * 2; return st * 1024 + (ob ^ (((ob >> 9) & 1) << 5)); }
DI void stage_rc(int b, int& R, int& C) { const int st = b / 1024, sb = b % 1024, swz = sb ^ (((sb >> 9) & 1) << 5); R = (st >> 1) * 16 + swz / 64; C = (st & 1) * 32 + (swz % 64) / 2; }

struct GemmDesc { const bf16_t* A; const bf16_t* Bt; long a_gs, b_gs; int K, lda, ldb, nM, nN, ngrp, mode; };
struct Unit { int pm, pn, grp; };

DI bool unit_next(const GemmDesc& g, int i, int G, int c, Unit& u) {
    const int nper = g.nM * g.nN;
    const long L = (long)i * G + c;
    const bool ok = L < (long)nper * g.ngrp;
    const int grp2 = (int)(L / nper), w = (int)(L - (long)grp2 * nper);
    const int nwg = nper, nM = g.nM, nN = g.nN;
    int wgid = w;
    { const int q = nwg / NXCD, r = nwg % NXCD, xcd = wgid % NXCD, off = wgid / NXCD; wgid = (xcd < r ? xcd * (q + 1) : r * (q + 1) + (xcd - r) * q) + off; }
    const int nig = WGM * nN, gid = wgid / nig, fm = gid * WGM, gsz = (nM - fm) < WGM ? (nM - fm) : WGM;
    const int gszc = gsz > 0 ? gsz : 1;
    const int pm1 = fm + ((wgid % nig) % gszc), pn1 = (wgid % nig) / gszc;
    const int pm2 = w % nM, pn2 = w / nM;
    const bool single = (g.ngrp == 1);
    Unit r; r.pm = single ? pm1 : pm2; r.pn = single ? pn1 : pn2; r.grp = single ? 0 : grp2;
    u = r;
    return ok;
}

#define EPI_LOOP(...) \
    _Pragma("unroll") for (int ai = 0; ai < 2; ++ai) _Pragma("unroll") for (int m = 0; m < 4; ++m) { const int row = row0 + ai * HALF + m * 16; \
        _Pragma("unroll") for (int bj = 0; bj < 2; ++bj) _Pragma("unroll") for (int n = 0; n < 2; ++n) { const int col = col0 + bj * HALF + n * 16; f32x4 v = acc[ai][bj][m][n]; __VA_ARGS__ } }

DI void epilogue(const Params& P, const GemmDesc& g, const f32x4 (&acc)[2][2][4][2], const Unit& u, int wr, int wc, int fr, int fq) {
    unsigned char* ws_ = P.ws; asm volatile("" : "+s"(ws_));
    unsigned char* ws = ws_;
    const int row0 = u.pm * BM + wr * 64 + fr, col0 = u.pn * BM + wc * 32 + 4 * fq;
    bf16_t* Zb = (bf16_t*)(ws + O_Z);
    bf16_t* AR = (bf16_t*)(ws + O_AR);
    switch (g.mode) {
    case E_Z: { EPI_LOOP( store_bf4(Zb + (size_t)row * 1024 + col, v); ) } break;
    case E_HID: { EPI_LOOP( _Pragma("unroll") for (int j = 0; j < 4; ++j) { const float t = fmaxf(v[j], 0.f); v[j] = t * t; } store_bf4(AR + (size_t)row * 4096 + col, v); ) } break;
    case E_UV: { const float* bin = P.in[6];
        EPI_LOOP( const f32x4 b = *(const f32x4*)(bin + col); _Pragma("unroll") for (int j = 0; j < 4; ++j) v[j] = gelu_tanh(v[j] + b[j]);
                  bf16_t* dst = (col < 1024) ? (AR + (size_t)row * 1024 + col) : (AR + 16 * MiB + (size_t)row * 1024 + (col - 1024)); store_bf4(dst, v); ) } break;
    case E_POOL: { const float* sc = P.in[13];
        EPI_LOOP( const int cgc = 256 * u.grp + col; const f32x4 s4 = *(const f32x4*)(sc + cgc); store_bf4(Zb + (size_t)row * 1024 + cgc, v * s4); ) } break;
    case E_LAT: { EPI_LOOP( store_bf4(AR + (size_t)row * 768 + col, v); ) } break;
    case E_Q: { const float* CS = (const float*)(ws + O_CS); bf16_t* Qb = AR + 24 * MiB;
        EPI_LOOP( const int w = col % 192;
                  if (w >= 128) { const int j = (w - 128) >> 1; const f32x4 cs = *(const f32x4*)(CS + ((size_t)row * 32 + j) * 2);
                      const float a0 = v[0] * cs[0] - v[1] * cs[1], a1 = v[0] * cs[1] + v[1] * cs[0], a2 = v[2] * cs[2] - v[3] * cs[3], a3 = v[2] * cs[3] + v[3] * cs[2];
                      v[0] = a0; v[1] = a1; v[2] = a2; v[3] = a3; }
                  store_bf4(Qb + (size_t)row * 1536 + col, v * QSCALE); ) } break;
    case E_KN: { bf16_t* KN = AR + 48 * MiB; EPI_LOOP( store_bf4(KN + (size_t)row * 1024 + col, v); ) } break;
    case E_VT: { bf16_t* VT = AR + 64 * MiB; EPI_LOOP( store_bf4(VT + (size_t)row * 16384 + col, v); ) } break;
    case E_XE: { float* XE = (float*)(ws + O_AR + 96 * MiB);
        EPI_LOOP( if (col < 128) *(f32x4*)(XE + ((size_t)(u.grp * 512 + row)) * 128 + col) = v; ) } break;
    case E_S5Y: { bf16_t* Y5 = AR + 56 * MiB;
        EPI_LOOP( const int l = col >> 4, c = col & 15; const int token = row * 32 + l; _Pragma("unroll") for (int j = 0; j < 4; ++j) v[j] = gelu_tanh(v[j]);
                  store_bf4(Y5 + (size_t)token * 1024 + u.grp * 16 + c, v); ) } break;
    case E_GLU: {
#pragma unroll
        for (int ai = 0; ai < 2; ++ai)
#pragma unroll
            for (int m = 0; m < 4; ++m) { const int row = row0 + ai * HALF + m * 16;
#pragma unroll
                for (int n = 0; n < 2; ++n) { const int oc = u.pn * 128 + wc * 32 + n * 16 + 4 * fq; const f32x4 a = acc[ai][0][m][n], b = acc[ai][1][m][n]; f32x4 v;
#pragma unroll
                    for (int j = 0; j < 4; ++j) v[j] = a[j] / (1.f + __expf(-b[j]));
                    store_bf4(Zb + (size_t)row * 1024 + oc, v); } }
    } break;
    default: break;
    }
}

DI void gemm_phase(LAS unsigned char* lds, const Params& P, const GemmDesc g, const int G, const int cidx, int tid) {
    asm volatile("" : "+v"(tid));
    const int wid = __builtin_amdgcn_readfirstlane(tid >> 6), lane = tid & 63, wr = wid >> 2, wc = wid & 3, fr = lane & 15, fq = lane >> 4;
    const int K = g.K, nt = K / BK;
    unsigned voffA[2], voffB[2];
#pragma unroll
    for (int i = 0; i < 2; ++i) { int R, C; stage_rc(tid * 16 + i * 8192, R, C); voffA[i] = (unsigned)(R * g.lda + C) * 2u; voffB[i] = (unsigned)(R * g.ldb + C) * 2u; }
    const size_t kstep = (size_t)(BK * 2);
    const size_t hstepA = (size_t)HALF * g.lda * 2, hstepB = (size_t)HALF * g.ldb * 2;
    const unsigned ldsw = (unsigned)wid * 1024u;
    const int aoff = lds_byte(wr * 64 + fr, fq * 8), boff = lds_byte(wc * 32 + fr, fq * 8);
#define PG8_SA(b, h) (((b) * 2 + (h)) * HTB)
#define PG8_SB(b, h) ((4 + (b) * 2 + (h)) * HTB)
#define PG8_STAGE(bufoff, gbase, voff) do { _Pragma("unroll") for (int _i = 0; _i < 2; ++_i) \
        __builtin_amdgcn_global_load_lds((const unsigned*)((const char*)(gbase) + (voff)[_i]), (LAS unsigned*)(lds + (bufoff) + ldsw + _i * 8192), 16, 0, 0); } while (0)
#define PG8_LDA(dst, b, h) do { _Pragma("unroll") for (int m = 0; m < 4; ++m) _Pragma("unroll") for (int k = 0; k < 2; ++k) dst[m][k] = *(const LAS bf16x8*)(lds + PG8_SA(b, h) + aoff + m * 2048 + k * 1024); } while (0)
#define PG8_LDB(dst, b, h) do { _Pragma("unroll") for (int n = 0; n < 2; ++n) _Pragma("unroll") for (int k = 0; k < 2; ++k) dst[n][k] = *(const LAS bf16x8*)(lds + PG8_SB(b, h) + boff + n * 2048 + k * 1024); } while (0)
#define PG8_MMA(ai, bj, At, Bt) do { __builtin_amdgcn_s_setprio(1); _Pragma("unroll") for (int m = 0; m < 4; ++m) _Pragma("unroll") for (int n = 0; n < 2; ++n) _Pragma("unroll") for (int k = 0; k < 2; ++k) \
        acc[ai][bj][m][n] = __builtin_amdgcn_mfma_f32_16x16x32_bf16(Bt[n][k], At[m][k], acc[ai][bj][m][n], 0, 0, 0); __builtin_amdgcn_s_setprio(0); } while (0)
#define PG8_WAIT_V(n) asm volatile("s_waitcnt vmcnt(" #n ")" ::: "memory")
#define PG8_WAIT_L(n) asm volatile("s_waitcnt lgkmcnt(" #n ")" ::: "memory")
#define PG8_BAR __builtin_amdgcn_s_barrier()
#define PG8_SCHED __builtin_amdgcn_sched_barrier(0)
    Unit cur, nxt; int ui = 0;
    if (!unit_next(g, 0, G, cidx, cur)) return;
    f32x4 acc[2][2][4][2];
#pragma unroll
    for (int a = 0; a < 2; ++a)
#pragma unroll
        for (int b = 0; b < 2; ++b)
#pragma unroll
            for (int m = 0; m < 4; ++m)
#pragma unroll
                for (int n = 0; n < 2; ++n) acc[a][b][m][n] = (f32x4){0.f, 0.f, 0.f, 0.f};
    bf16x8 At[4][2], B0[2][2], B1[2][2];
    const char* cA = (const char*)g.A + ((size_t)cur.grp * g.a_gs + (size_t)cur.pm * BM * g.lda) * 2;
    const char* cB = (const char*)g.Bt + ((size_t)cur.grp * g.b_gs + (size_t)cur.pn * BM * g.ldb) * 2;
    PG8_STAGE(PG8_SB(0, 0), cB, voffB); PG8_STAGE(PG8_SA(0, 0), cA, voffA); PG8_STAGE(PG8_SB(0, 1), cB + hstepB, voffB); PG8_STAGE(PG8_SA(0, 1), cA + hstepA, voffA);
    if (wr == 1) PG8_BAR;
    PG8_WAIT_V(4); PG8_BAR;
    PG8_STAGE(PG8_SB(1, 0), cB + kstep, voffB); PG8_STAGE(PG8_SA(1, 0), cA + kstep, voffA); PG8_STAGE(PG8_SB(1, 1), cB + hstepB + kstep, voffB);
    PG8_WAIT_V(6); PG8_BAR;
    for (;;) {
        const bool has_next = unit_next(g, ui + 1, G, cidx, nxt);
        const char* nA = has_next ? (const char*)g.A + ((size_t)nxt.grp * g.a_gs + (size_t)nxt.pm * BM * g.lda) * 2 : cA;
        const char* nB = has_next ? (const char*)g.Bt + ((size_t)nxt.grp * g.b_gs + (size_t)nxt.pn * BM * g.ldb) * 2 : cB;
        for (int t = 0; t < nt; t += 2) {
            const bool last = (t == nt - 2);
            const char* a1 = cA + (size_t)(t + 1) * kstep;
            const char* a2 = last ? nA : cA + (size_t)(t + 2) * kstep; const char* b2 = last ? nB : cB + (size_t)(t + 2) * kstep;
            const char* a3 = a2 + kstep; const char* b3 = b2 + kstep;
            PG8_LDB(B0, 0, 0); PG8_SCHED; PG8_LDA(At, 0, 0); PG8_STAGE(PG8_SA(1, 1), a1 + hstepA, voffA);
            PG8_WAIT_L(8); PG8_BAR; PG8_WAIT_L(0); PG8_MMA(0, 0, At, B0); PG8_BAR; PG8_SCHED;
            PG8_LDB(B1, 0, 1); PG8_STAGE(PG8_SB(0, 0), b2, voffB);
            PG8_BAR; PG8_WAIT_L(0); PG8_MMA(0, 1, At, B1); PG8_BAR;
            PG8_LDA(At, 0, 1); PG8_STAGE(PG8_SA(0, 0), a2, voffA);
            PG8_BAR; PG8_WAIT_L(0); PG8_MMA(1, 0, At, B0); PG8_BAR; PG8_SCHED;
            PG8_STAGE(PG8_SB(0, 1), b2 + hstepB, voffB);
            PG8_WAIT_V(6); PG8_BAR; PG8_MMA(1, 1, At, B1); PG8_BAR;
            PG8_LDB(B0, 1, 0); PG8_SCHED; PG8_LDA(At, 1, 0); PG8_STAGE(PG8_SA(0, 1), a2 + hstepA, voffA);
            PG8_WAIT_L(8); PG8_BAR; PG8_WAIT_L(0); PG8_MMA(0, 0, At, B0); PG8_BAR; PG8_SCHED;
            PG8_LDB(B1, 1, 1); PG8_STAGE(PG8_SB(1, 0), b3, voffB);
            PG8_BAR; PG8_WAIT_L(0); PG8_MMA(0, 1, At, B1); PG8_BAR;
            PG8_LDA(At, 1, 1); PG8_STAGE(PG8_SA(1, 0), a3, voffA);
            PG8_BAR; PG8_WAIT_L(0); PG8_MMA(1, 0, At, B0); PG8_BAR; PG8_SCHED;
            PG8_STAGE(PG8_SB(1, 1), b3 + hstepB, voffB);
            PG8_WAIT_V(6); PG8_BAR; PG8_MMA(1, 1, At, B1); PG8_BAR;
        }
        epilogue(P, g, acc, cur, wr, wc, fr, fq);
        if (!has_next) break;
#pragma unroll
        for (int a = 0; a < 2; ++a)
#pragma unroll
            for (int b = 0; b < 2; ++b)
#pragma unroll
                for (int m = 0; m < 4; ++m)
#pragma unroll
                    for (int n = 0; n < 2; ++n) acc[a][b][m][n] = (f32x4){0.f, 0.f, 0.f, 0.f};
        cur = nxt; cA = nA; cB = nB; ++ui;
    }
    PG8_WAIT_V(0);
    if (wr == 0) PG8_BAR;
    PG8_BAR;
}

DI bool get_gemm(const Params& P, int st, GemmDesc& g) {
    unsigned char* ws_ = P.ws; asm volatile("" : "+s"(ws_));
    unsigned char* ws = ws_;
    const bf16_t* XN = (const bf16_t*)(ws + O_XN);
    const bf16_t* WMIX = (const bf16_t*)(ws + O_WMIX);
    const bf16_t* AR = (const bf16_t*)(ws + O_AR);
    g.a_gs = 0; g.b_gs = 0; g.ngrp = 1; g.nM = 64; g.K = 1024; g.lda = 1024; g.ldb = 1024; g.A = XN; g.Bt = WMIX; g.nN = 4; g.mode = E_Z;
    switch (st) {
    case 1: g.nN = 8; g.mode = E_UV; return true;
    case 4: g.A = AR + 32 * MiB; g.Bt = WMIX + 2 * MiB; return true;
    case 6: case 12: case 23: case 31: g.Bt = (const bf16_t*)(ws + O_WUP); g.nN = 16; g.mode = E_HID; return true;
    case 7: case 13: case 24: case 32: g.A = AR; g.Bt = (const bf16_t*)(ws + O_WDN); g.K = 4096; g.lda = 4096; g.ldb = 4096; return true;
    case 10: g.A = AR + 32 * MiB; g.K = 256; g.ldb = 256; g.nN = 1; g.ngrp = 4; g.a_gs = 256; g.b_gs = 65536; g.mode = E_POOL; return true;
    case 15: g.nN = 3; g.mode = E_LAT; return true;
    case 17: g.A = AR + 12 * MiB; g.Bt = WMIX + 1 * MiB; g.K = 384; g.lda = 384; g.ldb = 384; g.nN = 6; g.mode = E_Q; return true;
    case 18: g.A = AR + 18 * MiB; g.Bt = WMIX + 2 * MiB; g.K = 256; g.lda = 256; g.ldb = 256; g.nN = 4; g.mode = E_KN; return true;
    case 19: g.A = WMIX + (5 * MiB) / 2; g.Bt = AR + 18 * MiB; g.K = 256; g.lda = 256; g.ldb = 256; g.nM = 4; g.nN = 64; g.mode = E_VT; return true;
    case 21: g.Bt = WMIX + 3 * MiB; return true;
    case 26: g.A = AR; g.Bt = AR + 40 * MiB; g.K = 512; g.lda = 640; g.ldb = 512; g.nM = 2; g.nN = 1; g.ngrp = 64; g.a_gs = 512 * 640; g.b_gs = 256 * 512; g.mode = E_XE; return true;
    case 28: g.A = AR; g.Bt = AR + 20 * MiB; g.K = 640; g.lda = 640; g.ldb = 640; g.nM = 2; g.nN = 2; g.ngrp = 64; g.a_gs = 512 * 640; g.b_gs = 512 * 640; g.mode = E_S5Y; return true;
    case 29: g.A = AR + 56 * MiB; g.nN = 8; g.mode = E_GLU; return true;
    default: return false;
    }
}

enum { RP_BF = 0, RP_F32 = 1, RP_S5 = 2, RP_FINAL = 3 };
template <int MODE>
DI void row_pass(const float* hin, float* hout, const bf16_t* z, const float* gpost, const float* gpre, void* outp, int gw, int NGW, int lane) {
    asm volatile("" : "+v"(lane));
    for (int row = gw; row < S; row += NGW) {
        f32x4 h[4];
#pragma unroll
        for (int j = 0; j < 4; ++j) { const int cb = (MODE == RP_S5) ? 16 * lane + 4 * j : 4 * lane + 256 * j; h[j] = *(const f32x4*)(hin + (size_t)row * 1024 + cb); }
        if (z) {
            f32x4 zz[4]; float ss = 0.f;
#pragma unroll
            for (int j = 0; j < 4; ++j) { const int cb = (MODE == RP_S5) ? 16 * lane + 4 * j : 4 * lane + 256 * j; const u32x2 w = *(const u32x2*)(z + (size_t)row * 1024 + cb);
                zz[j] = (f32x4){bflo(w.x), bfhi(w.x), bflo(w.y), bfhi(w.y)}; ss += zz[j][0] * zz[j][0] + zz[j][1] * zz[j][1] + zz[j][2] * zz[j][2] + zz[j][3] * zz[j][3]; }
            ss = wave_sum(ss, lane); const float rz = rsqrtf(ss * (1.f / 1024.f) + RMS_EPS);
#pragma unroll
            for (int j = 0; j < 4; ++j) { const int cb = (MODE == RP_S5) ? 16 * lane + 4 * j : 4 * lane + 256 * j; const f32x4 gp = *(const f32x4*)(gpost + cb); h[j] += zz[j] * rz * gp;
                *(f32x4*)(hout + (size_t)row * 1024 + cb) = h[j]; }
        }
        if (MODE != RP_FINAL) {
            float s2 = 0.f;
#pragma unroll
            for (int j = 0; j < 4; ++j) s2 += h[j][0] * h[j][0] + h[j][1] * h[j][1] + h[j][2] * h[j][2] + h[j][3] * h[j][3];
            s2 = wave_sum(s2, lane); const float rn = rsqrtf(s2 * (1.f / 1024.f) + RMS_EPS);
#pragma unroll
            for (int j = 0; j < 4; ++j) { const int cb = (MODE == RP_S5) ? 16 * lane + 4 * j : 4 * lane + 256 * j; const f32x4 gq = *(const f32x4*)(gpre + cb); const f32x4 xn = h[j] * rn * gq;
                if (MODE == RP_BF) store_bf4((bf16_t*)outp + (size_t)row * 1024 + cb, xn);
                if (MODE == RP_F32) *(f32x4*)((float*)outp + (size_t)row * 1024 + cb) = xn;
                if (MODE == RP_S5) store_bf4((bf16_t*)outp + ((size_t)(lane * 512 + (row >> 5))) * 640 + (row & 31) * 16 + 4 * j, xn); }
        }
    }
}

enum { MAP_ID = 0, MAP_UQ = 1, MAP_GLUA = 2, MAP_GLUB = 3 };
DI int dstrow(int mode, int n) {
    if (mode == MAP_UQ) { const int hd = n / 192, w = n - hd * 192; if (w < 128) return n; const int r = w - 128; return hd * 192 + 128 + 2 * (r & 31) + (r >> 5); }
    if (mode == MAP_GLUA) return (n >> 7) * 256 + (n & 127);
    if (mode == MAP_GLUB) return (n >> 7) * 256 + 128 + (n & 127);
    return n;
}
DI void convT(const float* src, int K, int N, bf16_t* dst, int ldT, int mapmode, int gw, int NGW, int lane) {
    asm volatile("" : "+v"(lane));
    const int nnb = N >> 4, nitems = nnb * (K >> 5);
    for (int it = gw; it < nitems; it += NGW) {
        const int kb = it / nnb, nb = it - kb * nnb;
        const int n = nb * 16 + (lane >> 2), k = kb * 32 + 8 * (lane & 3);
        const float* s = src + (size_t)k * N + n;
        float v[8];
#pragma unroll
        for (int i = 0; i < 8; ++i) v[i] = s[(size_t)i * N];
        u32x4 o; o.x = pk_bf16(v[0], v[1]); o.y = pk_bf16(v[2], v[3]); o.z = pk_bf16(v[4], v[5]); o.w = pk_bf16(v[6], v[7]);
        *(u32x4*)(dst + (size_t)dstrow(mapmode, n) * ldT + k) = o;
    }
}
DI void conv_layer(const Params& P, int L, int gw, int NGW, int lane) {
    unsigned char* ws_ = P.ws; asm volatile("" : "+s"(ws_));
    unsigned char* ws = ws_;
    bf16_t* WMIX = (bf16_t*)(ws + O_WMIX);
    convT(P.in[3] + (size_t)L * 1024 * 4096, 1024, 4096, (bf16_t*)(ws + O_WUP), 1024, MAP_ID, gw, NGW, lane);
    convT(P.in[4] + (size_t)L * 1024 * 4096, 4096, 1024, (bf16_t*)(ws + O_WDN), 4096, MAP_ID, gw, NGW, lane);
    if (L == 0) {
        convT(P.in[5], 1024, 2048, WMIX, 1024, MAP_ID, gw, NGW, lane);
        convT(P.in[11], 1024, 1024, WMIX + 2 * MiB, 1024, MAP_ID, gw, NGW, lane);
        const float* wsrc = P.in[9]; bf16_t* wd = WMIX + 3 * MiB;
        for (int e = gw * 64 + lane; e < 8 * 128 * 128 / 4; e += NGW * 64) { const int s0 = (e * 4) & 127, t = ((e * 4) >> 7) & 127; f32x4 w = *(const f32x4*)(wsrc + (size_t)e * 4);
#pragma unroll
            for (int j = 0; j < 4; ++j) if (s0 + j > t) w[j] = 0.f;
            store_bf4(wd + (size_t)e * 4, w); }
    } else if (L == 1) {
        for (int gg = 0; gg < 4; ++gg) convT(P.in[12] + gg * 65536, 256, 256, WMIX + gg * 65536, 256, MAP_ID, gw, NGW, lane);
    } else if (L == 2) {
        convT(P.in[14], 1024, 384, WMIX, 1024, MAP_ID, gw, NGW, lane);
        convT(P.in[17], 1024, 320, WMIX + 384 * 1024, 1024, MAP_ID, gw, NGW, lane);
        convT(P.in[16], 384, 1536, WMIX + 1 * MiB, 384, MAP_UQ, gw, NGW, lane);
        convT(P.in[19], 256, 1024, WMIX + 2 * MiB, 256, MAP_ID, gw, NGW, lane);
        convT(P.in[20], 256, 1024, WMIX + (5 * MiB) / 2, 256, MAP_ID, gw, NGW, lane);
        convT(P.in[21], 1024, 1024, WMIX + 3 * MiB, 1024, MAP_ID, gw, NGW, lane);
    } else {
        convT(P.in[30], 1024, 1024, WMIX, 1024, MAP_GLUA, gw, NGW, lane);
        convT(P.in[31], 1024, 1024, WMIX, 1024, MAP_GLUB, gw, NGW, lane);
    }
}

DI void lnv_phase(const Params& P, int gw, int NGW, int lane) {
    unsigned char* ws_ = P.ws; asm volatile("" : "+s"(ws_));
    asm volatile("" : "+v"(lane));
    bf16_t* V = (bf16_t*)(ws_ + O_AR + 32 * MiB);
    const float* gv = P.in[7]; const float* bv = P.in[8];
    for (int row = gw; row < S; row += NGW) {
        f32x4 x[4]; float s = 0.f;
#pragma unroll
        for (int j = 0; j < 4; ++j) { const u32x2 w = *(const u32x2*)(V + (size_t)row * 1024 + 4 * lane + 256 * j); x[j] = (f32x4){bflo(w.x), bfhi(w.x), bflo(w.y), bfhi(w.y)}; s += x[j][0] + x[j][1] + x[j][2] + x[j][3]; }
        const float mu = wave_sum(s, lane) * (1.f / 1024.f); float s2 = 0.f;
#pragma unroll
        for (int j = 0; j < 4; ++j) { x[j] = x[j] - mu; s2 += x[j][0] * x[j][0] + x[j][1] * x[j][1] + x[j][2] * x[j][2] + x[j][3] * x[j][3]; }
        const float rs = rsqrtf(wave_sum(s2, lane) * (1.f / 1024.f) + RMS_EPS);
#pragma unroll
        for (int j = 0; j < 4; ++j) { const int cb = 4 * lane + 256 * j; const f32x4 g4 = *(const f32x4*)(gv + cb), b4 = *(const f32x4*)(bv + cb); store_bf4(V + (size_t)row * 1024 + cb, x[j] * rs * g4 + b4); }
    }
}

DI void gate_phase(const Params& P, LAS unsigned char* lds, int tid, int wid, int lane, int bid) {
    unsigned char* ws_ = P.ws; asm volatile("" : "+s"(ws_));
    asm volatile("" : "+v"(tid)); lane = tid & 63; wid = __builtin_amdgcn_readfirstlane(tid >> 6);
    LAS bf16_t* Wt = (LAS bf16_t*)lds;
    LAS bf16_t* Vt = Wt + 128 * 136;
    const bf16_t* Wsb = (const bf16_t*)(ws_ + O_WMIX + 6 * MiB);
    const bf16_t* U = (const bf16_t*)(ws_ + O_AR);
    const bf16_t* V = (const bf16_t*)(ws_ + O_AR + 32 * MiB);
    bf16_t* Y = (bf16_t*)(ws_ + O_AR + 64 * MiB);
    const float* bs = P.in[10];
    const int r16 = lane & 15, quad = lane >> 4;
    for (int item = bid; item < 1024; item += gridDim.x) {
        const int hd = item & 7, c = item >> 3;
        __syncthreads();
#pragma unroll
        for (int i = 0; i < 4; ++i) { const int cid = tid + 512 * i, t = cid >> 4, sc = cid & 15;
            const u32x4 w = *(const u32x4*)(Wsb + ((size_t)(hd * 128 + t)) * 128 + 8 * sc); *(LAS u32x4*)(Wt + t * 136 + 8 * sc) = w; }
#pragma unroll
        for (int i = 0; i < 4; ++i) { const int cid = tid + 512 * i, s = cid >> 4, dc = cid & 15;
            const u32x4 w = *(const u32x4*)(V + ((size_t)(c * 128 + s)) * 1024 + hd * 128 + 8 * dc);
#pragma unroll
            for (int e = 0; e < 8; ++e) Vt[(8 * dc + e) * 136 + s] = (bf16_t)((e & 1) ? (w[e >> 1] >> 16) : (w[e >> 1] & 0xffffu)); }
        __syncthreads();
        const int t = 16 * wid + r16;
        const int nks = (16 * wid + 15) / 32 + 1;
        bf16x8 bw[4];
#pragma unroll
        for (int ks = 0; ks < 4; ++ks) bw[ks] = *(const LAS bf16x8*)(Wt + t * 136 + 32 * ks + 8 * quad);
        const int token = c * 128 + t;
        const float bias = bs[hd * 128 + t];
#pragma unroll
        for (int dt = 0; dt < 8; ++dt) {
            f32x4 acc = {0.f, 0.f, 0.f, 0.f};
#pragma unroll
            for (int ks = 0; ks < 4; ++ks) if (ks < nks) {
                const bf16x8 a = *(const LAS bf16x8*)(Vt + (16 * dt + r16) * 136 + 32 * ks + 8 * quad);
                acc = __builtin_amdgcn_mfma_f32_16x16x32_bf16(a, bw[ks], acc, 0, 0, 0); }
            const int col = hd * 128 + 16 * dt + 4 * quad;
            const u32x2 uu = *(const u32x2*)(U + (size_t)token * 1024 + col);
            f32x4 y; y[0] = (acc[0] + bias) * bflo(uu.x); y[1] = (acc[1] + bias) * bfhi(uu.x); y[2] = (acc[2] + bias) * bflo(uu.y); y[3] = (acc[3] + bias) * bfhi(uu.y);
            store_bf4(Y + (size_t)token * 1024 + col, y);
        }
    }
}

DI void pool_phase(const Params& P, int gtid, int nthreads) {
    unsigned char* ws_ = P.ws; asm volatile("" : "+s"(ws_));
    asm volatile("" : "+v"(gtid));
    const float* ZF = (const float*)(ws_ + O_AR);
    bf16_t* Pb = (bf16_t*)(ws_ + O_AR + 64 * MiB);
    for (int e = gtid; e < 1024 * 256; e += nthreads) {
        const int cgi = e & 255, tb = e >> 8, col = 4 * cgi, w = 2 << (cgi >> 6), t0 = 16 * tb;
        f32x4 W = {0.f, 0.f, 0.f, 0.f};
        for (int j = 1; j < w; ++j) if (t0 - j >= 0) W += *(const f32x4*)(ZF + (size_t)(t0 - j) * 1024 + col);
        for (int i = 0; i < 16; ++i) { const int t = t0 + i; const f32x4 z = *(const f32x4*)(ZF + (size_t)t * 1024 + col); W += z;
            const float cnt = (float)((t + 1 < w) ? (t + 1) : w); const f32x4 o = W / cnt - z; store_bf4(Pb + (size_t)t * 1024 + col, o);
            if (t - w + 1 >= 0) W -= *(const f32x4*)(ZF + (size_t)(t - w + 1) * 1024 + col); }
    }
}

DI void mla_rows(const Params& P, int gw, int NGW, int lane) {
    unsigned char* ws_ = P.ws; asm volatile("" : "+s"(ws_));
    asm volatile("" : "+v"(lane));
    unsigned char* ar = ws_ + O_AR;
    const bf16_t* LAT = (const bf16_t*)ar; bf16_t* QL = (bf16_t*)(ar + 24 * MiB); bf16_t* Cb = (bf16_t*)(ar + 36 * MiB); bf16_t* KR = (bf16_t*)(ar + 44 * MiB);
    const float* CS = (const float*)(ws_ + O_CS); const float* gq = P.in[15]; const float* gkv = P.in[18];
    for (int row = gw; row < S; row += NGW) {
        const bf16_t* lat = LAT + (size_t)row * 768;
        float q[6]; float ss = 0.f;
#pragma unroll
        for (int i = 0; i < 3; ++i) { const unsigned w = *(const unsigned*)(lat + 2 * lane + 128 * i); q[2 * i] = bflo(w); q[2 * i + 1] = bfhi(w); ss += q[2 * i] * q[2 * i] + q[2 * i + 1] * q[2 * i + 1]; }
        ss = wave_sum(ss, lane); const float rq = rsqrtf(ss * (1.f / 384.f) + RMS_EPS);
#pragma unroll
        for (int i = 0; i < 3; ++i) { const f32x2 g2 = *(const f32x2*)(gq + 2 * lane + 128 * i); *(unsigned*)(QL + (size_t)row * 384 + 2 * lane + 128 * i) = pk_bf16(q[2 * i] * rq * g2.x, q[2 * i + 1] * rq * g2.y); }
        float cc[4]; float s2 = 0.f;
#pragma unroll
        for (int i = 0; i < 2; ++i) { const unsigned w = *(const unsigned*)(lat + 384 + 2 * lane + 128 * i); cc[2 * i] = bflo(w); cc[2 * i + 1] = bfhi(w); s2 += cc[2 * i] * cc[2 * i] + cc[2 * i + 1] * cc[2 * i + 1]; }
        s2 = wave_sum(s2, lane); const float rc = rsqrtf(s2 * (1.f / 256.f) + RMS_EPS);
#pragma unroll
        for (int i = 0; i < 2; ++i) { const f32x2 g2 = *(const f32x2*)(gkv + 2 * lane + 128 * i); *(unsigned*)(Cb + (size_t)row * 256 + 2 * lane + 128 * i) = pk_bf16(cc[2 * i] * rc * g2.x, cc[2 * i + 1] * rc * g2.y); }
        if (lane < 32) { const float x1 = bf2f(lat[640 + lane]), x2 = bf2f(lat[672 + lane]); const f32x2 cs = *(const f32x2*)(CS + ((size_t)row * 32 + lane) * 2);
            *(unsigned*)(KR + (size_t)row * 64 + 2 * lane) = pk_bf16(x1 * cs.x - x2 * cs.y, x1 * cs.y + x2 * cs.x); }
    }
}

#define MFMA32(a, b, c) __builtin_amdgcn_mfma_f32_32x32x16_bf16((a), (b), (c), 0, 0, 0)
DI int crow(int reg, int h) { return (reg & 3) + 8 * (reg >> 2) + 4 * h; }

DI void attn_phase(const Params& P, LAS unsigned char* lds, int tid, int wid, int lane, int bid) {
    unsigned char* ws_ = P.ws; asm volatile("" : "+s"(ws_));
    asm volatile("" : "+v"(tid)); lane = tid & 63; wid = __builtin_amdgcn_readfirstlane(tid >> 6);
    unsigned char* ar = ws_ + O_AR;
    const bf16_t* Q = (const bf16_t*)(ar + 48 * MiB); const bf16_t* KN = (const bf16_t*)(ar + 96 * MiB); const bf16_t* VT = (const bf16_t*)(ar + 128 * MiB); const bf16_t* KR = (const bf16_t*)(ar + 44 * MiB);
    bf16_t* AO = (bf16_t*)(ws_ + O_XN);
    const int l32 = lane & 31, h2 = lane >> 5;
    constexpr int BUFB = 43008, VOFF = 25600;
    const unsigned kn_off0 = (unsigned)(((tid >> 4) * 1024 + 8 * (tid & 15)) * 2);
    const unsigned kr_off = (unsigned)(((tid >> 3) * 64 + 8 * (tid & 7)) * 2);
    const unsigned vt_off0 = (unsigned)(((tid >> 3) * 16384 + 8 * (tid & 7)) * 2);
    const unsigned kn_l0 = (unsigned)((tid >> 4) * 400 + 16 * (tid & 15));
    const unsigned kr_l = (unsigned)((tid >> 3) * 400 + 256 + 16 * (tid & 7));
    const unsigned vt_l0 = (unsigned)(25600 + (tid >> 3) * 136 + 16 * (tid & 7));
    for (int item = bid; item < 256; item += gridDim.x) {
        const int head = item & 7, pair = item >> 3;
        for (int half = 0; half < 2; ++half) {
            const int qb = half ? 63 - pair : pair;
            const int wrow0 = qb * 256 + wid * 32, qrow = wrow0 + l32;
            bf16x8 Qf[12];
#pragma unroll
            for (int s = 0; s < 12; ++s) Qf[s] = *(const bf16x8*)(Q + (size_t)qrow * 1536 + head * 192 + 16 * s + 8 * h2);
            f32x16 o[4];
#pragma unroll
            for (int d = 0; d < 4; ++d)
#pragma unroll
                for (int r = 0; r < 16; ++r) o[d][r] = 0.f;
            float mrun = -INFINITY, lsum = 0.f;
            const int ntiles = 4 * (qb + 1);
            u32x4 kreg[3], vreg[2];
#define ATT_ISSUE(kt) do { \
    unsigned o0_ = kn_off0, o1_ = kr_off, o2_ = vt_off0; asm volatile("" : "+v"(o0_), "+v"(o1_), "+v"(o2_)); \
    const char* knb = (const char*)(KN + (size_t)(kt) * 65536 + head * 128); const char* krb = (const char*)(KR + (size_t)(kt) * 4096); \
    const char* vtb = (const char*)(VT + (size_t)head * 128 * 16384 + 64 * (kt)); \
    kreg[0] = *(const u32x4*)(knb + o0_); kreg[1] = *(const u32x4*)(knb + 65536 + o0_); kreg[2] = *(const u32x4*)(krb + o1_); \
    vreg[0] = *(const u32x4*)(vtb + o2_); vreg[1] = *(const u32x4*)(vtb + 2097152 + o2_); } while (0)
#define ATT_WRITE(b) do { LAS unsigned char* base = lds + (b) * BUFB; \
    *(LAS u32x4*)(base + kn_l0) = kreg[0]; *(LAS u32x4*)(base + kn_l0 + 12800) = kreg[1]; *(LAS u32x4*)(base + kr_l) = kreg[2]; \
    *(LAS u32x2*)(base + vt_l0) = (u32x2){vreg[0].x, vreg[0].y}; *(LAS u32x2*)(base + vt_l0 + 8) = (u32x2){vreg[0].z, vreg[0].w}; \
    *(LAS u32x2*)(base + vt_l0 + 8704) = (u32x2){vreg[1].x, vreg[1].y}; *(LAS u32x2*)(base + vt_l0 + 8712) = (u32x2){vreg[1].z, vreg[1].w}; } while (0)
            ATT_ISSUE(0); ATT_WRITE(0); __syncthreads();
            for (int kt = 0; kt < ntiles; ++kt) {
                const bool more = (kt + 1 < ntiles);
                if (more) ATT_ISSUE(kt + 1);
                if (64 * kt <= wrow0 + 31) {
                    LAS unsigned char* base = lds + (kt & 1) * BUFB;
                    f32x16 st0, st1;
#pragma unroll
                    for (int r = 0; r < 16; ++r) { st0[r] = 0.f; st1[r] = 0.f; }
                    {
                        const LAS unsigned char* kp = base + l32 * 400 + 16 * h2;
                        bf16x8 ka[2][4];
#define ATT_LDK(bf, gq) do { _Pragma("unroll") for (int sl = 0; sl < 2; ++sl) { ka[bf][2 * sl] = *(const LAS bf16x8*)(kp + 32 * (2 * (gq) + sl)); ka[bf][2 * sl + 1] = *(const LAS bf16x8*)(kp + 12800 + 32 * (2 * (gq) + sl)); } } while (0)
#define ATT_MMK(bf, gq) do { _Pragma("unroll") for (int sl = 0; sl < 2; ++sl) { st0 = MFMA32(ka[bf][2 * sl], Qf[2 * (gq) + sl], st0); st1 = MFMA32(ka[bf][2 * sl + 1], Qf[2 * (gq) + sl], st1); } } while (0)
                        ATT_LDK(0, 0); __builtin_amdgcn_sched_barrier(0);
                        ATT_LDK(1, 1); __builtin_amdgcn_sched_barrier(0);
                        ATT_MMK(0, 0); __builtin_amdgcn_sched_barrier(0);
                        ATT_LDK(0, 2); __builtin_amdgcn_sched_barrier(0);
                        ATT_MMK(1, 1); __builtin_amdgcn_sched_barrier(0);
                        ATT_LDK(1, 3); __builtin_amdgcn_sched_barrier(0);
                        ATT_MMK(0, 2); __builtin_amdgcn_sched_barrier(0);
                        ATT_LDK(0, 4); __builtin_amdgcn_sched_barrier(0);
                        ATT_MMK(1, 3); __builtin_amdgcn_sched_barrier(0);
                        ATT_LDK(1, 5); __builtin_amdgcn_sched_barrier(0);
                        ATT_MMK(0, 4); __builtin_amdgcn_sched_barrier(0);
                        ATT_MMK(1, 5); __builtin_amdgcn_sched_barrier(0);
#undef ATT_LDK
#undef ATT_MMK
                    }
                    if (64 * kt + 63 > wrow0) {
#pragma unroll
                        for (int r = 0; r < 16; ++r) { const int key0 = 64 * kt + crow(r, h2); if (key0 > qrow) st0[r] = -INFINITY; if (key0 + 32 > qrow) st1[r] = -INFINITY; }
                    }
                    float mx = st0[0];
#pragma unroll
                    for (int r = 1; r < 16; ++r) mx = fmaxf(mx, st0[r]);
#pragma unroll
                    for (int r = 0; r < 16; ++r) mx = fmaxf(mx, st1[r]);
                    mx = fmaxf(mx, shx(mx, 32, lane));
                    const float mn = fmaxf(mrun, mx);
                    const float alpha = __builtin_amdgcn_exp2f(mrun - mn);
                    mrun = mn;
                    float psum = 0.f;
#pragma unroll
                    for (int r = 0; r < 16; ++r) { st0[r] = __builtin_amdgcn_exp2f(st0[r] - mn); st1[r] = __builtin_amdgcn_exp2f(st1[r] - mn); psum += st0[r] + st1[r]; }
                    lsum = lsum * alpha + psum;
#pragma unroll
                    for (int d = 0; d < 4; ++d)
#pragma unroll
                        for (int r = 0; r < 16; ++r) o[d][r] *= alpha;
                    {
                        const LAS unsigned char* vb = base + VOFF + l32 * 136 + 8 * h2;
                        u32x4 va[2][4];
#define ATT_LDV(bf, stp) do { _Pragma("unroll") for (int d = 0; d < 4; ++d) { const LAS unsigned char* vp = vb + d * 4352 + 32 * (stp); \
        const u32x2 lo = *(const LAS u32x2*)vp, hi = *(const LAS u32x2*)(vp + 16); va[bf][d] = (u32x4){lo.x, lo.y, hi.x, hi.y}; } } while (0)
#define ATT_MMV(bf, stv, sp) do { u32x4 pw; pw.x = pk_bf16(stv[8 * (sp)], stv[8 * (sp) + 1]); pw.y = pk_bf16(stv[8 * (sp) + 2], stv[8 * (sp) + 3]); pw.z = pk_bf16(stv[8 * (sp) + 4], stv[8 * (sp) + 5]); pw.w = pk_bf16(stv[8 * (sp) + 6], stv[8 * (sp) + 7]); \
        const bf16x8 pf = __builtin_bit_cast(bf16x8, pw); _Pragma("unroll") for (int d = 0; d < 4; ++d) o[d] = MFMA32(__builtin_bit_cast(bf16x8, va[bf][d]), pf, o[d]); } while (0)
                        ATT_LDV(0, 0); __builtin_amdgcn_sched_barrier(0);
                        ATT_LDV(1, 1); __builtin_amdgcn_sched_barrier(0);
                        ATT_MMV(0, st0, 0); __builtin_amdgcn_sched_barrier(0);
                        ATT_LDV(0, 2); __builtin_amdgcn_sched_barrier(0);
                        ATT_MMV(1, st0, 1); __builtin_amdgcn_sched_barrier(0);
                        ATT_LDV(1, 3); __builtin_amdgcn_sched_barrier(0);
                        ATT_MMV(0, st1, 0); __builtin_amdgcn_sched_barrier(0);
                        ATT_MMV(1, st1, 1); __builtin_amdgcn_sched_barrier(0);
#undef ATT_LDV
#undef ATT_MMV
                    }
                }
                if (more) ATT_WRITE((kt + 1) & 1);
                __syncthreads();
            }
            int t2_ = tid; asm volatile("" : "+v"(t2_));
            const int qrow2 = qb * 256 + (t2_ >> 6) * 32 + (t2_ & 31), h2b = (t2_ >> 5) & 1;
            const float ltot = lsum + shx(lsum, 32, lane);
            const float inv = 1.f / ltot;
#pragma unroll
            for (int d = 0; d < 4; ++d)
#pragma unroll
                for (int rg = 0; rg < 4; ++rg) { f32x4 v = {o[d][4 * rg] * inv, o[d][4 * rg + 1] * inv, o[d][4 * rg + 2] * inv, o[d][4 * rg + 3] * inv};
                    store_bf4(AO + (size_t)qrow2 * 1024 + head * 128 + d * 32 + 8 * rg + 4 * h2b, v); }
        }
    }
#undef ATT_ISSUE
#undef ATT_WRITE
}

DI void s5_precompute(const Params& P, LAS unsigned char* lds, int tid, int bid) {
    unsigned char* ws_ = P.ws; asm volatile("" : "+s"(ws_));
    asm volatile("" : "+v"(tid));
    LAS float* PWr = (LAS float*)lds;
    LAS float* PWi = PWr + 33 * 64;
    LAS float* BBr = PWi + 33 * 64;
    LAS float* BBi = BBr + 1024;
    LAS float* CRe = BBi + 1024;
    LAS float* CIm = CRe + 1024;
    LAS float* KT = CIm + 1024;
    const float* lam_re = P.in[22]; const float* lam_im = P.in[23]; const float* log_dt = P.in[24];
    const float* b_re = P.in[25]; const float* b_im = P.in[26]; const float* c_re = P.in[27]; const float* c_im = P.in[28]; const float* dsk = P.in[29];
    bf16_t* TF = (bf16_t*)(ws_ + O_AR + 40 * MiB); bf16_t* Eb = (bf16_t*)(ws_ + O_AR + 80 * MiB);
    for (int item = bid; item < 256; item += gridDim.x) {
        const int g = item >> 2, q = item & 3;
        __syncthreads();
        const float dt = expf(log_dt[g]);
        for (int e = tid; e < 33 * 64; e += 512) { const int j = e >> 6, p = e & 63; const float lr = lam_re[g * 64 + p], li = lam_im[g * 64 + p];
            const float mag = expf((float)j * (lr * dt)); float sn, cs; sincosf((float)j * (li * dt), &sn, &cs); PWr[e] = mag * cs; PWi[e] = mag * sn; }
        for (int e = tid; e < 1024; e += 512) { const int p = e >> 4; const float lr = lam_re[g * 64 + p], li = lam_im[g * 64 + p];
            const float mag = expf(lr * dt); float sn, cs; sincosf(li * dt, &sn, &cs); const float ar = mag * cs, ai = mag * sn;
            const float den = lr * lr + li * li; const float fre = ((ar - 1.f) * lr + ai * li) / den, fim = (ai * lr - (ar - 1.f) * li) / den;
            const float br = b_re[(size_t)g * 1024 + e], bi = b_im[(size_t)g * 1024 + e];
            BBr[e] = fre * br - fim * bi; BBi[e] = fre * bi + fim * br; }
        for (int e = tid; e < 1024; e += 512) { CRe[e] = c_re[(size_t)g * 1024 + e]; CIm[e] = c_im[(size_t)g * 1024 + e]; }
        __syncthreads();
        for (int e = tid; e < 8192; e += 512) { const int j = e >> 8, co = (e >> 4) & 15, ci = e & 15; float a = 0.f;
            for (int p = 0; p < 64; ++p) { const float cr = CRe[co * 64 + p], cm = CIm[co * 64 + p], pr = PWr[j * 64 + p], pi = PWi[j * 64 + p];
                const float wr_ = cr * pr - cm * pi, wi_ = cr * pi + cm * pr; a += wr_ * BBr[p * 16 + ci] - wi_ * BBi[p * 16 + ci]; }
            if (j == 0 && co == ci) a += dsk[g * 16 + co];
            KT[e] = a; }
        __syncthreads();
        for (int e = tid; e < 128 * 80; e += 512) { const int rr = e / 80, kc = e - rr * 80, n = 128 * q + rr, l = n >> 4, co = n & 15; float v[8];
            if (kc < 64) { const int lp = kc >> 1;
#pragma unroll
                for (int i = 0; i < 8; ++i) v[i] = (lp <= l) ? KT[((l - lp) * 16 + co) * 16 + 8 * (kc & 1) + i] : 0.f;
            } else {
                const bool im = kc >= 72; const int p0 = 8 * (kc - (im ? 72 : 64));
#pragma unroll
                for (int i = 0; i < 8; ++i) { const int p = p0 + i; const float cr = CRe[co * 64 + p], cm = CIm[co * 64 + p], pr = PWr[(l + 1) * 64 + p], pi = PWi[(l + 1) * 64 + p];
                    v[i] = im ? -(cr * pi + cm * pr) : (cr * pr - cm * pi); }
            }
            u32x4 o; o.x = pk_bf16(v[0], v[1]); o.y = pk_bf16(v[2], v[3]); o.z = pk_bf16(v[4], v[5]); o.w = pk_bf16(v[6], v[7]);
            *(u32x4*)(TF + ((size_t)(g * 512 + n)) * 640 + 8 * kc) = o; }
        for (int e = tid; e < 32 * 64; e += 512) { const int n = 32 * q + (e >> 6), kc = e & 63, p = n & 63, im = n >> 6, lp = kc >> 1; float v[8];
            const float pr = PWr[(31 - lp) * 64 + p], pi = PWi[(31 - lp) * 64 + p];
#pragma unroll
            for (int i = 0; i < 8; ++i) { const int ci = 8 * (kc & 1) + i; const float br = BBr[p * 16 + ci], bi = BBi[p * 16 + ci]; v[i] = im ? (pr * bi + pi * br) : (pr * br - pi * bi); }
            u32x4 o; o.x = pk_bf16(v[0], v[1]); o.y = pk_bf16(v[2], v[3]); o.z = pk_bf16(v[4], v[5]); o.w = pk_bf16(v[6], v[7]);
            *(u32x4*)(Eb + ((size_t)(g * 256 + n)) * 512 + 8 * kc) = o; }
    }
}

DI void s5_scan(const Params& P, int wid, int lane, int bid) {
    unsigned char* ws_ = P.ws; asm volatile("" : "+s"(ws_));
    asm volatile("" : "+v"(lane));
    if (wid != 0) return;
    const float* lam_re = P.in[22]; const float* lam_im = P.in[23]; const float* log_dt = P.in[24];
    const float* XE = (const float*)(ws_ + O_AR + 96 * MiB); bf16_t* UG = (bf16_t*)(ws_ + O_AR);
    for (int g = bid; g < 64; g += gridDim.x) {
        const int p = lane; const float dt = expf(log_dt[g]); const float lr = lam_re[g * 64 + p], li = lam_im[g * 64 + p];
        const float mag = expf(32.f * (lr * dt)); float sn, cs; sincosf(32.f * (li * dt), &sn, &cs); const float ar = mag * cs, ai = mag * sn;
        float cr = 0.f, ci = 0.f;
        const float* xe = XE + (size_t)g * 512 * 128; bf16_t* ug = UG + (size_t)g * 512 * 640;
        for (int c0 = 0; c0 < 512; c0 += 16) {
            float xr[16], xi[16];
#pragma unroll
            for (int i = 0; i < 16; ++i) { xr[i] = xe[(size_t)(c0 + i) * 128 + p]; xi[i] = xe[(size_t)(c0 + i) * 128 + 64 + p]; }
#pragma unroll
            for (int i = 0; i < 16; ++i) { ug[(size_t)(c0 + i) * 640 + 512 + p] = f2bf(cr); ug[(size_t)(c0 + i) * 640 + 576 + p] = f2bf(ci);
                const float nr = ar * cr - ai * ci + xr[i], ni = ar * ci + ai * cr + xi[i]; cr = nr; ci = ni; }
        }
    }
}

DI void cs_table(const Params& P, int gtid, int nthreads) {
    unsigned char* ws_ = P.ws; asm volatile("" : "+s"(ws_));
    asm volatile("" : "+v"(gtid));
    const int* pos = (const int*)P.in[1]; float* CS = (float*)(ws_ + O_CS);
    for (int e = gtid; e < S * 32; e += nthreads) { const int row = e >> 5, j = e & 31;
        const float invf = exp2f(-(float)j * (13.287712379549449f / 32.f)); const float ang = (float)pos[row] * invf; float sn, cs; sincosf(ang, &sn, &cs);
        *(f32x2*)(CS + (size_t)e * 2) = (f32x2){cs, sn}; }
}


#define XB_TMO      128
#define XB_XCNT(j)  (256  + 64 * (j))
#define XB_XSUB(j)  (1280 + 64 * (j))
#define XB_XGEN(j)  (2304 + 64 * (j))
#define XB_TOP      3328
#define XB_TOPGEN   3392
#define XCD_BAR_WORDS 3456
#define XB_SPIN_CAP (1u << 18)
DI unsigned xb_ld(unsigned* p)              { return __hip_atomic_load(p, __ATOMIC_RELAXED, __HIP_MEMORY_SCOPE_AGENT); }
DI unsigned xb_add(unsigned* p, unsigned v) { return __hip_atomic_fetch_add(p, v, __ATOMIC_RELAXED, __HIP_MEMORY_SCOPE_AGENT); }
DI unsigned xb_xcc_id() { return (unsigned)__builtin_amdgcn_s_getreg((3 << 11) | 20) & 0xFu; }
#define XB_SPIN(cond, bar) do { unsigned _sp = 0; while (cond) { __builtin_amdgcn_s_sleep(1); \
    if ((++_sp & 255u) == 0u) { if (xb_ld(&(bar)[XB_TMO])) break; if (_sp > XB_SPIN_CAP) { atomicAdd(&(bar)[XB_TMO], 1u); break; } } } } while (0)
struct XcdBarrier { unsigned* bar; unsigned x; volatile LAS unsigned* st; };
DI XcdBarrier xcd_barrier_post(unsigned* bar, volatile LAS unsigned* st) {
    XcdBarrier b; b.bar = bar; b.x = xb_xcc_id(); b.st = st;
    if (threadIdx.x == 0) (void)xb_add(&bar[XB_XCNT(b.x)], 1u);
    return b;
}
DI void xcd_barrier_complete(unsigned* bar, unsigned x, unsigned& nloc, unsigned& nx) {
    const unsigned G = gridDim.x * gridDim.y * gridDim.z;
    unsigned sum, cnt, mine, sp = 0u;
    for (;;) {
        sum = 0u; cnt = 0u; mine = 0u;
#pragma unroll
        for (unsigned j = 0; j < 16; ++j) { const unsigned c = xb_ld(&bar[XB_XCNT(j)]); sum += c; cnt += (c > 0u) ? 1u : 0u; mine = (j == x) ? c : mine; }
        if (sum == G) break;
        __builtin_amdgcn_s_sleep(1);
        if ((++sp & 255u) == 0u) { if (xb_ld(&bar[XB_TMO])) break; if (sp > XB_SPIN_CAP) { atomicAdd(&bar[XB_TMO], 1u); break; } }
    }
    nloc = mine > 0u ? mine : 1u; nx = cnt > 0u ? cnt : 1u;
}
DI void xcd_barrier(const XcdBarrier& b) {
    asm volatile("s_waitcnt vmcnt(0)" ::: "memory");
    __syncthreads();
    if (threadIdx.x == 0) {
        unsigned* bar = b.bar;
        __builtin_amdgcn_s_waitcnt(0);
        unsigned nloc = b.st[0], nx = b.st[1];
        if (nloc == 0u) { xcd_barrier_complete(bar, b.x, nloc, nx); b.st[0] = nloc; b.st[1] = nx; }
        const unsigned old = xb_add(&bar[XB_XSUB(b.x)], 1u);
        const unsigned gen = old / nloc;
        if (old + 1u == (gen + 1u) * nloc) {
            __builtin_amdgcn_fence(__ATOMIC_RELEASE, "agent");
            asm volatile("s_waitcnt vmcnt(0)" ::: "memory");
            const unsigned og = xb_add(&bar[XB_TOP], 1u);
            const unsigned tg = og / nx;
            if (og + 1u == (tg + 1u) * nx) xb_add(&bar[XB_TOPGEN], 1u);
            else XB_SPIN(xb_ld(&bar[XB_TOPGEN]) == tg, bar);
            __builtin_amdgcn_fence(__ATOMIC_ACQUIRE, "agent");
            xb_add(&bar[XB_XGEN(b.x)], 1u);
            asm volatile("s_waitcnt vmcnt(0)" ::: "memory");
        } else {
            XB_SPIN(xb_ld(&bar[XB_XGEN(b.x)]) == gen, bar);
            __builtin_amdgcn_fence(__ATOMIC_ACQUIRE, "agent");
            asm volatile("s_waitcnt vmcnt(0)" ::: "memory");
        }
    }
    __syncthreads();
}

__global__ void __launch_bounds__(512, 2) __attribute__((amdgpu_waves_per_eu(2, 2))) mega_fwd(Params P) {
    extern __shared__ __attribute__((aligned(16))) unsigned char smem[];
    LAS unsigned char* lds = (LAS unsigned char*)smem;
    cg::grid_group grid = cg::this_grid();
    __shared__ uint4 xb_words;
    if (threadIdx.x == 0) xb_words = make_uint4(0u, 0u, 0u, 0u);
    __syncthreads();
    const XcdBarrier xb = xcd_barrier_post((unsigned*)(P.ws + O_BAR), (volatile LAS unsigned*)&xb_words);
    const int G = gridDim.x, nthreads = G * 512, NGW = G * 8;
#pragma nounroll
    for (int st = 0; st < NSTEPS; ++st) {
        int nrep = PROBE_REP(st); asm volatile("" : "+s"(nrep));
_Pragma("nounroll") for (int rep = 0; rep < nrep; ++rep) {
        if (rep) __syncthreads();
        int tid = threadIdx.x; asm volatile("" : "+v"(tid));
        int bid = blockIdx.x; asm volatile("" : "+s"(bid));
        unsigned char* ws = P.ws; asm volatile("" : "+s"(ws));
        float* outp_ = P.out; asm volatile("" : "+s"(outp_));
        const float* ng = P.in[2];
        bf16_t* XN = (bf16_t*)(ws + O_XN); const bf16_t* Zb = (const bf16_t*)(ws + O_Z);
        GemmDesc g;
        if (get_gemm(P, st, g)) gemm_phase(lds, P, g, G, bid, tid);
        else switch (st) {
        case 0: conv_layer(P, 0, GW_, NGW, LANE_); cs_table(P, GTID_, nthreads);
                row_pass<RP_BF>(P.in[0], outp_, nullptr, nullptr, ng, XN, GW_, NGW, LANE_); break;
        case 2: lnv_phase(P, GW_, NGW, LANE_); break;
        case 3: gate_phase(P, lds, tid, WID_, LANE_, bid); break;
        case 5: case 11: case 14: case 22: case 30: {
            const int L = (st == 5) ? 0 : (st <= 14 ? 1 : (st == 22 ? 2 : 3)); const bool mlp = (st == 14);
            const float* hin = (st == 5) ? P.in[0] : outp_;
            const float* gpost = ng + (L * 4 + (mlp ? 3 : 1)) * 1024; const float* gpre = mlp ? ng + ((L + 1) * 4) * 1024 : ng + (L * 4 + 2) * 1024;
            row_pass<RP_BF>(hin, outp_, Zb, gpost, gpre, XN, GW_, NGW, LANE_);
            if (mlp) conv_layer(P, L + 1, GW_, NGW, LANE_);
        } break;
        case 8: row_pass<RP_F32>(outp_, outp_, Zb, ng + 3 * 1024, ng + 4 * 1024, ws + O_AR, GW_, NGW, LANE_); conv_layer(P, 1, GW_, NGW, LANE_); break;
        case 9: pool_phase(P, GTID_, nthreads); break;
        case 16: mla_rows(P, GW_, NGW, LANE_); break;
        case 20: attn_phase(P, lds, tid, WID_, LANE_, bid); break;
        case 25: row_pass<RP_S5>(outp_, outp_, Zb, ng + 11 * 1024, ng + 12 * 1024, ws + O_AR, GW_, NGW, LANE_); conv_layer(P, 3, GW_, NGW, LANE_); s5_precompute(P, lds, tid, bid); break;
        case 27: s5_scan(P, WID_, LANE_, bid); break;
        case 33: row_pass<RP_FINAL>(outp_, outp_, Zb, ng + 15 * 1024, nullptr, nullptr, GW_, NGW, LANE_); break;
        default: break;
        }
        }
        if (st == 0) grid.sync();
        else if (st != 17 && st != 18 && st != NSTEPS - 1) { xcd_barrier(xb); if (PROBE_SYNC) xcd_barrier(xb); }
    }
}
}

extern "C" void kernel_launch(void* const* d_in, const int* in_sizes, int n_in, void* d_out, int out_size, void* d_ws, size_t ws_size, hipStream_t stream) {
    static int grid = 0;
    if (grid == 0) {
        int dev = 0, cus = 0, per_cu = 0;
        hipGetDevice(&dev);
        hipDeviceGetAttribute(&cus, hipDeviceAttributeMultiprocessorCount, dev);
        hipFuncSetAttribute((const void*)mega_fwd, hipFuncAttributeMaxDynamicSharedMemorySize, LDS_BYTES);
        if (hipOccupancyMaxActiveBlocksPerMultiprocessor(&per_cu, (const void*)mega_fwd, 512, LDS_BYTES) != hipSuccess || per_cu < 1) per_cu = 1;
        (void)hipGetLastError();
        grid = cus * per_cu;
        if (grid <= 0) grid = 256;
    }
    Params p{};
    for (int i = 0; i < 32 && i < n_in; ++i) p.in[i] = (const float*)d_in[i];
    p.out = (float*)d_out; p.ws = (unsigned char*)d_ws;
    hipMemsetAsync((unsigned char*)d_ws + O_BAR, 0, XCD_BAR_WORDS * 4, stream);
    void* args[] = {&p};
    hipError_t e = hipLaunchCooperativeKernel((const void*)mega_fwd, dim3(grid), dim3(512), args, LDS_BYTES, stream);
    if (e != hipSuccess) fprintf(stderr, "cooperative launch failed: %s (grid %d)\n", hipGetErrorString(e), grid);
}
```

```cpp
#include <hip/hip_runtime.h>
#include <hip/hip_cooperative_groups.h>
#include <cstdio>
namespace cg = cooperative_groups;

#define DI __device__ __forceinline__
#define LAS __attribute__((address_space(3)))
typedef unsigned short bf16_t;
typedef short bf16x8 __attribute__((ext_vector_type(8)));
typedef float f32x2 __attribute__((ext_vector_type(2)));
typedef float f32x4 __attribute__((ext_vector_type(4)));
typedef float f32x16 __attribute__((ext_vector_type(16)));
typedef unsigned u32x2 __attribute__((ext_vector_type(2)));
typedef unsigned u32x4 __attribute__((ext_vector_type(4)));
typedef __bf16 bf16v2 __attribute__((ext_vector_type(2)));

#define LANE_ (tid & 63)
#define WID_ (__builtin_amdgcn_readfirstlane(tid >> 6))
#define GW_ (bid * 8 + WID_)
#define GTID_ (bid * 512 + tid)
#ifndef PROBE_REP
#define PROBE_REP(st) 1
#endif
#ifndef PROBE_SYNC
#define PROBE_SYNC 0
#endif
#define IS_GEMM_STEP(st) ((st)==1||(st)==4||(st)==6||(st)==7||(st)==10||(st)==12||(st)==13||(st)==15||(st)==17||(st)==18||(st)==19||(st)==21||(st)==23||(st)==24||(st)==26||(st)==28||(st)==29||(st)==31||(st)==32)
#define IS_MLP_STEP(st) ((st)==6||(st)==7||(st)==12||(st)==13||(st)==23||(st)==24||(st)==31||(st)==32)
namespace {
constexpr int S = 16384;
constexpr size_t MiB = (size_t)1 << 20;
constexpr size_t O_CS = 0, O_WUP = 4 * MiB, O_WDN = 12 * MiB, O_WMIX = 20 * MiB, O_XN = 28 * MiB, O_Z = 60 * MiB, O_AR = 92 * MiB;
constexpr int LDS_BYTES = 131072;
constexpr size_t O_BAR = 254 * MiB;
constexpr int NSTEPS = 34;
constexpr float RMS_EPS = 1e-6f;
constexpr float QSCALE = 0.07216878364870322f * 1.4426950408889634f;

enum { E_Z = 0, E_HID, E_UV, E_POOL, E_LAT, E_Q, E_KN, E_VT, E_XE, E_S5Y, E_GLU };

struct Params { const float* in[32]; float* out; unsigned char* ws; };

DI unsigned pk_bf16(float a, float b) { f32x2 f = {a, b}; bf16v2 h = __builtin_convertvector(f, bf16v2); return __builtin_bit_cast(unsigned, h); }
DI bf16_t f2bf(float x) { return (bf16_t)(pk_bf16(x, 0.f) & 0xffffu); }
DI float bf2f(bf16_t b) { return __uint_as_float(((unsigned)b) << 16); }
DI float bflo(unsigned u) { return __uint_as_float(u << 16); }
DI float bfhi(unsigned u) { return __uint_as_float(u & 0xffff0000u); }
DI float shx(float v, int o, int lane) { return __int_as_float(__builtin_amdgcn_ds_bpermute((lane ^ o) << 2, __float_as_int(v))); }
DI float wave_sum(float v, int lane) {
#pragma unroll
    for (int o = 1; o < 64; o <<= 1) v += shx(v, o, lane);
    return v;
}
DI void store_bf4(bf16_t* p, f32x4 v) { u32x2 w; w.x = pk_bf16(v[0], v[1]); w.y = pk_bf16(v[2], v[3]); *(u32x2*)p = w; }
DI float gelu_tanh(float x) {
    const float u = 0.7978845608028654f * (x + 0.044715f * x * x * x);
    const float e = __expf(-2.f * u);
    return x / (1.f + e);
}

constexpr int BM = 256, BK = 64, HALF = 128, HTB = HALF * BK * 2, NXCD = 8, WGM = 8;
DI int lds_byte(int r, int c) { const int st = (r >> 4) * 2 + (c >> 5), rr = r & 15, cc = c & 31, ob = rr * 64 + cc * 2; return st * 1024 + (ob ^ (((ob >> 9) & 1) << 5)); }
DI void stage_rc(int b, int& R, int& C) { const int st = b / 1024, sb = b % 1024, swz = sb ^ (((sb >> 9) & 1) << 5); R = (st >> 1) * 16 + swz / 64; C = (st & 1) * 32 + (swz % 64) / 2; }

struct GemmDesc { const bf16_t* A; const bf16_t* Bt; long a_gs, b_gs; int K, lda, ldb, nM, nN, ngrp, mode; };
struct Unit { int pm, pn, grp; };

DI bool unit_next(const GemmDesc& g, int i, int G, int c, Unit& u) {
    const int nper = g.nM * g.nN;
    const long L = (long)i * G + c;
    const bool ok = L < (long)nper * g.ngrp;
    const int grp2 = (int)(L / nper), w = (int)(L - (long)grp2 * nper);
    const int nwg = nper, nM = g.nM, nN = g.nN;
    int wgid = w;
    { const int q = nwg / NXCD, r = nwg % NXCD, xcd = wgid % NXCD, off = wgid / NXCD; wgid = (xcd < r ? xcd * (q + 1) : r * (q + 1) + (xcd - r) * q) + off; }
    const int nig = WGM * nN, gid = wgid / nig, fm = gid * WGM, gsz = (nM - fm) < WGM ? (nM - fm) : WGM;
    const int gszc = gsz > 0 ? gsz : 1;
    const int pm1 = fm + ((wgid % nig) % gszc), pn1 = (wgid % nig) / gszc;
    const int pm2 = w % nM, pn2 = w / nM;
    const bool single = (g.ngrp == 1);
    Unit r; r.pm = single ? pm1 : pm2; r.pn = single ? pn1 : pn2; r.grp = single ? 0 : grp2;
    u = r;
    return ok;
}

DI int perm32(int rho) { const int n = rho >> 4, i = rho & 15; return 8 * (i >> 2) + 4 * n + (i & 3); }
DI void store_bf8(bf16_t* p, f32x4 a, f32x4 b) { u32x4 w; w.x = pk_bf16(a[0], a[1]); w.y = pk_bf16(a[2], a[3]); w.z = pk_bf16(b[0], b[1]); w.w = pk_bf16(b[2], b[3]); *(u32x4*)p = w; }
#define EPI_LOOP(...) \
    _Pragma("unroll") for (int ai = 0; ai < 2; ++ai) _Pragma("unroll") for (int m = 0; m < 4; ++m) { const int row = row0 + ai * HALF + m * 16; \
        _Pragma("unroll") for (int bj = 0; bj < 2; ++bj) { const int col = col0 + bj * HALF; f32x4 v0 = acc[ai][bj][m][0], v1 = acc[ai][bj][m][1]; __VA_ARGS__ } }

DI void epilogue(const Params& P, const GemmDesc& g, const f32x4 (&acc)[2][2][4][2], const Unit& u, int wr, int wc, int fr, int fq) {
    unsigned char* ws_ = P.ws; asm volatile("" : "+s"(ws_));
    unsigned char* ws = ws_;
    const int row0 = u.pm * BM + wr * 64 + fr, col0 = u.pn * BM + wc * 32 + 8 * fq;
    bf16_t* Zb = (bf16_t*)(ws + O_Z);
    bf16_t* AR = (bf16_t*)(ws + O_AR);
    switch (g.mode) {
    case E_Z: { EPI_LOOP( store_bf8(Zb + (size_t)row * 1024 + col, v0, v1); ) } break;
    case E_HID: { EPI_LOOP( _Pragma("unroll") for (int j = 0; j < 4; ++j) { const float t0 = fmaxf(v0[j], 0.f), t1 = fmaxf(v1[j], 0.f); v0[j] = t0 * t0; v1[j] = t1 * t1; } store_bf8(AR + (size_t)row * 4096 + col, v0, v1); ) } break;
    case E_UV: { const float* bin = P.in[6];
        EPI_LOOP( const f32x4 b0 = *(const f32x4*)(bin + col); const f32x4 b1 = *(const f32x4*)(bin + col + 4);
                  _Pragma("unroll") for (int j = 0; j < 4; ++j) { v0[j] = gelu_tanh(v0[j] + b0[j]); v1[j] = gelu_tanh(v1[j] + b1[j]); }
                  bf16_t* dst = (col < 1024) ? (AR + (size_t)row * 1024 + col) : (AR + 16 * MiB + (size_t)row * 1024 + (col - 1024)); store_bf8(dst, v0, v1); ) } break;
    case E_POOL: { const float* sc = P.in[13];
        EPI_LOOP( const int cgc = 256 * u.grp + col; const f32x4 s0 = *(const f32x4*)(sc + cgc); const f32x4 s1 = *(const f32x4*)(sc + cgc + 4); store_bf8(Zb + (size_t)row * 1024 + cgc, v0 * s0, v1 * s1); ) } break;
    case E_LAT: { EPI_LOOP( store_bf8(AR + (size_t)row * 768 + col, v0, v1); ) } break;
    case E_Q: { const float* CS = (const float*)(ws + O_CS); bf16_t* Qb = AR + 24 * MiB;
        EPI_LOOP( const int w = col % 192;
                  if (w >= 128) { const int j = (w - 128) >> 1; const f32x4 c0 = *(const f32x4*)(CS + ((size_t)row * 32 + j) * 2); const f32x4 c1 = *(const f32x4*)(CS + ((size_t)row * 32 + j) * 2 + 4);
                      const float a0 = v0[0] * c0[0] - v0[1] * c0[1]; const float a1 = v0[0] * c0[1] + v0[1] * c0[0]; const float a2 = v0[2] * c0[2] - v0[3] * c0[3]; const float a3 = v0[2] * c0[3] + v0[3] * c0[2];
                      const float e0 = v1[0] * c1[0] - v1[1] * c1[1]; const float e1 = v1[0] * c1[1] + v1[1] * c1[0]; const float e2 = v1[2] * c1[2] - v1[3] * c1[3]; const float e3 = v1[2] * c1[3] + v1[3] * c1[2];
                      v0[0] = a0; v0[1] = a1; v0[2] = a2; v0[3] = a3; v1[0] = e0; v1[1] = e1; v1[2] = e2; v1[3] = e3; }
                  store_bf8(Qb + (size_t)row * 1536 + col, v0 * QSCALE, v1 * QSCALE); ) } break;
    case E_KN: { bf16_t* KN = AR + 48 * MiB; EPI_LOOP( store_bf8(KN + (size_t)row * 1024 + col, v0, v1); ) } break;
    case E_VT: { bf16_t* VT = AR + 64 * MiB; EPI_LOOP( store_bf8(VT + (size_t)row * 16384 + col, v0, v1); ) } break;
    case E_XE: { float* XE = (float*)(ws + O_AR + 96 * MiB);
        EPI_LOOP( if (col < 128) { float* xp = XE + ((size_t)(u.grp * 512 + row)) * 128 + col; *(f32x4*)xp = v0; *(f32x4*)(xp + 4) = v1; } ) } break;
    case E_S5Y: { bf16_t* Y5 = AR + 56 * MiB;
        EPI_LOOP( const int l = col >> 4, c = col & 15; const int token = row * 32 + l; _Pragma("unroll") for (int j = 0; j < 4; ++j) { v0[j] = gelu_tanh(v0[j]); v1[j] = gelu_tanh(v1[j]); }
                  store_bf8(Y5 + (size_t)token * 1024 + u.grp * 16 + c, v0, v1); ) } break;
    case E_GLU: {
#pragma unroll
        for (int ai = 0; ai < 2; ++ai)
#pragma unroll
            for (int m = 0; m < 4; ++m) { const int row = row0 + ai * HALF + m * 16; const int oc = u.pn * 128 + wc * 32 + 8 * fq;
                const f32x4 a0 = acc[ai][0][m][0], a1 = acc[ai][0][m][1], b0 = acc[ai][1][m][0], b1 = acc[ai][1][m][1]; f32x4 v0, v1;
#pragma unroll
                for (int j = 0; j < 4; ++j) { v0[j] = a0[j] / (1.f + __expf(-b0[j])); v1[j] = a1[j] / (1.f + __expf(-b1[j])); }
                store_bf8(Zb + (size_t)row * 1024 + oc, v0, v1); }
    } break;
    default: break;
    }
}

DI void gemm_phase(LAS unsigned char* lds, const Params& P, const GemmDesc g, const int G, const int cidx, int tid) {
    asm volatile("" : "+v"(tid));
    const int wid = __builtin_amdgcn_readfirstlane(tid >> 6), lane = tid & 63, wr = wid >> 2, wc = wid & 3, fr = lane & 15, fq = lane >> 4;
    const int K = g.K, nt = K / BK;
    unsigned voffA[2], voffB[2];
#pragma unroll
    for (int i = 0; i < 2; ++i) { int R, C; stage_rc(tid * 16 + i * 8192, R, C); const int Rb = (R & ~31) + perm32(R & 31); voffA[i] = (unsigned)(R * g.lda + C) * 2u; voffB[i] = (unsigned)(Rb * g.ldb + C) * 2u; }
    const size_t kstep = (size_t)(BK * 2);
    const size_t hstepA = (size_t)HALF * g.lda * 2, hstepB = (size_t)HALF * g.ldb * 2;
    const unsigned ldsw = (unsigned)wid * 1024u;
    const int aoff = lds_byte(wr * 64 + fr, fq * 8), boff = lds_byte(wc * 32 + fr, fq * 8);
#define PG8_SA(b, h) (((b) * 2 + (h)) * HTB)
#define PG8_SB(b, h) ((4 + (b) * 2 + (h)) * HTB)
#define PG8_STAGE(bufoff, gbase, voff) do { _Pragma("unroll") for (int _i = 0; _i < 2; ++_i) \
        __builtin_amdgcn_global_load_lds((const unsigned*)((const char*)(gbase) + (voff)[_i]), (LAS unsigned*)(lds + (bufoff) + ldsw + _i * 8192), 16, 0, 0); } while (0)
#define PG8_LDA(dst, b, h) do { _Pragma("unroll") for (int m = 0; m < 4; ++m) _Pragma("unroll") for (int k = 0; k < 2; ++k) dst[m][k] = *(const LAS bf16x8*)(lds + PG8_SA(b, h) + aoff + m * 2048 + k * 1024); } while (0)
#define PG8_LDB(dst, b, h) do { _Pragma("unroll") for (int n = 0; n < 2; ++n) _Pragma("unroll") for (int k = 0; k < 2; ++k) dst[n][k] = *(const LAS bf16x8*)(lds + PG8_SB(b, h) + boff + n * 2048 + k * 1024); } while (0)
#define PG8_MMA(ai, bj, At, Bt) do { __builtin_amdgcn_s_setprio(1); _Pragma("unroll") for (int m = 0; m < 4; ++m) _Pragma("unroll") for (int n = 0; n < 2; ++n) _Pragma("unroll") for (int k = 0; k < 2; ++k) \
        acc[ai][bj][m][n] = __builtin_amdgcn_mfma_f32_16x16x32_bf16(Bt[n][k], At[m][k], acc[ai][bj][m][n], 0, 0, 0); __builtin_amdgcn_s_setprio(0); } while (0)
#define PG8_WAIT_V(n) asm volatile("s_waitcnt vmcnt(" #n ")" ::: "memory")
#define PG8_WAIT_L(n) asm volatile("s_waitcnt lgkmcnt(" #n ")" ::: "memory")
#define PG8_BAR __builtin_amdgcn_s_barrier()
#define PG8_SCHED __builtin_amdgcn_sched_barrier(0)
    Unit cur, nxt; int ui = 0;
    if (!unit_next(g, 0, G, cidx, cur)) return;
    f32x4 acc[2][2][4][2];
#pragma unroll
    for (int a = 0; a < 2; ++a)
#pragma unroll
        for (int b = 0; b < 2; ++b)
#pragma unroll
            for (int m = 0; m < 4; ++m)
#pragma unroll
                for (int n = 0; n < 2; ++n) acc[a][b][m][n] = (f32x4){0.f, 0.f, 0.f, 0.f};
    bf16x8 At[4][2], B0[2][2], B1[2][2];
    const char* cA = (const char*)g.A + ((size_t)cur.grp * g.a_gs + (size_t)cur.pm * BM * g.lda) * 2;
    const char* cB = (const char*)g.Bt + ((size_t)cur.grp * g.b_gs + (size_t)cur.pn * BM * g.ldb) * 2;
    PG8_STAGE(PG8_SB(0, 0), cB, voffB); PG8_STAGE(PG8_SA(0, 0), cA, voffA); PG8_STAGE(PG8_SB(0, 1), cB + hstepB, voffB); PG8_STAGE(PG8_SA(0, 1), cA + hstepA, voffA);
    if (wr == 1) PG8_BAR;
    PG8_WAIT_V(4); PG8_BAR;
    PG8_STAGE(PG8_SB(1, 0), cB + kstep, voffB); PG8_STAGE(PG8_SA(1, 0), cA + kstep, voffA); PG8_STAGE(PG8_SB(1, 1), cB + hstepB + kstep, voffB);
    PG8_WAIT_V(6); PG8_BAR;
    for (;;) {
        const bool has_next = unit_next(g, ui + 1, G, cidx, nxt);
        const char* nA = has_next ? (const char*)g.A + ((size_t)nxt.grp * g.a_gs + (size_t)nxt.pm * BM * g.lda) * 2 : cA;
        const char* nB = has_next ? (const char*)g.Bt + ((size_t)nxt.grp * g.b_gs + (size_t)nxt.pn * BM * g.ldb) * 2 : cB;
        for (int t = 0; t < nt; t += 2) {
            const bool last = (t == nt - 2);
            const char* a1 = cA + (size_t)(t + 1) * kstep;
            const char* a2 = last ? nA : cA + (size_t)(t + 2) * kstep; const char* b2 = last ? nB : cB + (size_t)(t + 2) * kstep;
            const char* a3 = a2 + kstep; const char* b3 = b2 + kstep;
            PG8_LDB(B0, 0, 0); PG8_SCHED; PG8_LDA(At, 0, 0); PG8_STAGE(PG8_SA(1, 1), a1 + hstepA, voffA);
            PG8_WAIT_L(8); PG8_BAR; PG8_WAIT_L(0); PG8_MMA(0, 0, At, B0); PG8_BAR; PG8_SCHED;
            PG8_LDB(B1, 0, 1); PG8_STAGE(PG8_SB(0, 0), b2, voffB);
            PG8_BAR; PG8_WAIT_L(0); PG8_MMA(0, 1, At, B1); PG8_BAR;
            PG8_LDA(At, 0, 1); PG8_STAGE(PG8_SA(0, 0), a2, voffA);
            PG8_BAR; PG8_WAIT_L(0); PG8_MMA(1, 0, At, B0); PG8_BAR; PG8_SCHED;
            PG8_STAGE(PG8_SB(0, 1), b2 + hstepB, voffB);
            PG8_WAIT_V(6); PG8_BAR; PG8_MMA(1, 1, At, B1); PG8_BAR;
            PG8_LDB(B0, 1, 0); PG8_SCHED; PG8_LDA(At, 1, 0); PG8_STAGE(PG8_SA(0, 1), a2 + hstepA, voffA);
            PG8_WAIT_L(8); PG8_BAR; PG8_WAIT_L(0); PG8_MMA(0, 0, At, B0); PG8_BAR; PG8_SCHED;
            PG8_LDB(B1, 1, 1); PG8_STAGE(PG8_SB(1, 0), b3, voffB);
            PG8_BAR; PG8_WAIT_L(0); PG8_MMA(0, 1, At, B1); PG8_BAR;
            PG8_LDA(At, 1, 1); PG8_STAGE(PG8_SA(1, 0), a3, voffA);
            PG8_BAR; PG8_WAIT_L(0); PG8_MMA(1, 0, At, B0); PG8_BAR; PG8_SCHED;
            PG8_STAGE(PG8_SB(1, 1), b3 + hstepB, voffB);
            PG8_WAIT_V(6); PG8_BAR; PG8_MMA(1, 1, At, B1); PG8_BAR;
        }
        epilogue(P, g, acc, cur, wr, wc, fr, fq);
        if (!has_next) break;
#pragma unroll
        for (int a = 0; a < 2; ++a)
#pragma unroll
            for (int b = 0; b < 2; ++b)
#pragma unroll
                for (int m = 0; m < 4; ++m)
#pragma unroll
                    for (int n = 0; n < 2; ++n) acc[a][b][m][n] = (f32x4){0.f, 0.f, 0.f, 0.f};
        cur = nxt; cA = nA; cB = nB; ++ui;
    }
    PG8_WAIT_V(0);
    if (wr == 0) PG8_BAR;
    PG8_BAR;
}

DI bool get_gemm(const Params& P, int st, GemmDesc& g) {
    unsigned char* ws_ = P.ws; asm volatile("" : "+s"(ws_));
    unsigned char* ws = ws_;
    const bf16_t* XN = (const bf16_t*)(ws + O_XN);
    const bf16_t* WMIX = (const bf16_t*)(ws + O_WMIX);
    const bf16_t* AR = (const bf16_t*)(ws + O_AR);
    g.a_gs = 0; g.b_gs = 0; g.ngrp = 1; g.nM = 64; g.K = 1024; g.lda = 1024; g.ldb = 1024; g.A = XN; g.Bt = WMIX; g.nN = 4; g.mode = E_Z;
    switch (st) {
    case 1: g.nN = 8; g.mode = E_UV; return true;
    case 4: g.A = AR + 32 * MiB; g.Bt = WMIX + 2 * MiB; return true;
    case 6: case 12: case 23: case 31: g.Bt = (const bf16_t*)(ws + O_WUP); g.nN = 16; g.mode = E_HID; return true;
    case 7: case 13: case 24: case 32: g.A = AR; g.Bt = (const bf16_t*)(ws + O_WDN); g.K = 4096; g.lda = 4096; g.ldb = 4096; return true;
    case 10: g.A = AR + 32 * MiB; g.K = 256; g.ldb = 256; g.nN = 1; g.ngrp = 4; g.a_gs = 256; g.b_gs = 65536; g.mode = E_POOL; return true;
    case 15: g.nN = 3; g.mode = E_LAT; return true;
    case 17: g.A = AR + 12 * MiB; g.Bt = WMIX + 1 * MiB; g.K = 384; g.lda = 384; g.ldb = 384; g.nN = 6; g.mode = E_Q; return true;
    case 18: g.A = AR + 18 * MiB; g.Bt = WMIX + 2 * MiB; g.K = 256; g.lda = 256; g.ldb = 256; g.nN = 4; g.mode = E_KN; return true;
    case 19: g.A = WMIX + (5 * MiB) / 2; g.Bt = AR + 18 * MiB; g.K = 256; g.lda = 256; g.ldb = 256; g.nM = 4; g.nN = 64; g.mode = E_VT; return true;
    case 21: g.Bt = WMIX + 3 * MiB; return true;
    case 26: g.A = AR; g.Bt = AR + 40 * MiB; g.K = 512; g.lda = 640; g.ldb = 512; g.nM = 2; g.nN = 1; g.ngrp = 64; g.a_gs = 512 * 640; g.b_gs = 256 * 512; g.mode = E_XE; return true;
    case 28: g.A = AR; g.Bt = AR + 20 * MiB; g.K = 640; g.lda = 640; g.ldb = 640; g.nM = 2; g.nN = 2; g.ngrp = 64; g.a_gs = 512 * 640; g.b_gs = 512 * 640; g.mode = E_S5Y; return true;
    case 29: g.A = AR + 56 * MiB; g.nN = 8; g.mode = E_GLU; return true;
    default: return false;
    }
}

enum { RP_BF = 0, RP_F32 = 1, RP_S5 = 2, RP_FINAL = 3 };
template <int MODE>
DI void row_pass(const float* hin, float* hout, const bf16_t* z, const float* gpost, const float* gpre, void* outp, int gw, int NGW, int lane) {
    asm volatile("" : "+v"(lane));
    for (int rowa = gw; rowa < S; rowa += 2 * NGW) {
        f32x4 h[2][4];
#pragma unroll
        for (int q = 0; q < 2; ++q) { const int row = rowa + q * NGW;
#pragma unroll
            for (int j = 0; j < 4; ++j) { const int cb = (MODE == RP_S5) ? 16 * lane + 4 * j : 4 * lane + 256 * j; h[q][j] = *(const f32x4*)(hin + (size_t)row * 1024 + cb); } }
        if (z) {
            f32x4 zz[2][4]; float ss[2] = {0.f, 0.f};
#pragma unroll
            for (int q = 0; q < 2; ++q) { const int row = rowa + q * NGW;
#pragma unroll
                for (int j = 0; j < 4; ++j) { const int cb = (MODE == RP_S5) ? 16 * lane + 4 * j : 4 * lane + 256 * j; const u32x2 w = *(const u32x2*)(z + (size_t)row * 1024 + cb);
                    zz[q][j] = (f32x4){bflo(w.x), bfhi(w.x), bflo(w.y), bfhi(w.y)}; ss[q] += zz[q][j][0] * zz[q][j][0] + zz[q][j][1] * zz[q][j][1] + zz[q][j][2] * zz[q][j][2] + zz[q][j][3] * zz[q][j][3]; } }
#pragma unroll
            for (int q = 0; q < 2; ++q) { const int row = rowa + q * NGW;
                const float rz = rsqrtf(wave_sum(ss[q], lane) * (1.f / 1024.f) + RMS_EPS);
#pragma unroll
                for (int j = 0; j < 4; ++j) { const int cb = (MODE == RP_S5) ? 16 * lane + 4 * j : 4 * lane + 256 * j; const f32x4 gp = *(const f32x4*)(gpost + cb); h[q][j] += zz[q][j] * rz * gp;
                    *(f32x4*)(hout + (size_t)row * 1024 + cb) = h[q][j]; } }
        }
        if (MODE != RP_FINAL) {
#pragma unroll
            for (int q = 0; q < 2; ++q) { const int row = rowa + q * NGW;
                float s2 = 0.f;
#pragma unroll
                for (int j = 0; j < 4; ++j) s2 += h[q][j][0] * h[q][j][0] + h[q][j][1] * h[q][j][1] + h[q][j][2] * h[q][j][2] + h[q][j][3] * h[q][j][3];
                const float rn = rsqrtf(wave_sum(s2, lane) * (1.f / 1024.f) + RMS_EPS);
#pragma unroll
                for (int j = 0; j < 4; ++j) { const int cb = (MODE == RP_S5) ? 16 * lane + 4 * j : 4 * lane + 256 * j; const f32x4 gq = *(const f32x4*)(gpre + cb); const f32x4 xn = h[q][j] * rn * gq;
                    if (MODE == RP_BF) store_bf4((bf16_t*)outp + (size_t)row * 1024 + cb, xn);
                    if (MODE == RP_F32) *(f32x4*)((float*)outp + (size_t)row * 1024 + cb) = xn;
                    if (MODE == RP_S5) store_bf4((bf16_t*)outp + ((size_t)(lane * 512 + (row >> 5))) * 640 + (row & 31) * 16 + 4 * j, xn); } }
        }
    }
}

enum { MAP_ID = 0, MAP_UQ = 1, MAP_GLUA = 2, MAP_GLUB = 3 };
DI int dstrow(int mode, int n) {
    if (mode == MAP_UQ) { const int hd = n / 192, w = n - hd * 192; if (w < 128) return n; const int r = w - 128; return hd * 192 + 128 + 2 * (r & 31) + (r >> 5); }
    if (mode == MAP_GLUA) return (n >> 7) * 256 + (n & 127);
    if (mode == MAP_GLUB) return (n >> 7) * 256 + 128 + (n & 127);
    return n;
}
DI void convT(const float* src, int K, int N, bf16_t* dst, int ldT, int mapmode, int gw, int NGW, int lane) {
    asm volatile("" : "+v"(lane));
    const int nnb = N >> 4, nitems = nnb * (K >> 5);
    for (int it = gw; it < nitems; it += NGW) {
        const int kb = it / nnb, nb = it - kb * nnb;
        const int n = nb * 16 + (lane >> 2), k = kb * 32 + 8 * (lane & 3);
        const float* s = src + (size_t)k * N + n;
        float v[8];
#pragma unroll
        for (int i = 0; i < 8; ++i) v[i] = s[(size_t)i * N];
        u32x4 o; o.x = pk_bf16(v[0], v[1]); o.y = pk_bf16(v[2], v[3]); o.z = pk_bf16(v[4], v[5]); o.w = pk_bf16(v[6], v[7]);
        *(u32x4*)(dst + (size_t)dstrow(mapmode, n) * ldT + k) = o;
    }
}
DI void conv_layer(const Params& P, int L, int gw, int NGW, int lane) {
    unsigned char* ws_ = P.ws; asm volatile("" : "+s"(ws_));
    unsigned char* ws = ws_;
    bf16_t* WMIX = (bf16_t*)(ws + O_WMIX);
    convT(P.in[3] + (size_t)L * 1024 * 4096, 1024, 4096, (bf16_t*)(ws + O_WUP), 1024, MAP_ID, gw, NGW, lane);
    convT(P.in[4] + (size_t)L * 1024 * 4096, 4096, 1024, (bf16_t*)(ws + O_WDN), 4096, MAP_ID, gw, NGW, lane);
    if (L == 0) {
        convT(P.in[5], 1024, 2048, WMIX, 1024, MAP_ID, gw, NGW, lane);
        convT(P.in[11], 1024, 1024, WMIX + 2 * MiB, 1024, MAP_ID, gw, NGW, lane);
        const float* wsrc = P.in[9]; bf16_t* wd = WMIX + 3 * MiB;
        for (int e = gw * 64 + lane; e < 8 * 128 * 128 / 4; e += NGW * 64) { const int s0 = (e * 4) & 127, t = ((e * 4) >> 7) & 127; f32x4 w = *(const f32x4*)(wsrc + (size_t)e * 4);
#pragma unroll
            for (int j = 0; j < 4; ++j) if (s0 + j > t) w[j] = 0.f;
            store_bf4(wd + (size_t)e * 4, w); }
    } else if (L == 1) {
        for (int gg = 0; gg < 4; ++gg) convT(P.in[12] + gg * 65536, 256, 256, WMIX + gg * 65536, 256, MAP_ID, gw, NGW, lane);
    } else if (L == 2) {
        convT(P.in[14], 1024, 384, WMIX, 1024, MAP_ID, gw, NGW, lane);
        convT(P.in[17], 1024, 320, WMIX + 384 * 1024, 1024, MAP_ID, gw, NGW, lane);
        convT(P.in[16], 384, 1536, WMIX + 1 * MiB, 384, MAP_UQ, gw, NGW, lane);
        convT(P.in[19], 256, 1024, WMIX + 2 * MiB, 256, MAP_ID, gw, NGW, lane);
        convT(P.in[20], 256, 1024, WMIX + (5 * MiB) / 2, 256, MAP_ID, gw, NGW, lane);
        convT(P.in[21], 1024, 1024, WMIX + 3 * MiB, 1024, MAP_ID, gw, NGW, lane);
    } else {
        convT(P.in[30], 1024, 1024, WMIX, 1024, MAP_GLUA, gw, NGW, lane);
        convT(P.in[31], 1024, 1024, WMIX, 1024, MAP_GLUB, gw, NGW, lane);
    }
}

DI void lnv_phase(const Params& P, int gw, int NGW, int lane) {
    unsigned char* ws_ = P.ws; asm volatile("" : "+s"(ws_));
    asm volatile("" : "+v"(lane));
    bf16_t* V = (bf16_t*)(ws_ + O_AR + 32 * MiB);
    const float* gv = P.in[7]; const float* bv = P.in[8];
    for (int row = gw; row < S; row += NGW) {
        f32x4 x[4]; float s = 0.f;
#pragma unroll
        for (int j = 0; j < 4; ++j) { const u32x2 w = *(const u32x2*)(V + (size_t)row * 1024 + 4 * lane + 256 * j); x[j] = (f32x4){bflo(w.x), bfhi(w.x), bflo(w.y), bfhi(w.y)}; s += x[j][0] + x[j][1] + x[j][2] + x[j][3]; }
        const float mu = wave_sum(s, lane) * (1.f / 1024.f); float s2 = 0.f;
#pragma unroll
        for (int j = 0; j < 4; ++j) { x[j] = x[j] - mu; s2 += x[j][0] * x[j][0] + x[j][1] * x[j][1] + x[j][2] * x[j][2] + x[j][3] * x[j][3]; }
        const float rs = rsqrtf(wave_sum(s2, lane) * (1.f / 1024.f) + RMS_EPS);
#pragma unroll
        for (int j = 0; j < 4; ++j) { const int cb = 4 * lane + 256 * j; const f32x4 g4 = *(const f32x4*)(gv + cb), b4 = *(const f32x4*)(bv + cb); store_bf4(V + (size_t)row * 1024 + cb, x[j] * rs * g4 + b4); }
    }
}

DI void gate_phase(const Params& P, LAS unsigned char* lds, int tid, int wid, int lane, int bid) {
    unsigned char* ws_ = P.ws; asm volatile("" : "+s"(ws_));
    asm volatile("" : "+v"(tid)); lane = tid & 63; wid = __builtin_amdgcn_readfirstlane(tid >> 6);
    LAS bf16_t* Wt = (LAS bf16_t*)lds;
    LAS bf16_t* Vt = Wt + 128 * 136;
    const bf16_t* Wsb = (const bf16_t*)(ws_ + O_WMIX + 6 * MiB);
    const bf16_t* U = (const bf16_t*)(ws_ + O_AR);
    const bf16_t* V = (const bf16_t*)(ws_ + O_AR + 32 * MiB);
    bf16_t* Y = (bf16_t*)(ws_ + O_AR + 64 * MiB);
    const float* bs = P.in[10];
    const int r16 = lane & 15, quad = lane >> 4;
    for (int item = bid; item < 1024; item += gridDim.x) {
        const int hd = item & 7, c = item >> 3;
        __syncthreads();
#pragma unroll
        for (int i = 0; i < 4; ++i) { const int cid = tid + 512 * i, t = cid >> 4, sc = cid & 15;
            const u32x4 w = *(const u32x4*)(Wsb + ((size_t)(hd * 128 + t)) * 128 + 8 * sc); *(LAS u32x4*)(Wt + t * 136 + 8 * sc) = w; }
#pragma unroll
        for (int i = 0; i < 4; ++i) { const int cid = tid + 512 * i, s = cid >> 4, dc = cid & 15;
            const u32x4 w = *(const u32x4*)(V + ((size_t)(c * 128 + s)) * 1024 + hd * 128 + 8 * dc);
#pragma unroll
            for (int e = 0; e < 8; ++e) Vt[(8 * dc + e) * 136 + s] = (bf16_t)((e & 1) ? (w[e >> 1] >> 16) : (w[e >> 1] & 0xffffu)); }
        __syncthreads();
        const int t = 16 * wid + r16;
        const int nks = (16 * wid + 15) / 32 + 1;
        bf16x8 bw[4];
#pragma unroll
        for (int ks = 0; ks < 4; ++ks) bw[ks] = *(const LAS bf16x8*)(Wt + t * 136 + 32 * ks + 8 * quad);
        const int token = c * 128 + t;
        const float bias = bs[hd * 128 + t];
#pragma unroll
        for (int dt = 0; dt < 8; ++dt) {
            f32x4 acc = {0.f, 0.f, 0.f, 0.f};
#pragma unroll
            for (int ks = 0; ks < 4; ++ks) if (ks < nks) {
                const bf16x8 a = *(const LAS bf16x8*)(Vt + (16 * dt + r16) * 136 + 32 * ks + 8 * quad);
                acc = __builtin_amdgcn_mfma_f32_16x16x32_bf16(a, bw[ks], acc, 0, 0, 0); }
            const int col = hd * 128 + 16 * dt + 4 * quad;
            const u32x2 uu = *(const u32x2*)(U + (size_t)token * 1024 + col);
            f32x4 y; y[0] = (acc[0] + bias) * bflo(uu.x); y[1] = (acc[1] + bias) * bfhi(uu.x); y[2] = (acc[2] + bias) * bflo(uu.y); y[3] = (acc[3] + bias) * bfhi(uu.y);
            store_bf4(Y + (size_t)token * 1024 + col, y);
        }
    }
}

DI void pool_phase(const Params& P, int gtid, int nthreads) {
    unsigned char* ws_ = P.ws; asm volatile("" : "+s"(ws_));
    asm volatile("" : "+v"(gtid));
    const float* ZF = (const float*)(ws_ + O_AR);
    bf16_t* Pb = (bf16_t*)(ws_ + O_AR + 64 * MiB);
    for (int e = gtid; e < 1024 * 256; e += nthreads) {
        const int cgi = e & 255, tb = e >> 8, col = 4 * cgi, w = 2 << (cgi >> 6), t0 = 16 * tb;
        f32x4 W = {0.f, 0.f, 0.f, 0.f};
        for (int j = 1; j < w; ++j) if (t0 - j >= 0) W += *(const f32x4*)(ZF + (size_t)(t0 - j) * 1024 + col);
        for (int i = 0; i < 16; ++i) { const int t = t0 + i; const f32x4 z = *(const f32x4*)(ZF + (size_t)t * 1024 + col); W += z;
            const float cnt = (float)((t + 1 < w) ? (t + 1) : w); const f32x4 o = W / cnt - z; store_bf4(Pb + (size_t)t * 1024 + col, o);
            if (t - w + 1 >= 0) W -= *(const f32x4*)(ZF + (size_t)(t - w + 1) * 1024 + col); }
    }
}

DI void mla_rows(const Params& P, int gw, int NGW, int lane) {
    unsigned char* ws_ = P.ws; asm volatile("" : "+s"(ws_));
    asm volatile("" : "+v"(lane));
    unsigned char* ar = ws_ + O_AR;
    const bf16_t* LAT = (const bf16_t*)ar; bf16_t* QL = (bf16_t*)(ar + 24 * MiB); bf16_t* Cb = (bf16_t*)(ar + 36 * MiB); bf16_t* KR = (bf16_t*)(ar + 44 * MiB);
    const float* CS = (const float*)(ws_ + O_CS); const float* gq = P.in[15]; const float* gkv = P.in[18];
    for (int row = gw; row < S; row += NGW) {
        const bf16_t* lat = LAT + (size_t)row * 768;
        float q[6]; float ss = 0.f;
#pragma unroll
        for (int i = 0; i < 3; ++i) { const unsigned w = *(const unsigned*)(lat + 2 * lane + 128 * i); q[2 * i] = bflo(w); q[2 * i + 1] = bfhi(w); ss += q[2 * i] * q[2 * i] + q[2 * i + 1] * q[2 * i + 1]; }
        ss = wave_sum(ss, lane); const float rq = rsqrtf(ss * (1.f / 384.f) + RMS_EPS);
#pragma unroll
        for (int i = 0; i < 3; ++i) { const f32x2 g2 = *(const f32x2*)(gq + 2 * lane + 128 * i); *(unsigned*)(QL + (size_t)row * 384 + 2 * lane + 128 * i) = pk_bf16(q[2 * i] * rq * g2.x, q[2 * i + 1] * rq * g2.y); }
        float cc[4]; float s2 = 0.f;
#pragma unroll
        for (int i = 0; i < 2; ++i) { const unsigned w = *(const unsigned*)(lat + 384 + 2 * lane + 128 * i); cc[2 * i] = bflo(w); cc[2 * i + 1] = bfhi(w); s2 += cc[2 * i] * cc[2 * i] + cc[2 * i + 1] * cc[2 * i + 1]; }
        s2 = wave_sum(s2, lane); const float rc = rsqrtf(s2 * (1.f / 256.f) + RMS_EPS);
#pragma unroll
        for (int i = 0; i < 2; ++i) { const f32x2 g2 = *(const f32x2*)(gkv + 2 * lane + 128 * i); *(unsigned*)(Cb + (size_t)row * 256 + 2 * lane + 128 * i) = pk_bf16(cc[2 * i] * rc * g2.x, cc[2 * i + 1] * rc * g2.y); }
        if (lane < 32) { const float x1 = bf2f(lat[640 + lane]), x2 = bf2f(lat[672 + lane]); const f32x2 cs = *(const f32x2*)(CS + ((size_t)row * 32 + lane) * 2);
            *(unsigned*)(KR + (size_t)row * 64 + 2 * lane) = pk_bf16(x1 * cs.x - x2 * cs.y, x1 * cs.y + x2 * cs.x); }
    }
}

#define MFMA32(a, b, c) __builtin_amdgcn_mfma_f32_32x32x16_bf16((a), (b), (c), 0, 0, 0)
DI int crow(int reg, int h) { return (reg & 3) + 8 * (reg >> 2) + 4 * h; }

DI void attn_phase(const Params& P, LAS unsigned char* lds, int tid, int wid, int lane, int bid) {
    unsigned char* ws_ = P.ws; asm volatile("" : "+s"(ws_));
    asm volatile("" : "+v"(tid)); lane = tid & 63; wid = __builtin_amdgcn_readfirstlane(tid >> 6);
    unsigned char* ar = ws_ + O_AR;
    const bf16_t* Q = (const bf16_t*)(ar + 48 * MiB); const bf16_t* KN = (const bf16_t*)(ar + 96 * MiB); const bf16_t* VT = (const bf16_t*)(ar + 128 * MiB); const bf16_t* KR = (const bf16_t*)(ar + 44 * MiB);
    bf16_t* AO = (bf16_t*)(ws_ + O_XN);
    const int l32 = lane & 31, h2 = lane >> 5;
    constexpr int BUFB = 43008, VOFF = 25600;
    const unsigned kn_off0 = (unsigned)(((tid >> 4) * 1024 + 8 * (tid & 15)) * 2);
    const unsigned kr_off = (unsigned)(((tid >> 3) * 64 + 8 * (tid & 7)) * 2);
    const unsigned vt_off0 = (unsigned)(((tid >> 3) * 16384 + 8 * (tid & 7)) * 2);
    const unsigned kn_l0 = (unsigned)((tid >> 4) * 400 + 16 * (tid & 15));
    const unsigned kr_l = (unsigned)((tid >> 3) * 400 + 256 + 16 * (tid & 7));
    const unsigned vt_l0 = (unsigned)(25600 + (tid >> 3) * 136 + 16 * (tid & 7));
    for (int item = bid; item < 256; item += gridDim.x) {
        const int head = item & 7, pair = item >> 3;
        for (int half = 0; half < 2; ++half) {
            const int qb = half ? 63 - pair : pair;
            const int wrow0 = qb * 256 + wid * 32, qrow = wrow0 + l32;
            bf16x8 Qf[12];
#pragma unroll
            for (int s = 0; s < 12; ++s) Qf[s] = *(const bf16x8*)(Q + (size_t)qrow * 1536 + head * 192 + 16 * s + 8 * h2);
            f32x16 o[4];
#pragma unroll
            for (int d = 0; d < 4; ++d)
#pragma unroll
                for (int r = 0; r < 16; ++r) o[d][r] = 0.f;
            float mrun = -INFINITY, lsum = 0.f;
            const int ntiles = 4 * (qb + 1);
            u32x4 kreg[3], vreg[2];
#define ATT_ISSUE(kt) do { \
    unsigned o0_ = kn_off0, o1_ = kr_off, o2_ = vt_off0; asm volatile("" : "+v"(o0_), "+v"(o1_), "+v"(o2_)); \
    const char* knb = (const char*)(KN + (size_t)(kt) * 65536 + head * 128); const char* krb = (const char*)(KR + (size_t)(kt) * 4096); \
    const char* vtb = (const char*)(VT + (size_t)head * 128 * 16384 + 64 * (kt)); \
    kreg[0] = *(const u32x4*)(knb + o0_); kreg[1] = *(const u32x4*)(knb + 65536 + o0_); kreg[2] = *(const u32x4*)(krb + o1_); \
    vreg[0] = *(const u32x4*)(vtb + o2_); vreg[1] = *(const u32x4*)(vtb + 2097152 + o2_); } while (0)
#define ATT_WRITE(b) do { LAS unsigned char* base = lds + (b) * BUFB; \
    *(LAS u32x4*)(base + kn_l0) = kreg[0]; *(LAS u32x4*)(base + kn_l0 + 12800) = kreg[1]; *(LAS u32x4*)(base + kr_l) = kreg[2]; \
    *(LAS u32x2*)(base + vt_l0) = (u32x2){vreg[0].x, vreg[0].y}; *(LAS u32x2*)(base + vt_l0 + 8) = (u32x2){vreg[0].z, vreg[0].w}; \
    *(LAS u32x2*)(base + vt_l0 + 8704) = (u32x2){vreg[1].x, vreg[1].y}; *(LAS u32x2*)(base + vt_l0 + 8712) = (u32x2){vreg[1].z, vreg[1].w}; } while (0)
            ATT_ISSUE(0); ATT_WRITE(0); __syncthreads();
            for (int kt = 0; kt < ntiles; ++kt) {
                const bool more = (kt + 1 < ntiles);
                if (more) ATT_ISSUE(kt + 1);
                if (64 * kt <= wrow0 + 31) {
                    LAS unsigned char* base = lds + (kt & 1) * BUFB;
                    f32x16 st0, st1;
#pragma unroll
                    for (int r = 0; r < 16; ++r) { st0[r] = 0.f; st1[r] = 0.f; }
                    {
                        const LAS unsigned char* kp = base + l32 * 400 + 16 * h2;
                        bf16x8 ka[2][4];
#define ATT_LDK(bf, gq) do { _Pragma("unroll") for (int sl = 0; sl < 2; ++sl) { ka[bf][2 * sl] = *(const LAS bf16x8*)(kp + 32 * (2 * (gq) + sl)); ka[bf][2 * sl + 1] = *(const LAS bf16x8*)(kp + 12800 + 32 * (2 * (gq) + sl)); } } while (0)
#define ATT_MMK(bf, gq) do { _Pragma("unroll") for (int sl = 0; sl < 2; ++sl) { st0 = MFMA32(ka[bf][2 * sl], Qf[2 * (gq) + sl], st0); st1 = MFMA32(ka[bf][2 * sl + 1], Qf[2 * (gq) + sl], st1); } } while (0)
                        ATT_LDK(0, 0); __builtin_amdgcn_sched_barrier(0);
                        ATT_LDK(1, 1); __builtin_amdgcn_sched_barrier(0);
                        ATT_MMK(0, 0); __builtin_amdgcn_sched_barrier(0);
                        ATT_LDK(0, 2); __builtin_amdgcn_sched_barrier(0);
                        ATT_MMK(1, 1); __builtin_amdgcn_sched_barrier(0);
                        ATT_LDK(1, 3); __builtin_amdgcn_sched_barrier(0);
                        ATT_MMK(0, 2); __builtin_amdgcn_sched_barrier(0);
                        ATT_LDK(0, 4); __builtin_amdgcn_sched_barrier(0);
                        ATT_MMK(1, 3); __builtin_amdgcn_sched_barrier(0);
                        ATT_LDK(1, 5); __builtin_amdgcn_sched_barrier(0);
                        ATT_MMK(0, 4); __builtin_amdgcn_sched_barrier(0);
                        ATT_MMK(1, 5); __builtin_amdgcn_sched_barrier(0);
#undef ATT_LDK
#undef ATT_MMK
                    }
                    if (64 * kt + 63 > wrow0) {
#pragma unroll
                        for (int r = 0; r < 16; ++r) { const int key0 = 64 * kt + crow(r, h2); if (key0 > qrow) st0[r] = -INFINITY; if (key0 + 32 > qrow) st1[r] = -INFINITY; }
                    }
                    float mx = st0[0];
#pragma unroll
                    for (int r = 1; r < 16; ++r) mx = fmaxf(mx, st0[r]);
#pragma unroll
                    for (int r = 0; r < 16; ++r) mx = fmaxf(mx, st1[r]);
                    mx = fmaxf(mx, shx(mx, 32, lane));
                    const float mn = fmaxf(mrun, mx);
                    const float alpha = __builtin_amdgcn_exp2f(mrun - mn);
                    mrun = mn;
                    float psum = 0.f;
#pragma unroll
                    for (int r = 0; r < 16; ++r) { st0[r] = __builtin_amdgcn_exp2f(st0[r] - mn); st1[r] = __builtin_amdgcn_exp2f(st1[r] - mn); psum += st0[r] + st1[r]; }
                    lsum = lsum * alpha + psum;
                    if (__builtin_amdgcn_ballot_w64(alpha != 1.f) != 0ull) {
#pragma unroll
                        for (int d = 0; d < 4; ++d)
#pragma unroll
                            for (int r = 0; r < 16; ++r) o[d][r] *= alpha;
                    }
                    {
                        const LAS unsigned char* vb = base + VOFF + l32 * 136 + 8 * h2;
                        u32x4 va[2][4];
#define ATT_LDV(bf, stp) do { _Pragma("unroll") for (int d = 0; d < 4; ++d) { const LAS unsigned char* vp = vb + d * 4352 + 32 * (stp); \
        const u32x2 lo = *(const LAS u32x2*)vp, hi = *(const LAS u32x2*)(vp + 16); va[bf][d] = (u32x4){lo.x, lo.y, hi.x, hi.y}; } } while (0)
#define ATT_MMV(bf, stv, sp) do { u32x4 pw; pw.x = pk_bf16(stv[8 * (sp)], stv[8 * (sp) + 1]); pw.y = pk_bf16(stv[8 * (sp) + 2], stv[8 * (sp) + 3]); pw.z = pk_bf16(stv[8 * (sp) + 4], stv[8 * (sp) + 5]); pw.w = pk_bf16(stv[8 * (sp) + 6], stv[8 * (sp) + 7]); \
        const bf16x8 pf = __builtin_bit_cast(bf16x8, pw); _Pragma("unroll") for (int d = 0; d < 4; ++d) o[d] = MFMA32(__builtin_bit_cast(bf16x8, va[bf][d]), pf, o[d]); } while (0)
                        ATT_LDV(0, 0); __builtin_amdgcn_sched_barrier(0);
                        ATT_LDV(1, 1); __builtin_amdgcn_sched_barrier(0);
                        ATT_MMV(0, st0, 0); __builtin_amdgcn_sched_barrier(0);
                        ATT_LDV(0, 2); __builtin_amdgcn_sched_barrier(0);
                        ATT_MMV(1, st0, 1); __builtin_amdgcn_sched_barrier(0);
                        ATT_LDV(1, 3); __builtin_amdgcn_sched_barrier(0);
                        ATT_MMV(0, st1, 0); __builtin_amdgcn_sched_barrier(0);
                        ATT_MMV(1, st1, 1); __builtin_amdgcn_sched_barrier(0);
#undef ATT_LDV
#undef ATT_MMV
                    }
                }
                if (more) ATT_WRITE((kt + 1) & 1);
                __syncthreads();
            }
            int t2_ = tid; asm volatile("" : "+v"(t2_));
            const int qrow2 = qb * 256 + (t2_ >> 6) * 32 + (t2_ & 31), h2b = (t2_ >> 5) & 1;
            const float ltot = lsum + shx(lsum, 32, lane);
            const float inv = 1.f / ltot;
#pragma unroll
            for (int d = 0; d < 4; ++d)
#pragma unroll
                for (int rg = 0; rg < 4; ++rg) { f32x4 v = {o[d][4 * rg] * inv, o[d][4 * rg + 1] * inv, o[d][4 * rg + 2] * inv, o[d][4 * rg + 3] * inv};
                    store_bf4(AO + (size_t)qrow2 * 1024 + head * 128 + d * 32 + 8 * rg + 4 * h2b, v); }
        }
    }
#undef ATT_ISSUE
#undef ATT_WRITE
}

DI void s5_precompute(const Params& P, LAS unsigned char* lds, int tid, int bid) {
    unsigned char* ws_ = P.ws; asm volatile("" : "+s"(ws_));
    asm volatile("" : "+v"(tid));
    LAS float* PWr = (LAS float*)lds;
    LAS float* PWi = PWr + 33 * 64;
    LAS float* BBr = PWi + 33 * 64;
    LAS float* BBi = BBr + 1024;
    LAS float* CRe = BBi + 1024;
    LAS float* CIm = CRe + 1024;
    LAS float* KT = CIm + 1024;
    const float* lam_re = P.in[22]; const float* lam_im = P.in[23]; const float* log_dt = P.in[24];
    const float* b_re = P.in[25]; const float* b_im = P.in[26]; const float* c_re = P.in[27]; const float* c_im = P.in[28]; const float* dsk = P.in[29];
    bf16_t* TF = (bf16_t*)(ws_ + O_AR + 40 * MiB); bf16_t* Eb = (bf16_t*)(ws_ + O_AR + 80 * MiB);
    for (int item = bid; item < 256; item += gridDim.x) {
        const int g = item >> 2, q = item & 3;
        __syncthreads();
        const float dt = expf(log_dt[g]);
        for (int e = tid; e < 33 * 64; e += 512) { const int j = e >> 6, p = e & 63; const float lr = lam_re[g * 64 + p], li = lam_im[g * 64 + p];
            const float mag = expf((float)j * (lr * dt)); float sn, cs; sincosf((float)j * (li * dt), &sn, &cs); PWr[e] = mag * cs; PWi[e] = mag * sn; }
        for (int e = tid; e < 1024; e += 512) { const int p = e >> 4; const float lr = lam_re[g * 64 + p], li = lam_im[g * 64 + p];
            const float mag = expf(lr * dt); float sn, cs; sincosf(li * dt, &sn, &cs); const float ar = mag * cs, ai = mag * sn;
            const float den = lr * lr + li * li; const float fre = ((ar - 1.f) * lr + ai * li) / den, fim = (ai * lr - (ar - 1.f) * li) / den;
            const float br = b_re[(size_t)g * 1024 + e], bi = b_im[(size_t)g * 1024 + e];
            BBr[e] = fre * br - fim * bi; BBi[e] = fre * bi + fim * br; }
        for (int e = tid; e < 1024; e += 512) { CRe[e] = c_re[(size_t)g * 1024 + e]; CIm[e] = c_im[(size_t)g * 1024 + e]; }
        __syncthreads();
        for (int e = tid; e < 8192; e += 512) { const int j = e >> 8, co = (e >> 4) & 15, ci = e & 15; float a = 0.f;
            for (int p = 0; p < 64; ++p) { const float cr = CRe[co * 64 + p], cm = CIm[co * 64 + p], pr = PWr[j * 64 + p], pi = PWi[j * 64 + p];
                const float wr_ = cr * pr - cm * pi, wi_ = cr * pi + cm * pr; a += wr_ * BBr[p * 16 + ci] - wi_ * BBi[p * 16 + ci]; }
            if (j == 0 && co == ci) a += dsk[g * 16 + co];
            KT[e] = a; }
        __syncthreads();
        for (int e = tid; e < 128 * 80; e += 512) { const int rr = e / 80, kc = e - rr * 80, n = 128 * q + rr, l = n >> 4, co = n & 15; float v[8];
            if (kc < 64) { const int lp = kc >> 1;
#pragma unroll
                for (int i = 0; i < 8; ++i) v[i] = (lp <= l) ? KT[((l - lp) * 16 + co) * 16 + 8 * (kc & 1) + i] : 0.f;
            } else {
                const bool im = kc >= 72; const int p0 = 8 * (kc - (im ? 72 : 64));
#pragma unroll
                for (int i = 0; i < 8; ++i) { const int p = p0 + i; const float cr = CRe[co * 64 + p], cm = CIm[co * 64 + p], pr = PWr[(l + 1) * 64 + p], pi = PWi[(l + 1) * 64 + p];
                    v[i] = im ? -(cr * pi + cm * pr) : (cr * pr - cm * pi); }
            }
            u32x4 o; o.x = pk_bf16(v[0], v[1]); o.y = pk_bf16(v[2], v[3]); o.z = pk_bf16(v[4], v[5]); o.w = pk_bf16(v[6], v[7]);
            *(u32x4*)(TF + ((size_t)(g * 512 + n)) * 640 + 8 * kc) = o; }
        for (int e = tid; e < 32 * 64; e += 512) { const int n = 32 * q + (e >> 6), kc = e & 63, p = n & 63, im = n >> 6, lp = kc >> 1; float v[8];
            const float pr = PWr[(31 - lp) * 64 + p], pi = PWi[(31 - lp) * 64 + p];
#pragma unroll
            for (int i = 0; i < 8; ++i) { const int ci = 8 * (kc & 1) + i; const float br = BBr[p * 16 + ci], bi = BBi[p * 16 + ci]; v[i] = im ? (pr * bi + pi * br) : (pr * br - pi * bi); }
            u32x4 o; o.x = pk_bf16(v[0], v[1]); o.y = pk_bf16(v[2], v[3]); o.z = pk_bf16(v[4], v[5]); o.w = pk_bf16(v[6], v[7]);
            *(u32x4*)(Eb + ((size_t)(g * 256 + n)) * 512 + 8 * kc) = o; }
    }
}

DI void s5_scan(const Params& P, int wid, int lane, int bid) {
    unsigned char* ws_ = P.ws; asm volatile("" : "+s"(ws_));
    asm volatile("" : "+v"(lane));
    if (wid != 0) return;
    const float* lam_re = P.in[22]; const float* lam_im = P.in[23]; const float* log_dt = P.in[24];
    const float* XE = (const float*)(ws_ + O_AR + 96 * MiB); bf16_t* UG = (bf16_t*)(ws_ + O_AR);
    for (int g = bid; g < 64; g += gridDim.x) {
        const int p = lane; const float dt = expf(log_dt[g]); const float lr = lam_re[g * 64 + p], li = lam_im[g * 64 + p];
        const float mag = expf(32.f * (lr * dt)); float sn, cs; sincosf(32.f * (li * dt), &sn, &cs); const float ar = mag * cs, ai = mag * sn;
        float cr = 0.f, ci = 0.f;
        const float* xe = XE + (size_t)g * 512 * 128; bf16_t* ug = UG + (size_t)g * 512 * 640;
        for (int c0 = 0; c0 < 512; c0 += 16) {
            float xr[16], xi[16];
#pragma unroll
            for (int i = 0; i < 16; ++i) { xr[i] = xe[(size_t)(c0 + i) * 128 + p]; xi[i] = xe[(size_t)(c0 + i) * 128 + 64 + p]; }
#pragma unroll
            for (int i = 0; i < 16; ++i) { ug[(size_t)(c0 + i) * 640 + 512 + p] = f2bf(cr); ug[(size_t)(c0 + i) * 640 + 576 + p] = f2bf(ci);
                const float nr = ar * cr - ai * ci + xr[i], ni = ar * ci + ai * cr + xi[i]; cr = nr; ci = ni; }
        }
    }
}

DI void cs_table(const Params& P, int gtid, int nthreads) {
    unsigned char* ws_ = P.ws; asm volatile("" : "+s"(ws_));
    asm volatile("" : "+v"(gtid));
    const int* pos = (const int*)P.in[1]; float* CS = (float*)(ws_ + O_CS);
    for (int e = gtid; e < S * 32; e += nthreads) { const int row = e >> 5, j = e & 31;
        const float invf = exp2f(-(float)j * (13.287712379549449f / 32.f)); const float ang = (float)pos[row] * invf; float sn, cs; sincosf(ang, &sn, &cs);
        *(f32x2*)(CS + (size_t)e * 2) = (f32x2){cs, sn}; }
}


#define XB_TMO      128
#define XB_XCNT(j)  (256  + 64 * (j))
#define XB_XSUB(j)  (1280 + 64 * (j))
#define XB_XGEN(j)  (2304 + 64 * (j))
#define XB_TOP      3328
#define XB_TOPGEN   3392
#define XCD_BAR_WORDS 3456
#define XB_SPIN_CAP (1u << 18)
DI unsigned xb_ld(unsigned* p)              { return __hip_atomic_load(p, __ATOMIC_RELAXED, __HIP_MEMORY_SCOPE_AGENT); }
DI unsigned xb_add(unsigned* p, unsigned v) { return __hip_atomic_fetch_add(p, v, __ATOMIC_RELAXED, __HIP_MEMORY_SCOPE_AGENT); }
DI unsigned xb_xcc_id() { return (unsigned)__builtin_amdgcn_s_getreg((3 << 11) | 20) & 0xFu; }
#define XB_SPIN(cond, bar) do { unsigned _sp = 0; while (cond) { __builtin_amdgcn_s_sleep(1); \
    if ((++_sp & 255u) == 0u) { if (xb_ld(&(bar)[XB_TMO])) break; if (_sp > XB_SPIN_CAP) { atomicAdd(&(bar)[XB_TMO], 1u); break; } } } } while (0)
struct XcdBarrier { unsigned* bar; unsigned x; volatile LAS unsigned* st; };
DI XcdBarrier xcd_barrier_post(unsigned* bar, volatile LAS unsigned* st) {
    XcdBarrier b; b.bar = bar; b.x = xb_xcc_id(); b.st = st;
    if (threadIdx.x == 0) (void)xb_add(&bar[XB_XCNT(b.x)], 1u);
    return b;
}
DI void xcd_barrier_complete(unsigned* bar, unsigned x, unsigned& nloc, unsigned& nx) {
    const unsigned G = gridDim.x * gridDim.y * gridDim.z;
    unsigned sum, cnt, mine, sp = 0u;
    for (;;) {
        sum = 0u; cnt = 0u; mine = 0u;
#pragma unroll
        for (unsigned j = 0; j < 16; ++j) { const unsigned c = xb_ld(&bar[XB_XCNT(j)]); sum += c; cnt += (c > 0u) ? 1u : 0u; mine = (j == x) ? c : mine; }
        if (sum == G) break;
        __builtin_amdgcn_s_sleep(1);
        if ((++sp & 255u) == 0u) { if (xb_ld(&bar[XB_TMO])) break; if (sp > XB_SPIN_CAP) { atomicAdd(&bar[XB_TMO], 1u); break; } }
    }
    nloc = mine > 0u ? mine : 1u; nx = cnt > 0u ? cnt : 1u;
}
DI void xcd_barrier(const XcdBarrier& b) {
    asm volatile("s_waitcnt vmcnt(0)" ::: "memory");
    __syncthreads();
    if (threadIdx.x == 0) {
        unsigned* bar = b.bar;
        __builtin_amdgcn_s_waitcnt(0);
        unsigned nloc = b.st[0], nx = b.st[1];
        if (nloc == 0u) { xcd_barrier_complete(bar, b.x, nloc, nx); b.st[0] = nloc; b.st[1] = nx; }
        const unsigned old = xb_add(&bar[XB_XSUB(b.x)], 1u);
        const unsigned gen = old / nloc;
        if (old + 1u == (gen + 1u) * nloc) {
            __builtin_amdgcn_fence(__ATOMIC_RELEASE, "agent");
            asm volatile("s_waitcnt vmcnt(0)" ::: "memory");
            const unsigned og = xb_add(&bar[XB_TOP], 1u);
            const unsigned tg = og / nx;
            if (og + 1u == (tg + 1u) * nx) xb_add(&bar[XB_TOPGEN], 1u);
            else XB_SPIN(xb_ld(&bar[XB_TOPGEN]) == tg, bar);
            __builtin_amdgcn_fence(__ATOMIC_ACQUIRE, "agent");
            xb_add(&bar[XB_XGEN(b.x)], 1u);
            asm volatile("s_waitcnt vmcnt(0)" ::: "memory");
        } else {
            XB_SPIN(xb_ld(&bar[XB_XGEN(b.x)]) == gen, bar);
            __builtin_amdgcn_fence(__ATOMIC_ACQUIRE, "agent");
            asm volatile("s_waitcnt vmcnt(0)" ::: "memory");
        }
    }
    __syncthreads();
}

__global__ void __launch_bounds__(512, 2) __attribute__((amdgpu_waves_per_eu(2, 2))) mega_fwd(Params P) {
    extern __shared__ __attribute__((aligned(16))) unsigned char smem[];
    LAS unsigned char* lds = (LAS unsigned char*)smem;
    cg::grid_group grid = cg::this_grid();
    __shared__ uint4 xb_words;
    if (threadIdx.x == 0) xb_words = make_uint4(0u, 0u, 0u, 0u);
    __syncthreads();
    const XcdBarrier xb = xcd_barrier_post((unsigned*)(P.ws + O_BAR), (volatile LAS unsigned*)&xb_words);
    const int G = gridDim.x, nthreads = G * 512, NGW = G * 8;
#pragma nounroll
    for (int st = 0; st < NSTEPS; ++st) {
        int nrep = PROBE_REP(st); asm volatile("" : "+s"(nrep));
_Pragma("nounroll") for (int rep = 0; rep < nrep; ++rep) {
        if (rep) __syncthreads();
        int tid = threadIdx.x; asm volatile("" : "+v"(tid));
        int bid = blockIdx.x; asm volatile("" : "+s"(bid));
        unsigned char* ws = P.ws; asm volatile("" : "+s"(ws));
        float* outp_ = P.out; asm volatile("" : "+s"(outp_));
        const float* ng = P.in[2];
        bf16_t* XN = (bf16_t*)(ws + O_XN); const bf16_t* Zb = (const bf16_t*)(ws + O_Z);
        GemmDesc g;
        if (get_gemm(P, st, g)) gemm_phase(lds, P, g, G, bid, tid);
        else switch (st) {
        case 0: conv_layer(P, 0, GW_, NGW, LANE_); cs_table(P, GTID_, nthreads);
                row_pass<RP_BF>(P.in[0], outp_, nullptr, nullptr, ng, XN, GW_, NGW, LANE_); break;
        case 2: lnv_phase(P, GW_, NGW, LANE_); break;
        case 3: gate_phase(P, lds, tid, WID_, LANE_, bid); break;
        case 5: case 11: case 14: case 22: case 30: {
            const int L = (st == 5) ? 0 : (st <= 14 ? 1 : (st == 22 ? 2 : 3)); const bool mlp = (st == 14);
            const float* hin = (st == 5) ? P.in[0] : outp_;
            const float* gpost = ng + (L * 4 + (mlp ? 3 : 1)) * 1024; const float* gpre = mlp ? ng + ((L + 1) * 4) * 1024 : ng + (L * 4 + 2) * 1024;
            row_pass<RP_BF>(hin, outp_, Zb, gpost, gpre, XN, GW_, NGW, LANE_);
            if (mlp) conv_layer(P, L + 1, GW_, NGW, LANE_);
        } break;
        case 8: row_pass<RP_F32>(outp_, outp_, Zb, ng + 3 * 1024, ng + 4 * 1024, ws + O_AR, GW_, NGW, LANE_); conv_layer(P, 1, GW_, NGW, LANE_); break;
        case 9: pool_phase(P, GTID_, nthreads); break;
        case 16: mla_rows(P, GW_, NGW, LANE_); break;
        case 20: attn_phase(P, lds, tid, WID_, LANE_, bid); break;
        case 25: row_pass<RP_S5>(outp_, outp_, Zb, ng + 11 * 1024, ng + 12 * 1024, ws + O_AR, GW_, NGW, LANE_); conv_layer(P, 3, GW_, NGW, LANE_); s5_precompute(P, lds, tid, bid); break;
        case 27: s5_scan(P, WID_, LANE_, bid); break;
        case 33: row_pass<RP_FINAL>(outp_, outp_, Zb, ng + 15 * 1024, nullptr, nullptr, GW_, NGW, LANE_); break;
        default: break;
        }
        }
        if (st == 0) grid.sync();
        else if (st != 17 && st != 18 && st != NSTEPS - 1) { xcd_barrier(xb); if (PROBE_SYNC) xcd_barrier(xb); }
    }
}
}

extern "C" void kernel_launch(void* const* d_in, const int* in_sizes, int n_in, void* d_out, int out_size, void* d_ws, size_t ws_size, hipStream_t stream) {
    static int grid = 0;
    if (grid == 0) {
        int dev = 0, cus = 0, per_cu = 0;
        hipGetDevice(&dev);
        hipDeviceGetAttribute(&cus, hipDeviceAttributeMultiprocessorCount, dev);
        hipFuncSetAttribute((const void*)mega_fwd, hipFuncAttributeMaxDynamicSharedMemorySize, LDS_BYTES);
        if (hipOccupancyMaxActiveBlocksPerMultiprocessor(&per_cu, (const void*)mega_fwd, 512, LDS_BYTES) != hipSuccess || per_cu < 1) per_cu = 1;
        (void)hipGetLastError();
        grid = cus * per_cu;
        if (grid <= 0) grid = 256;
    }
    Params p{};
    for (int i = 0; i < 32 && i < n_in; ++i) p.in[i] = (const float*)d_in[i];
    p.out = (float*)d_out; p.ws = (unsigned char*)d_ws;
    hipMemsetAsync((unsigned char*)d_ws + O_BAR, 0, XCD_BAR_WORDS * 4, stream);
    void* args[] = {&p};
    hipError_t e = hipLaunchCooperativeKernel((const void*)mega_fwd, dim3(grid), dim3(512), args, LDS_BYTES, stream);
    if (e != hipSuccess) fprintf(stderr, "cooperative launch failed: %s (grid %d)\n", hipGetErrorString(e), grid);
}
```

```cpp
#include <hip/hip_runtime.h>
#include <hip/hip_cooperative_groups.h>
#include <cstdio>
namespace cg = cooperative_groups;

#define DI __device__ __forceinline__
#define LAS __attribute__((address_space(3)))
typedef unsigned short bf16_t;
typedef short bf16x8 __attribute__((ext_vector_type(8)));
typedef float f32x2 __attribute__((ext_vector_type(2)));
typedef float f32x4 __attribute__((ext_vector_type(4)));
typedef float f32x16 __attribute__((ext_vector_type(16)));
typedef unsigned u32x2 __attribute__((ext_vector_type(2)));
typedef unsigned u32x4 __attribute__((ext_vector_type(4)));
typedef __bf16 bf16v2 __attribute__((ext_vector_type(2)));

#define LANE_ (tid & 63)
#define WID_ (__builtin_amdgcn_readfirstlane(tid >> 6))
#define GW_ (bid * 8 + WID_)
#define GTID_ (bid * 512 + tid)
#ifndef PROBE_REP
#define PROBE_REP(st) 1
#endif
#ifndef PROBE_SYNC
#define PROBE_SYNC 0
#endif
#define IS_GEMM_STEP(st) ((st)==1||(st)==4||(st)==6||(st)==7||(st)==10||(st)==12||(st)==13||(st)==15||(st)==17||(st)==18||(st)==19||(st)==21||(st)==23||(st)==24||(st)==26||(st)==28||(st)==29||(st)==31||(st)==32)
#define IS_MLP_STEP(st) ((st)==6||(st)==7||(st)==12||(st)==13||(st)==23||(st)==24||(st)==31||(st)==32)
namespace {
constexpr int S = 16384;
constexpr size_t MiB = (size_t)1 << 20;
constexpr size_t O_CS = 0, O_WUP = 4 * MiB, O_WDN = 12 * MiB, O_WMIX = 20 * MiB, O_XN = 28 * MiB, O_Z = 60 * MiB, O_AR = 92 * MiB;
constexpr int LDS_BYTES = 131072;
constexpr size_t O_BAR = 254 * MiB;
constexpr size_t O_STAT = 254 * MiB + 65536;
constexpr int NSTEPS = 34;
constexpr float RMS_EPS = 1e-6f;
constexpr float QSCALE = 0.07216878364870322f * 1.4426950408889634f;

enum { E_Z = 0, E_HID, E_UV, E_POOL, E_LAT, E_Q, E_KN, E_VT, E_XE, E_S5Y, E_GLU };

struct Params { const float* in[32]; float* out; unsigned char* ws; };

DI unsigned pk_bf16(float a, float b) { f32x2 f = {a, b}; bf16v2 h = __builtin_convertvector(f, bf16v2); return __builtin_bit_cast(unsigned, h); }
DI bf16_t f2bf(float x) { return (bf16_t)(pk_bf16(x, 0.f) & 0xffffu); }
DI float bf2f(bf16_t b) { return __uint_as_float(((unsigned)b) << 16); }
DI float bflo(unsigned u) { return __uint_as_float(u << 16); }
DI float bfhi(unsigned u) { return __uint_as_float(u & 0xffff0000u); }
DI float shx(float v, int o, int lane) { return __int_as_float(__builtin_amdgcn_ds_bpermute((lane ^ o) << 2, __float_as_int(v))); }
DI float wave_sum(float v, int lane) {
#pragma unroll
    for (int o = 1; o < 64; o <<= 1) v += shx(v, o, lane);
    return v;
}
DI void store_bf4(bf16_t* p, f32x4 v) { u32x2 w; w.x = pk_bf16(v[0], v[1]); w.y = pk_bf16(v[2], v[3]); *(u32x2*)p = w; }
DI float gelu_tanh(float x) {
    const float u = 0.7978845608028654f * (x + 0.044715f * x * x * x);
    const float e = __expf(-2.f * u);
    return x * __builtin_amdgcn_rcpf(1.f + e);
}

constexpr int BM = 256, BK = 64, HALF = 128, HTB = HALF * BK * 2, NXCD = 8, WGM = 8;
DI int lds_byte(int r, int c) { const int st = (r >> 4) * 2 + (c >> 5), rr = r & 15, cc = c & 31, ob = rr * 64 + cc * 2; return st * 1024 + (ob ^ (((ob >> 9) & 1) << 5)); }
DI void stage_rc(int b, int& R, int& C) { const int st = b / 1024, sb = b % 1024, swz = sb ^ (((sb >> 9) & 1) << 5); R = (st >> 1) * 16 + swz / 64; C = (st & 1) * 32 + (swz % 64) / 2; }

struct GemmDesc { const bf16_t* A; const bf16_t* Bt; long a_gs, b_gs; int K, lda, ldb, nM, nN, ngrp, mode; };
struct Unit { int pm, pn, grp; };

DI bool unit_next(const GemmDesc& g, int i, int G, int c, Unit& u) {
    const int nper = g.nM * g.nN;
    const long L = (long)i * G + c;
    const bool ok = L < (long)nper * g.ngrp;
    const int grp2 = (int)(L / nper), w = (int)(L - (long)grp2 * nper);
    const int nwg = nper, nM = g.nM, nN = g.nN;
    int wgid = w;
    { const int q = nwg / NXCD, r = nwg % NXCD, xcd = wgid % NXCD, off = wgid / NXCD; wgid = (xcd < r ? xcd * (q + 1) : r * (q + 1) + (xcd - r) * q) + off; }
    const int nig = WGM * nN, gid = wgid / nig, fm = gid * WGM, gsz = (nM - fm) < WGM ? (nM - fm) : WGM;
    const int gszc = gsz > 0 ? gsz : 1;
    const int pm1 = fm + ((wgid % nig) % gszc), pn1 = (wgid % nig) / gszc;
    const int pm2 = w % nM, pn2 = w / nM;
    const bool single = (g.ngrp == 1);
    Unit r; r.pm = single ? pm1 : pm2; r.pn = single ? pn1 : pn2; r.grp = single ? 0 : grp2;
    u = r;
    return ok;
}

DI int perm32(int rho) { const int n = rho >> 4, i = rho & 15; return 8 * (i >> 2) + 4 * n + (i & 3); }
DI void store_bf8(bf16_t* p, f32x4 a, f32x4 b) { u32x4 w; w.x = pk_bf16(a[0], a[1]); w.y = pk_bf16(a[2], a[3]); w.z = pk_bf16(b[0], b[1]); w.w = pk_bf16(b[2], b[3]); *(u32x4*)p = w; }
#define EPI_LOOP(...) \
    _Pragma("unroll") for (int ai = 0; ai < 2; ++ai) _Pragma("unroll") for (int m = 0; m < 4; ++m) { const int row = row0 + ai * HALF + m * 16; \
        _Pragma("unroll") for (int bj = 0; bj < 2; ++bj) { const int col = col0 + bj * HALF; f32x4 v0 = acc[ai][bj][m][0], v1 = acc[ai][bj][m][1]; __VA_ARGS__ } }

DI void epilogue(const Params& P, const GemmDesc& g, const f32x4 (&acc)[2][2][4][2], const Unit& u, int wr, int wc, int fr, int fq) {
    unsigned char* ws_ = P.ws; asm volatile("" : "+s"(ws_));
    unsigned char* ws = ws_;
    const int row0 = u.pm * BM + wr * 64 + fr, col0 = u.pn * BM + wc * 32 + 8 * fq;
    bf16_t* Zb = (bf16_t*)(ws + O_Z);
    bf16_t* AR = (bf16_t*)(ws + O_AR);
    switch (g.mode) {
    case E_Z: { EPI_LOOP( store_bf8(Zb + (size_t)row * 1024 + col, v0, v1); ) } break;
    case E_HID: { EPI_LOOP( _Pragma("unroll") for (int j = 0; j < 4; ++j) { const float t0 = fmaxf(v0[j], 0.f), t1 = fmaxf(v1[j], 0.f); v0[j] = t0 * t0; v1[j] = t1 * t1; } store_bf8(AR + (size_t)row * 4096 + col, v0, v1); ) } break;
    case E_UV: { const float* bin = P.in[6]; float* STAT = (float*)(ws + O_AR + 96 * MiB); const int lane_ = fr + 16 * fq;
#pragma unroll
        for (int ai = 0; ai < 2; ++ai)
#pragma unroll
            for (int m = 0; m < 4; ++m) { const int row = row0 + ai * HALF + m * 16; float s1 = 0.f, s2 = 0.f;
#pragma unroll
                for (int bj = 0; bj < 2; ++bj) { const int col = col0 + bj * HALF; f32x4 v0 = acc[ai][bj][m][0], v1 = acc[ai][bj][m][1];
                    const f32x4 b0 = *(const f32x4*)(bin + col); const f32x4 b1 = *(const f32x4*)(bin + col + 4);
#pragma unroll
                    for (int j = 0; j < 4; ++j) { v0[j] = gelu_tanh(v0[j] + b0[j]); v1[j] = gelu_tanh(v1[j] + b1[j]); s1 += v0[j] + v1[j]; s2 += v0[j] * v0[j] + v1[j] * v1[j]; }
                    bf16_t* dst = (col < 1024) ? (AR + (size_t)row * 1024 + col) : (AR + 16 * MiB + (size_t)row * 1024 + (col - 1024)); store_bf8(dst, v0, v1); }
                if (col0 >= 1024) {
                    s1 += shx(s1, 16, lane_); s2 += shx(s2, 16, lane_); s1 += shx(s1, 32, lane_); s2 += shx(s2, 32, lane_);
                    if (fq == 0) *(f32x2*)(STAT + ((size_t)row * 16 + (u.pn - 4) * 4 + wc) * 2) = (f32x2){s1, s2}; }
            }
    } break;
    case E_POOL: { const float* sc = P.in[13];
        EPI_LOOP( const int cgc = 256 * u.grp + col; const f32x4 s0 = *(const f32x4*)(sc + cgc); const f32x4 s1 = *(const f32x4*)(sc + cgc + 4); store_bf8(Zb + (size_t)row * 1024 + cgc, v0 * s0, v1 * s1); ) } break;
    case E_LAT: { EPI_LOOP( store_bf8(AR + (size_t)row * 768 + col, v0, v1); ) } break;
    case E_Q: { const float* CS = (const float*)(ws + O_CS); bf16_t* Qb = AR + 24 * MiB;
        EPI_LOOP( const int w = col % 192;
                  if (w >= 128) { const int j = (w - 128) >> 1; const f32x4 c0 = *(const f32x4*)(CS + ((size_t)row * 32 + j) * 2); const f32x4 c1 = *(const f32x4*)(CS + ((size_t)row * 32 + j) * 2 + 4);
                      const float a0 = v0[0] * c0[0] - v0[1] * c0[1]; const float a1 = v0[0] * c0[1] + v0[1] * c0[0]; const float a2 = v0[2] * c0[2] - v0[3] * c0[3]; const float a3 = v0[2] * c0[3] + v0[3] * c0[2];
                      const float e0 = v1[0] * c1[0] - v1[1] * c1[1]; const float e1 = v1[0] * c1[1] + v1[1] * c1[0]; const float e2 = v1[2] * c1[2] - v1[3] * c1[3]; const float e3 = v1[2] * c1[3] + v1[3] * c1[2];
                      v0[0] = a0; v0[1] = a1; v0[2] = a2; v0[3] = a3; v1[0] = e0; v1[1] = e1; v1[2] = e2; v1[3] = e3; }
                  store_bf8(Qb + (size_t)row * 1536 + col, v0 * QSCALE, v1 * QSCALE); ) } break;
    case E_KN: { bf16_t* KN = AR + 48 * MiB; EPI_LOOP( store_bf8(KN + (size_t)row * 1024 + col, v0, v1); ) } break;
    case E_VT: { bf16_t* VT = AR + 64 * MiB; EPI_LOOP( store_bf8(VT + (size_t)row * 16384 + col, v0, v1); ) } break;
    case E_XE: { float* XE = (float*)(ws + O_AR + 96 * MiB);
        EPI_LOOP( if (col < 128) { float* xp = XE + ((size_t)(u.grp * 512 + row)) * 128 + col; *(f32x4*)xp = v0; *(f32x4*)(xp + 4) = v1; } ) } break;
    case E_S5Y: { bf16_t* Y5 = AR + 56 * MiB;
        EPI_LOOP( const int l = col >> 4, c = col & 15; const int token = row * 32 + l; _Pragma("unroll") for (int j = 0; j < 4; ++j) { v0[j] = gelu_tanh(v0[j]); v1[j] = gelu_tanh(v1[j]); }
                  store_bf8(Y5 + (size_t)token * 1024 + u.grp * 16 + c, v0, v1); ) } break;
    case E_GLU: {
#pragma unroll
        for (int ai = 0; ai < 2; ++ai)
#pragma unroll
            for (int m = 0; m < 4; ++m) { const int row = row0 + ai * HALF + m * 16; const int oc = u.pn * 128 + wc * 32 + 8 * fq;
                const f32x4 a0 = acc[ai][0][m][0], a1 = acc[ai][0][m][1], b0 = acc[ai][1][m][0], b1 = acc[ai][1][m][1]; f32x4 v0, v1;
#pragma unroll
                for (int j = 0; j < 4; ++j) { v0[j] = a0[j] * __builtin_amdgcn_rcpf(1.f + __expf(-b0[j])); v1[j] = a1[j] * __builtin_amdgcn_rcpf(1.f + __expf(-b1[j])); }
                store_bf8(Zb + (size_t)row * 1024 + oc, v0, v1); }
    } break;
    default: break;
    }
}

DI void gemm_phase(LAS unsigned char* lds, const Params& P, const GemmDesc g, const int G, const int cidx, int tid) {
    asm volatile("" : "+v"(tid));
    const int wid = __builtin_amdgcn_readfirstlane(tid >> 6), lane = tid & 63, wr = wid >> 2, wc = wid & 3, fr = lane & 15, fq = lane >> 4;
    const int K = g.K, nt = K / BK;
    unsigned voffA[2], voffB[2];
#pragma unroll
    for (int i = 0; i < 2; ++i) { int R, C; stage_rc(tid * 16 + i * 8192, R, C); const int Rb = (R & ~31) + perm32(R & 31); voffA[i] = (unsigned)(R * g.lda + C) * 2u; voffB[i] = (unsigned)(Rb * g.ldb + C) * 2u; }
    const size_t kstep = (size_t)(BK * 2);
    const size_t hstepA = (size_t)HALF * g.lda * 2, hstepB = (size_t)HALF * g.ldb * 2;
    const unsigned ldsw = (unsigned)wid * 1024u;
    const int aoff = lds_byte(wr * 64 + fr, fq * 8), boff = lds_byte(wc * 32 + fr, fq * 8);
#define PG8_SA(b, h) (((b) * 2 + (h)) * HTB)
#define PG8_SB(b, h) ((4 + (b) * 2 + (h)) * HTB)
#define PG8_STAGE(bufoff, gbase, voff) do { _Pragma("unroll") for (int _i = 0; _i < 2; ++_i) \
        __builtin_amdgcn_global_load_lds((const unsigned*)((const char*)(gbase) + (voff)[_i]), (LAS unsigned*)(lds + (bufoff) + ldsw + _i * 8192), 16, 0, 0); } while (0)
#define PG8_LDA(dst, b, h) do { _Pragma("unroll") for (int m = 0; m < 4; ++m) _Pragma("unroll") for (int k = 0; k < 2; ++k) dst[m][k] = *(const LAS bf16x8*)(lds + PG8_SA(b, h) + aoff + m * 2048 + k * 1024); } while (0)
#define PG8_LDB(dst, b, h) do { _Pragma("unroll") for (int n = 0; n < 2; ++n) _Pragma("unroll") for (int k = 0; k < 2; ++k) dst[n][k] = *(const LAS bf16x8*)(lds + PG8_SB(b, h) + boff + n * 2048 + k * 1024); } while (0)
#define PG8_MMA(ai, bj, At, Bt) do { __builtin_amdgcn_s_setprio(1); _Pragma("unroll") for (int m = 0; m < 4; ++m) _Pragma("unroll") for (int n = 0; n < 2; ++n) _Pragma("unroll") for (int k = 0; k < 2; ++k) \
        acc[ai][bj][m][n] = __builtin_amdgcn_mfma_f32_16x16x32_bf16(Bt[n][k], At[m][k], acc[ai][bj][m][n], 0, 0, 0); __builtin_amdgcn_s_setprio(0); } while (0)
#define PG8_WAIT_V(n) asm volatile("s_waitcnt vmcnt(" #n ")" ::: "memory")
#define PG8_WAIT_L(n) asm volatile("s_waitcnt lgkmcnt(" #n ")" ::: "memory")
#define PG8_BAR __builtin_amdgcn_s_barrier()
#define PG8_SCHED __builtin_amdgcn_sched_barrier(0)
    Unit cur, nxt; int ui = 0;
    if (!unit_next(g, 0, G, cidx, cur)) return;
    f32x4 acc[2][2][4][2];
#pragma unroll
    for (int a = 0; a < 2; ++a)
#pragma unroll
        for (int b = 0; b < 2; ++b)
#pragma unroll
            for (int m = 0; m < 4; ++m)
#pragma unroll
                for (int n = 0; n < 2; ++n) acc[a][b][m][n] = (f32x4){0.f, 0.f, 0.f, 0.f};
    bf16x8 At[4][2], B0[2][2], B1[2][2];
    const char* cA = (const char*)g.A + ((size_t)cur.grp * g.a_gs + (size_t)cur.pm * BM * g.lda) * 2;
    const char* cB = (const char*)g.Bt + ((size_t)cur.grp * g.b_gs + (size_t)cur.pn * BM * g.ldb) * 2;
    PG8_STAGE(PG8_SB(0, 0), cB, voffB); PG8_STAGE(PG8_SA(0, 0), cA, voffA); PG8_STAGE(PG8_SB(0, 1), cB + hstepB, voffB); PG8_STAGE(PG8_SA(0, 1), cA + hstepA, voffA);
    if (wr == 1) PG8_BAR;
    PG8_WAIT_V(4); PG8_BAR;
    PG8_STAGE(PG8_SB(1, 0), cB + kstep, voffB); PG8_STAGE(PG8_SA(1, 0), cA + kstep, voffA); PG8_STAGE(PG8_SB(1, 1), cB + hstepB + kstep, voffB);
    PG8_WAIT_V(6); PG8_BAR;
    for (;;) {
        const bool has_next = unit_next(g, ui + 1, G, cidx, nxt);
        const char* nA = has_next ? (const char*)g.A + ((size_t)nxt.grp * g.a_gs + (size_t)nxt.pm * BM * g.lda) * 2 : cA;
        const char* nB = has_next ? (const char*)g.Bt + ((size_t)nxt.grp * g.b_gs + (size_t)nxt.pn * BM * g.ldb) * 2 : cB;
        for (int t = 0; t < nt; t += 2) {
            const bool last = (t == nt - 2);
            const char* a1 = cA + (size_t)(t + 1) * kstep;
            const char* a2 = last ? nA : cA + (size_t)(t + 2) * kstep; const char* b2 = last ? nB : cB + (size_t)(t + 2) * kstep;
            const char* a3 = a2 + kstep; const char* b3 = b2 + kstep;
            PG8_LDB(B0, 0, 0); PG8_SCHED; PG8_LDA(At, 0, 0); PG8_STAGE(PG8_SA(1, 1), a1 + hstepA, voffA);
            PG8_WAIT_L(8); PG8_BAR; PG8_WAIT_L(0); PG8_MMA(0, 0, At, B0); PG8_BAR; PG8_SCHED;
            PG8_LDB(B1, 0, 1); PG8_STAGE(PG8_SB(0, 0), b2, voffB);
            PG8_BAR; PG8_WAIT_L(0); PG8_MMA(0, 1, At, B1); PG8_BAR;
            PG8_LDA(At, 0, 1); PG8_STAGE(PG8_SA(0, 0), a2, voffA);
            PG8_BAR; PG8_WAIT_L(0); PG8_MMA(1, 0, At, B0); PG8_BAR; PG8_SCHED;
            PG8_STAGE(PG8_SB(0, 1), b2 + hstepB, voffB);
            PG8_WAIT_V(6); PG8_BAR; PG8_MMA(1, 1, At, B1); PG8_BAR;
            PG8_LDB(B0, 1, 0); PG8_SCHED; PG8_LDA(At, 1, 0); PG8_STAGE(PG8_SA(0, 1), a2 + hstepA, voffA);
            PG8_WAIT_L(8); PG8_BAR; PG8_WAIT_L(0); PG8_MMA(0, 0, At, B0); PG8_BAR; PG8_SCHED;
            PG8_LDB(B1, 1, 1); PG8_STAGE(PG8_SB(1, 0), b3, voffB);
            PG8_BAR; PG8_WAIT_L(0); PG8_MMA(0, 1, At, B1); PG8_BAR;
            PG8_LDA(At, 1, 1); PG8_STAGE(PG8_SA(1, 0), a3, voffA);
            PG8_BAR; PG8_WAIT_L(0); PG8_MMA(1, 0, At, B0); PG8_BAR; PG8_SCHED;
            PG8_STAGE(PG8_SB(1, 1), b3 + hstepB, voffB);
            PG8_WAIT_V(6); PG8_BAR; PG8_MMA(1, 1, At, B1); PG8_BAR;
        }
        epilogue(P, g, acc, cur, wr, wc, fr, fq);
        if (!has_next) break;
#pragma unroll
        for (int a = 0; a < 2; ++a)
#pragma unroll
            for (int b = 0; b < 2; ++b)
#pragma unroll
                for (int m = 0; m < 4; ++m)
#pragma unroll
                    for (int n = 0; n < 2; ++n) acc[a][b][m][n] = (f32x4){0.f, 0.f, 0.f, 0.f};
        cur = nxt; cA = nA; cB = nB; ++ui;
    }
    PG8_WAIT_V(0);
    if (wr == 0) PG8_BAR;
    PG8_BAR;
}

DI bool get_gemm(const Params& P, int st, GemmDesc& g) {
    unsigned char* ws_ = P.ws; asm volatile("" : "+s"(ws_));
    unsigned char* ws = ws_;
    const bf16_t* XN = (const bf16_t*)(ws + O_XN);
    const bf16_t* WMIX = (const bf16_t*)(ws + O_WMIX);
    const bf16_t* AR = (const bf16_t*)(ws + O_AR);
    g.a_gs = 0; g.b_gs = 0; g.ngrp = 1; g.nM = 64; g.K = 1024; g.lda = 1024; g.ldb = 1024; g.A = XN; g.Bt = WMIX; g.nN = 4; g.mode = E_Z;
    switch (st) {
    case 1: g.nN = 8; g.mode = E_UV; return true;
    case 4: g.A = AR + 32 * MiB; g.Bt = WMIX + 2 * MiB; return true;
    case 6: case 12: case 23: case 31: g.Bt = (const bf16_t*)(ws + O_WUP); g.nN = 16; g.mode = E_HID; return true;
    case 7: case 13: case 24: case 32: g.A = AR; g.Bt = (const bf16_t*)(ws + O_WDN); g.K = 4096; g.lda = 4096; g.ldb = 4096; return true;
    case 10: g.A = AR + 32 * MiB; g.K = 256; g.ldb = 256; g.nN = 1; g.ngrp = 4; g.a_gs = 256; g.b_gs = 65536; g.mode = E_POOL; return true;
    case 15: g.nN = 3; g.mode = E_LAT; return true;
    case 17: g.A = AR + 12 * MiB; g.Bt = WMIX + 1 * MiB; g.K = 384; g.lda = 384; g.ldb = 384; g.nN = 6; g.mode = E_Q; return true;
    case 18: g.A = AR + 18 * MiB; g.Bt = WMIX + 2 * MiB; g.K = 256; g.lda = 256; g.ldb = 256; g.nN = 4; g.mode = E_KN; return true;
    case 19: g.A = WMIX + (5 * MiB) / 2; g.Bt = AR + 18 * MiB; g.K = 256; g.lda = 256; g.ldb = 256; g.nM = 4; g.nN = 64; g.mode = E_VT; return true;
    case 21: g.Bt = WMIX + 3 * MiB; return true;
    case 26: g.A = AR; g.Bt = AR + 40 * MiB; g.K = 512; g.lda = 640; g.ldb = 512; g.nM = 2; g.nN = 1; g.ngrp = 64; g.a_gs = 512 * 640; g.b_gs = 256 * 512; g.mode = E_XE; return true;
    case 28: g.A = AR; g.Bt = AR + 20 * MiB; g.K = 640; g.lda = 640; g.ldb = 640; g.nM = 2; g.nN = 2; g.ngrp = 64; g.a_gs = 512 * 640; g.b_gs = 512 * 640; g.mode = E_S5Y; return true;
    case 29: g.A = AR + 56 * MiB; g.nN = 8; g.mode = E_GLU; return true;
    default: return false;
    }
}

enum { RP_BF = 0, RP_F32 = 1, RP_S5 = 2, RP_FINAL = 3 };
template <int MODE>
DI void row_pass(const float* hin, float* hout, const bf16_t* z, const float* gpost, const float* gpre, void* outp, int gw, int NGW, int lane) {
    asm volatile("" : "+v"(lane));
    for (int rowa = gw; rowa < S; rowa += 2 * NGW) {
        f32x4 h[2][4];
#pragma unroll
        for (int q = 0; q < 2; ++q) { const int row = rowa + q * NGW;
#pragma unroll
            for (int j = 0; j < 4; ++j) { const int cb = (MODE == RP_S5) ? 16 * lane + 4 * j : 4 * lane + 256 * j; h[q][j] = *(const f32x4*)(hin + (size_t)row * 1024 + cb); } }
        if (z) {
            f32x4 zz[2][4]; float ss[2] = {0.f, 0.f};
#pragma unroll
            for (int q = 0; q < 2; ++q) { const int row = rowa + q * NGW;
#pragma unroll
                for (int j = 0; j < 4; ++j) { const int cb = (MODE == RP_S5) ? 16 * lane + 4 * j : 4 * lane + 256 * j; const u32x2 w = *(const u32x2*)(z + (size_t)row * 1024 + cb);
                    zz[q][j] = (f32x4){bflo(w.x), bfhi(w.x), bflo(w.y), bfhi(w.y)}; ss[q] += zz[q][j][0] * zz[q][j][0] + zz[q][j][1] * zz[q][j][1] + zz[q][j][2] * zz[q][j][2] + zz[q][j][3] * zz[q][j][3]; } }
#pragma unroll
            for (int q = 0; q < 2; ++q) { const int row = rowa + q * NGW;
                const float rz = rsqrtf(wave_sum(ss[q], lane) * (1.f / 1024.f) + RMS_EPS);
#pragma unroll
                for (int j = 0; j < 4; ++j) { const int cb = (MODE == RP_S5) ? 16 * lane + 4 * j : 4 * lane + 256 * j; const f32x4 gp = *(const f32x4*)(gpost + cb); h[q][j] += zz[q][j] * rz * gp;
                    *(f32x4*)(hout + (size_t)row * 1024 + cb) = h[q][j]; } }
        }
        if (MODE != RP_FINAL) {
#pragma unroll
            for (int q = 0; q < 2; ++q) { const int row = rowa + q * NGW;
                float s2 = 0.f;
#pragma unroll
                for (int j = 0; j < 4; ++j) s2 += h[q][j][0] * h[q][j][0] + h[q][j][1] * h[q][j][1] + h[q][j][2] * h[q][j][2] + h[q][j][3] * h[q][j][3];
                const float rn = rsqrtf(wave_sum(s2, lane) * (1.f / 1024.f) + RMS_EPS);
#pragma unroll
                for (int j = 0; j < 4; ++j) { const int cb = (MODE == RP_S5) ? 16 * lane + 4 * j : 4 * lane + 256 * j; const f32x4 gq = *(const f32x4*)(gpre + cb); const f32x4 xn = h[q][j] * rn * gq;
                    if (MODE == RP_BF) store_bf4((bf16_t*)outp + (size_t)row * 1024 + cb, xn);
                    if (MODE == RP_F32) *(f32x4*)((float*)outp + (size_t)row * 1024 + cb) = xn;
                    if (MODE == RP_S5) store_bf4((bf16_t*)outp + ((size_t)(lane * 512 + (row >> 5))) * 640 + (row & 31) * 16 + 4 * j, xn); } }
        }
    }
}

enum { MAP_ID = 0, MAP_UQ = 1, MAP_GLUA = 2, MAP_GLUB = 3 };
DI int dstrow(int mode, int n) {
    if (mode == MAP_UQ) { const int hd = n / 192, w = n - hd * 192; if (w < 128) return n; const int r = w - 128; return hd * 192 + 128 + 2 * (r & 31) + (r >> 5); }
    if (mode == MAP_GLUA) return (n >> 7) * 256 + (n & 127);
    if (mode == MAP_GLUB) return (n >> 7) * 256 + 128 + (n & 127);
    return n;
}
DI void convT(const float* src, int K, int N, bf16_t* dst, int ldT, int mapmode, int gw, int NGW, int lane) {
    asm volatile("" : "+v"(lane));
    const int nnb = N >> 4, nitems = nnb * (K >> 5);
    for (int it = gw; it < nitems; it += NGW) {
        const int kb = it / nnb, nb = it - kb * nnb;
        const int n = nb * 16 + (lane >> 2), k = kb * 32 + 8 * (lane & 3);
        const float* s = src + (size_t)k * N + n;
        float v[8];
#pragma unroll
        for (int i = 0; i < 8; ++i) v[i] = s[(size_t)i * N];
        u32x4 o; o.x = pk_bf16(v[0], v[1]); o.y = pk_bf16(v[2], v[3]); o.z = pk_bf16(v[4], v[5]); o.w = pk_bf16(v[6], v[7]);
        *(u32x4*)(dst + (size_t)dstrow(mapmode, n) * ldT + k) = o;
    }
}
DI void conv_layer(const Params& P, int L, int gw, int NGW, int lane) {
    unsigned char* ws_ = P.ws; asm volatile("" : "+s"(ws_));
    unsigned char* ws = ws_;
    bf16_t* WMIX = (bf16_t*)(ws + O_WMIX);
    convT(P.in[3] + (size_t)L * 1024 * 4096, 1024, 4096, (bf16_t*)(ws + O_WUP), 1024, MAP_ID, gw, NGW, lane);
    convT(P.in[4] + (size_t)L * 1024 * 4096, 4096, 1024, (bf16_t*)(ws + O_WDN), 4096, MAP_ID, gw, NGW, lane);
    if (L == 0) {
        convT(P.in[5], 1024, 2048, WMIX, 1024, MAP_ID, gw, NGW, lane);
        convT(P.in[11], 1024, 1024, WMIX + 2 * MiB, 1024, MAP_ID, gw, NGW, lane);
        const float* wsrc = P.in[9]; bf16_t* wd = WMIX + 3 * MiB;
        for (int e = gw * 64 + lane; e < 8 * 128 * 128 / 4; e += NGW * 64) { const int s0 = (e * 4) & 127, t = ((e * 4) >> 7) & 127; f32x4 w = *(const f32x4*)(wsrc + (size_t)e * 4);
#pragma unroll
            for (int j = 0; j < 4; ++j) if (s0 + j > t) w[j] = 0.f;
            store_bf4(wd + (size_t)e * 4, w); }
    } else if (L == 1) {
        for (int gg = 0; gg < 4; ++gg) convT(P.in[12] + gg * 65536, 256, 256, WMIX + gg * 65536, 256, MAP_ID, gw, NGW, lane);
    } else if (L == 2) {
        convT(P.in[14], 1024, 384, WMIX, 1024, MAP_ID, gw, NGW, lane);
        convT(P.in[17], 1024, 320, WMIX + 384 * 1024, 1024, MAP_ID, gw, NGW, lane);
        convT(P.in[16], 384, 1536, WMIX + 1 * MiB, 384, MAP_UQ, gw, NGW, lane);
        convT(P.in[19], 256, 1024, WMIX + 2 * MiB, 256, MAP_ID, gw, NGW, lane);
        convT(P.in[20], 256, 1024, WMIX + (5 * MiB) / 2, 256, MAP_ID, gw, NGW, lane);
        convT(P.in[21], 1024, 1024, WMIX + 3 * MiB, 1024, MAP_ID, gw, NGW, lane);
    } else {
        convT(P.in[30], 1024, 1024, WMIX, 1024, MAP_GLUA, gw, NGW, lane);
        convT(P.in[31], 1024, 1024, WMIX, 1024, MAP_GLUB, gw, NGW, lane);
    }
}

DI void lnv_phase(const Params& P, int gw, int NGW, int lane) {
    unsigned char* ws_ = P.ws; asm volatile("" : "+s"(ws_));
    asm volatile("" : "+v"(lane));
    bf16_t* V = (bf16_t*)(ws_ + O_AR + 32 * MiB);
    const float* gv = P.in[7]; const float* bv = P.in[8];
    for (int row = gw; row < S; row += NGW) {
        f32x4 x[4]; float s = 0.f;
#pragma unroll
        for (int j = 0; j < 4; ++j) { const u32x2 w = *(const u32x2*)(V + (size_t)row * 1024 + 4 * lane + 256 * j); x[j] = (f32x4){bflo(w.x), bfhi(w.x), bflo(w.y), bfhi(w.y)}; s += x[j][0] + x[j][1] + x[j][2] + x[j][3]; }
        const float mu = wave_sum(s, lane) * (1.f / 1024.f); float s2 = 0.f;
#pragma unroll
        for (int j = 0; j < 4; ++j) { x[j] = x[j] - mu; s2 += x[j][0] * x[j][0] + x[j][1] * x[j][1] + x[j][2] * x[j][2] + x[j][3] * x[j][3]; }
        const float rs = rsqrtf(wave_sum(s2, lane) * (1.f / 1024.f) + RMS_EPS);
#pragma unroll
        for (int j = 0; j < 4; ++j) { const int cb = 4 * lane + 256 * j; const f32x4 g4 = *(const f32x4*)(gv + cb), b4 = *(const f32x4*)(bv + cb); store_bf4(V + (size_t)row * 1024 + cb, x[j] * rs * g4 + b4); }
    }
}

DI void gate_phase(const Params& P, LAS unsigned char* lds, int tid, int wid, int lane, int bid) {
    unsigned char* ws_ = P.ws; asm volatile("" : "+s"(ws_));
    asm volatile("" : "+v"(tid)); lane = tid & 63; wid = __builtin_amdgcn_readfirstlane(tid >> 6);
    LAS bf16_t* Wt = (LAS bf16_t*)lds;
    LAS bf16_t* Vt = Wt + 128 * 136;
    const bf16_t* Wsb = (const bf16_t*)(ws_ + O_WMIX + 6 * MiB);
    const bf16_t* U = (const bf16_t*)(ws_ + O_AR);
    const bf16_t* V = (const bf16_t*)(ws_ + O_AR + 32 * MiB);
    bf16_t* Y = (bf16_t*)(ws_ + O_AR + 64 * MiB);
    const float* bs = P.in[10]; const float* gv = P.in[7]; const float* bv = P.in[8]; const float* STAT = (const float*)(ws_ + O_AR + 96 * MiB);
    LAS float* mus = (LAS float*)(lds + 69632); LAS float* rss = mus + 128;
    const int r16 = lane & 15, quad = lane >> 4;
    for (int item = bid; item < 1024; item += gridDim.x) {
        const int hd = item & 7, c = item >> 3;
        __syncthreads();
        if (tid < 128) { const f32x4* pp = (const f32x4*)(STAT + (size_t)(c * 128 + tid) * 32); float a1 = 0.f, a2 = 0.f;
#pragma unroll
            for (int i = 0; i < 8; ++i) { const f32x4 t4 = pp[i]; a1 += t4[0] + t4[2]; a2 += t4[1] + t4[3]; }
            const float mu = a1 * (1.f / 1024.f); mus[tid] = mu; rss[tid] = rsqrtf(fmaxf(a2 * (1.f / 1024.f) - mu * mu, 0.f) + RMS_EPS); }
#pragma unroll
        for (int i = 0; i < 4; ++i) { const int cid = tid + 512 * i, t = cid >> 4, sc = cid & 15;
            const u32x4 w = *(const u32x4*)(Wsb + ((size_t)(hd * 128 + t)) * 128 + 8 * sc); *(LAS u32x4*)(Wt + t * 136 + 8 * sc) = w; }
        __syncthreads();
#pragma unroll
        for (int i = 0; i < 4; ++i) { const int cid = tid + 512 * i, s = cid >> 4, dc = cid & 15;
            const int grow = c * 128 + s, gcol = hd * 128 + 8 * dc;
            const u32x4 w = *(const u32x4*)(V + (size_t)grow * 1024 + gcol);
            const float mu = mus[s], rs = rss[s];
            const f32x4 g0 = *(const f32x4*)(gv + gcol), g1 = *(const f32x4*)(gv + gcol + 4), b0 = *(const f32x4*)(bv + gcol), b1 = *(const f32x4*)(bv + gcol + 4);
            float y[8];
#pragma unroll
            for (int e = 0; e < 8; ++e) { const float x = (e & 1) ? bfhi(w[e >> 1]) : bflo(w[e >> 1]); y[e] = (x - mu) * rs * ((e < 4) ? g0[e & 3] : g1[e & 3]) + ((e < 4) ? b0[e & 3] : b1[e & 3]); }
#pragma unroll
            for (int e = 0; e < 8; ++e) Vt[(8 * dc + e) * 136 + s] = f2bf(y[e]); }
        __syncthreads();
        const int t = 16 * wid + r16;
        const int nks = (16 * wid + 15) / 32 + 1;
        bf16x8 bw[4];
#pragma unroll
        for (int ks = 0; ks < 4; ++ks) bw[ks] = *(const LAS bf16x8*)(Wt + t * 136 + 32 * ks + 8 * quad);
        const int token = c * 128 + t;
        const float bias = bs[hd * 128 + t];
#pragma unroll
        for (int dt = 0; dt < 8; ++dt) {
            f32x4 acc = {0.f, 0.f, 0.f, 0.f};
#pragma unroll
            for (int ks = 0; ks < 4; ++ks) if (ks < nks) {
                const bf16x8 a = *(const LAS bf16x8*)(Vt + (16 * dt + r16) * 136 + 32 * ks + 8 * quad);
                acc = __builtin_amdgcn_mfma_f32_16x16x32_bf16(a, bw[ks], acc, 0, 0, 0); }
            const int col = hd * 128 + 16 * dt + 4 * quad;
            const u32x2 uu = *(const u32x2*)(U + (size_t)token * 1024 + col);
            f32x4 y; y[0] = (acc[0] + bias) * bflo(uu.x); y[1] = (acc[1] + bias) * bfhi(uu.x); y[2] = (acc[2] + bias) * bflo(uu.y); y[3] = (acc[3] + bias) * bfhi(uu.y);
            store_bf4(Y + (size_t)token * 1024 + col, y);
        }
    }
}

DI void pool_phase(const Params& P, int gtid, int nthreads) {
    unsigned char* ws_ = P.ws; asm volatile("" : "+s"(ws_));
    asm volatile("" : "+v"(gtid));
    const float* ZF = (const float*)(ws_ + O_AR);
    bf16_t* Pb = (bf16_t*)(ws_ + O_AR + 64 * MiB);
    for (int e = gtid; e < 1024 * 256; e += nthreads) {
        const int cgi = e & 255, tb = e >> 8, col = 4 * cgi, w = 2 << (cgi >> 6), t0 = 16 * tb;
        f32x4 W = {0.f, 0.f, 0.f, 0.f};
        for (int j = 1; j < w; ++j) if (t0 - j >= 0) W += *(const f32x4*)(ZF + (size_t)(t0 - j) * 1024 + col);
        for (int i = 0; i < 16; ++i) { const int t = t0 + i; const f32x4 z = *(const f32x4*)(ZF + (size_t)t * 1024 + col); W += z;
            const float cnt = (float)((t + 1 < w) ? (t + 1) : w); const f32x4 o = W / cnt - z; store_bf4(Pb + (size_t)t * 1024 + col, o);
            if (t - w + 1 >= 0) W -= *(const f32x4*)(ZF + (size_t)(t - w + 1) * 1024 + col); }
    }
}

DI void mla_rows(const Params& P, int gw, int NGW, int lane) {
    unsigned char* ws_ = P.ws; asm volatile("" : "+s"(ws_));
    asm volatile("" : "+v"(lane));
    unsigned char* ar = ws_ + O_AR;
    const bf16_t* LAT = (const bf16_t*)ar; bf16_t* QL = (bf16_t*)(ar + 24 * MiB); bf16_t* Cb = (bf16_t*)(ar + 36 * MiB); bf16_t* KR = (bf16_t*)(ar + 44 * MiB);
    const float* CS = (const float*)(ws_ + O_CS); const float* gq = P.in[15]; const float* gkv = P.in[18];
    for (int row = gw; row < S; row += NGW) {
        const bf16_t* lat = LAT + (size_t)row * 768;
        float q[6]; float ss = 0.f;
#pragma unroll
        for (int i = 0; i < 3; ++i) { const unsigned w = *(const unsigned*)(lat + 2 * lane + 128 * i); q[2 * i] = bflo(w); q[2 * i + 1] = bfhi(w); ss += q[2 * i] * q[2 * i] + q[2 * i + 1] * q[2 * i + 1]; }
        ss = wave_sum(ss, lane); const float rq = rsqrtf(ss * (1.f / 384.f) + RMS_EPS);
#pragma unroll
        for (int i = 0; i < 3; ++i) { const f32x2 g2 = *(const f32x2*)(gq + 2 * lane + 128 * i); *(unsigned*)(QL + (size_t)row * 384 + 2 * lane + 128 * i) = pk_bf16(q[2 * i] * rq * g2.x, q[2 * i + 1] * rq * g2.y); }
        float cc[4]; float s2 = 0.f;
#pragma unroll
        for (int i = 0; i < 2; ++i) { const unsigned w = *(const unsigned*)(lat + 384 + 2 * lane + 128 * i); cc[2 * i] = bflo(w); cc[2 * i + 1] = bfhi(w); s2 += cc[2 * i] * cc[2 * i] + cc[2 * i + 1] * cc[2 * i + 1]; }
        s2 = wave_sum(s2, lane); const float rc = rsqrtf(s2 * (1.f / 256.f) + RMS_EPS);
#pragma unroll
        for (int i = 0; i < 2; ++i) { const f32x2 g2 = *(const f32x2*)(gkv + 2 * lane + 128 * i); *(unsigned*)(Cb + (size_t)row * 256 + 2 * lane + 128 * i) = pk_bf16(cc[2 * i] * rc * g2.x, cc[2 * i + 1] * rc * g2.y); }
        if (lane < 32) { const float x1 = bf2f(lat[640 + lane]), x2 = bf2f(lat[672 + lane]); const f32x2 cs = *(const f32x2*)(CS + ((size_t)row * 32 + lane) * 2);
            *(unsigned*)(KR + (size_t)row * 64 + 2 * lane) = pk_bf16(x1 * cs.x - x2 * cs.y, x1 * cs.y + x2 * cs.x); }
    }
}

#define MFMA32(a, b, c) __builtin_amdgcn_mfma_f32_32x32x16_bf16((a), (b), (c), 0, 0, 0)
DI int crow(int reg, int h) { return (reg & 3) + 8 * (reg >> 2) + 4 * h; }

DI void attn_phase(const Params& P, LAS unsigned char* lds, int tid, int wid, int lane, int bid) {
    unsigned char* ws_ = P.ws; asm volatile("" : "+s"(ws_));
    asm volatile("" : "+v"(tid)); lane = tid & 63; wid = __builtin_amdgcn_readfirstlane(tid >> 6);
    unsigned char* ar = ws_ + O_AR;
    const bf16_t* Q = (const bf16_t*)(ar + 48 * MiB); const bf16_t* KN = (const bf16_t*)(ar + 96 * MiB); const bf16_t* VT = (const bf16_t*)(ar + 128 * MiB); const bf16_t* KR = (const bf16_t*)(ar + 44 * MiB);
    bf16_t* AO = (bf16_t*)(ws_ + O_XN);
    const int l32 = lane & 31, h2 = lane >> 5;
    constexpr int BUFB = 43008, VOFF = 25600;
    const unsigned kn_off0 = (unsigned)(((tid >> 4) * 1024 + 8 * (tid & 15)) * 2);
    const unsigned kr_off = (unsigned)(((tid >> 3) * 64 + 8 * (tid & 7)) * 2);
    const unsigned vt_off0 = (unsigned)(((tid >> 3) * 16384 + 8 * (tid & 7)) * 2);
    const unsigned kn_l0 = (unsigned)((tid >> 4) * 400 + 16 * (tid & 15));
    const unsigned kr_l = (unsigned)((tid >> 3) * 400 + 256 + 16 * (tid & 7));
    const unsigned vt_l0 = (unsigned)(25600 + (tid >> 3) * 136 + 16 * (tid & 7));
    for (int item = bid; item < 256; item += gridDim.x) {
        const int head = item & 7, pair = item >> 3;
        for (int half = 0; half < 2; ++half) {
            const int qb = half ? 63 - pair : pair;
            const int wrow0 = qb * 256 + wid * 32, qrow = wrow0 + l32;
            bf16x8 Qf[12];
#pragma unroll
            for (int s = 0; s < 12; ++s) Qf[s] = *(const bf16x8*)(Q + (size_t)qrow * 1536 + head * 192 + 16 * s + 8 * h2);
            f32x16 o[4];
#pragma unroll
            for (int d = 0; d < 4; ++d)
#pragma unroll
                for (int r = 0; r < 16; ++r) o[d][r] = 0.f;
            float mrun = -INFINITY, lsum = 0.f;
            const int ntiles = 4 * (qb + 1);
            u32x4 kreg[3], vreg[2];
#define ATT_ISSUE(kt) do { \
    unsigned o0_ = kn_off0, o1_ = kr_off, o2_ = vt_off0; asm volatile("" : "+v"(o0_), "+v"(o1_), "+v"(o2_)); \
    const char* knb = (const char*)(KN + (size_t)(kt) * 65536 + head * 128); const char* krb = (const char*)(KR + (size_t)(kt) * 4096); \
    const char* vtb = (const char*)(VT + (size_t)head * 128 * 16384 + 64 * (kt)); \
    kreg[0] = *(const u32x4*)(knb + o0_); kreg[1] = *(const u32x4*)(knb + 65536 + o0_); kreg[2] = *(const u32x4*)(krb + o1_); \
    vreg[0] = *(const u32x4*)(vtb + o2_); vreg[1] = *(const u32x4*)(vtb + 2097152 + o2_); } while (0)
#define ATT_WRITE(b) do { LAS unsigned char* base = lds + (b) * BUFB; \
    *(LAS u32x4*)(base + kn_l0) = kreg[0]; *(LAS u32x4*)(base + kn_l0 + 12800) = kreg[1]; *(LAS u32x4*)(base + kr_l) = kreg[2]; \
    *(LAS u32x2*)(base + vt_l0) = (u32x2){vreg[0].x, vreg[0].y}; *(LAS u32x2*)(base + vt_l0 + 8) = (u32x2){vreg[0].z, vreg[0].w}; \
    *(LAS u32x2*)(base + vt_l0 + 8704) = (u32x2){vreg[1].x, vreg[1].y}; *(LAS u32x2*)(base + vt_l0 + 8712) = (u32x2){vreg[1].z, vreg[1].w}; } while (0)
            ATT_ISSUE(0); ATT_WRITE(0); __syncthreads();
            for (int kt = 0; kt < ntiles; ++kt) {
                const bool more = (kt + 1 < ntiles);
                if (more) ATT_ISSUE(kt + 1);
                if (64 * kt <= wrow0 + 31) {
                    LAS unsigned char* base = lds + (kt & 1) * BUFB;
                    f32x16 st0, st1;
#pragma unroll
                    for (int r = 0; r < 16; ++r) { st0[r] = 0.f; st1[r] = 0.f; }
                    {
                        const LAS unsigned char* kp = base + l32 * 400 + 16 * h2;
                        bf16x8 ka[2][4];
#define ATT_LDK(bf, gq) do { _Pragma("unroll") for (int sl = 0; sl < 2; ++sl) { ka[bf][2 * sl] = *(const LAS bf16x8*)(kp + 32 * (2 * (gq) + sl)); ka[bf][2 * sl + 1] = *(const LAS bf16x8*)(kp + 12800 + 32 * (2 * (gq) + sl)); } } while (0)
#define ATT_MMK(bf, gq) do { _Pragma("unroll") for (int sl = 0; sl < 2; ++sl) { st0 = MFMA32(ka[bf][2 * sl], Qf[2 * (gq) + sl], st0); st1 = MFMA32(ka[bf][2 * sl + 1], Qf[2 * (gq) + sl], st1); } } while (0)
                        ATT_LDK(0, 0); __builtin_amdgcn_sched_barrier(0);
                        ATT_LDK(1, 1); __builtin_amdgcn_sched_barrier(0);
                        ATT_MMK(0, 0); __builtin_amdgcn_sched_barrier(0);
                        ATT_LDK(0, 2); __builtin_amdgcn_sched_barrier(0);
                        ATT_MMK(1, 1); __builtin_amdgcn_sched_barrier(0);
                        ATT_LDK(1, 3); __builtin_amdgcn_sched_barrier(0);
                        ATT_MMK(0, 2); __builtin_amdgcn_sched_barrier(0);
                        ATT_LDK(0, 4); __builtin_amdgcn_sched_barrier(0);
                        ATT_MMK(1, 3); __builtin_amdgcn_sched_barrier(0);
                        ATT_LDK(1, 5); __builtin_amdgcn_sched_barrier(0);
                        ATT_MMK(0, 4); __builtin_amdgcn_sched_barrier(0);
                        ATT_MMK(1, 5); __builtin_amdgcn_sched_barrier(0);
#undef ATT_LDK
#undef ATT_MMK
                    }
                    if (64 * kt + 63 > wrow0) {
#pragma unroll
                        for (int r = 0; r < 16; ++r) { const int key0 = 64 * kt + crow(r, h2); if (key0 > qrow) st0[r] = -INFINITY; if (key0 + 32 > qrow) st1[r] = -INFINITY; }
                    }
                    float mx = st0[0];
#pragma unroll
                    for (int r = 1; r < 16; ++r) mx = fmaxf(mx, st0[r]);
#pragma unroll
                    for (int r = 0; r < 16; ++r) mx = fmaxf(mx, st1[r]);
                    mx = fmaxf(mx, shx(mx, 32, lane));
                    const float mn = fmaxf(mrun, mx);
                    const float alpha = __builtin_amdgcn_exp2f(mrun - mn);
                    mrun = mn;
                    float psum = 0.f;
#pragma unroll
                    for (int r = 0; r < 16; ++r) { st0[r] = __builtin_amdgcn_exp2f(st0[r] - mn); st1[r] = __builtin_amdgcn_exp2f(st1[r] - mn); psum += st0[r] + st1[r]; }
                    lsum = lsum * alpha + psum;
                    if (__builtin_amdgcn_ballot_w64(alpha != 1.f) != 0ull) {
#pragma unroll
                        for (int d = 0; d < 4; ++d)
#pragma unroll
                            for (int r = 0; r < 16; ++r) o[d][r] *= alpha;
                    }
                    {
                        const LAS unsigned char* vb = base + VOFF + l32 * 136 + 8 * h2;
                        u32x4 va[2][4];
#define ATT_LDV(bf, stp) do { _Pragma("unroll") for (int d = 0; d < 4; ++d) { const LAS unsigned char* vp = vb + d * 4352 + 32 * (stp); \
        const u32x2 lo = *(const LAS u32x2*)vp, hi = *(const LAS u32x2*)(vp + 16); va[bf][d] = (u32x4){lo.x, lo.y, hi.x, hi.y}; } } while (0)
#define ATT_MMV(bf, stv, sp) do { u32x4 pw; pw.x = pk_bf16(stv[8 * (sp)], stv[8 * (sp) + 1]); pw.y = pk_bf16(stv[8 * (sp) + 2], stv[8 * (sp) + 3]); pw.z = pk_bf16(stv[8 * (sp) + 4], stv[8 * (sp) + 5]); pw.w = pk_bf16(stv[8 * (sp) + 6], stv[8 * (sp) + 7]); \
        const bf16x8 pf = __builtin_bit_cast(bf16x8, pw); _Pragma("unroll") for (int d = 0; d < 4; ++d) o[d] = MFMA32(__builtin_bit_cast(bf16x8, va[bf][d]), pf, o[d]); } while (0)
                        ATT_LDV(0, 0); __builtin_amdgcn_sched_barrier(0);
                        ATT_LDV(1, 1); __builtin_amdgcn_sched_barrier(0);
                        ATT_MMV(0, st0, 0); __builtin_amdgcn_sched_barrier(0);
                        ATT_LDV(0, 2); __builtin_amdgcn_sched_barrier(0);
                        ATT_MMV(1, st0, 1); __builtin_amdgcn_sched_barrier(0);
                        ATT_LDV(1, 3); __builtin_amdgcn_sched_barrier(0);
                        ATT_MMV(0, st1, 0); __builtin_amdgcn_sched_barrier(0);
                        ATT_MMV(1, st1, 1); __builtin_amdgcn_sched_barrier(0);
#undef ATT_LDV
#undef ATT_MMV
                    }
                }
                if (more) ATT_WRITE((kt + 1) & 1);
                __syncthreads();
            }
            int t2_ = tid; asm volatile("" : "+v"(t2_));
            const int qrow2 = qb * 256 + (t2_ >> 6) * 32 + (t2_ & 31), h2b = (t2_ >> 5) & 1;
            const float ltot = lsum + shx(lsum, 32, lane);
            const float inv = 1.f / ltot;
#pragma unroll
            for (int d = 0; d < 4; ++d)
#pragma unroll
                for (int rg = 0; rg < 4; ++rg) { f32x4 v = {o[d][4 * rg] * inv, o[d][4 * rg + 1] * inv, o[d][4 * rg + 2] * inv, o[d][4 * rg + 3] * inv};
                    store_bf4(AO + (size_t)qrow2 * 1024 + head * 128 + d * 32 + 8 * rg + 4 * h2b, v); }
        }
    }
#undef ATT_ISSUE
#undef ATT_WRITE
}

DI void s5_precompute(const Params& P, LAS unsigned char* lds, int tid, int bid) {
    unsigned char* ws_ = P.ws; asm volatile("" : "+s"(ws_));
    asm volatile("" : "+v"(tid));
    LAS float* PWr = (LAS float*)lds;
    LAS float* PWi = PWr + 33 * 64;
    LAS float* BBr = PWi + 33 * 64;
    LAS float* BBi = BBr + 1024;
    LAS float* CRe = BBi + 1024;
    LAS float* CIm = CRe + 1024;
    LAS float* KT = CIm + 1024;
    const float* lam_re = P.in[22]; const float* lam_im = P.in[23]; const float* log_dt = P.in[24];
    const float* b_re = P.in[25]; const float* b_im = P.in[26]; const float* c_re = P.in[27]; const float* c_im = P.in[28]; const float* dsk = P.in[29];
    bf16_t* TF = (bf16_t*)(ws_ + O_AR + 40 * MiB); bf16_t* Eb = (bf16_t*)(ws_ + O_AR + 80 * MiB);
    for (int item = bid; item < 256; item += gridDim.x) {
        const int g = item >> 2, q = item & 3;
        __syncthreads();
        const float dt = expf(log_dt[g]);
        for (int e = tid; e < 33 * 64; e += 512) { const int j = e >> 6, p = e & 63; const float lr = lam_re[g * 64 + p], li = lam_im[g * 64 + p];
            const float mag = expf((float)j * (lr * dt)); float sn, cs; sincosf((float)j * (li * dt), &sn, &cs); PWr[e] = mag * cs; PWi[e] = mag * sn; }
        for (int e = tid; e < 1024; e += 512) { const int p = e >> 4; const float lr = lam_re[g * 64 + p], li = lam_im[g * 64 + p];
            const float mag = expf(lr * dt); float sn, cs; sincosf(li * dt, &sn, &cs); const float ar = mag * cs, ai = mag * sn;
            const float den = lr * lr + li * li; const float fre = ((ar - 1.f) * lr + ai * li) / den, fim = (ai * lr - (ar - 1.f) * li) / den;
            const float br = b_re[(size_t)g * 1024 + e], bi = b_im[(size_t)g * 1024 + e];
            BBr[e] = fre * br - fim * bi; BBi[e] = fre * bi + fim * br; }
        for (int e = tid; e < 1024; e += 512) { CRe[e] = c_re[(size_t)g * 1024 + e]; CIm[e] = c_im[(size_t)g * 1024 + e]; }
        __syncthreads();
        {
            const int pr_ = tid & 255, co = pr_ >> 4, ci = pr_ & 15, j0 = (tid >> 8) * 16;
            float a[16];
#pragma unroll
            for (int jj = 0; jj < 16; ++jj) a[jj] = 0.f;
            for (int p = 0; p < 64; ++p) {
                const float cr = CRe[co * 64 + p], cm = CIm[co * 64 + p], br = BBr[p * 16 + ci], bi = BBi[p * 16 + ci];
                const float xr = cr * br - cm * bi, xi = cr * bi + cm * br;
#pragma unroll
                for (int jj = 0; jj < 16; ++jj) a[jj] += xr * PWr[(j0 + jj) * 64 + p] - xi * PWi[(j0 + jj) * 64 + p];
            }
            if (j0 == 0 && co == ci) a[0] += dsk[g * 16 + co];
#pragma unroll
            for (int jj = 0; jj < 16; ++jj) KT[((j0 + jj) * 16 + co) * 16 + ci] = a[jj];
        }
        __syncthreads();
        for (int e = tid; e < 128 * 80; e += 512) { const int rr = e / 80, kc = e - rr * 80, n = 128 * q + rr, l = n >> 4, co = n & 15; float v[8];
            if (kc < 64) { const int lp = kc >> 1;
#pragma unroll
                for (int i = 0; i < 8; ++i) v[i] = (lp <= l) ? KT[((l - lp) * 16 + co) * 16 + 8 * (kc & 1) + i] : 0.f;
            } else {
                const bool im = kc >= 72; const int p0 = 8 * (kc - (im ? 72 : 64));
#pragma unroll
                for (int i = 0; i < 8; ++i) { const int p = p0 + i; const float cr = CRe[co * 64 + p], cm = CIm[co * 64 + p], pr = PWr[(l + 1) * 64 + p], pi = PWi[(l + 1) * 64 + p];
                    v[i] = im ? -(cr * pi + cm * pr) : (cr * pr - cm * pi); }
            }
            u32x4 o; o.x = pk_bf16(v[0], v[1]); o.y = pk_bf16(v[2], v[3]); o.z = pk_bf16(v[4], v[5]); o.w = pk_bf16(v[6], v[7]);
            *(u32x4*)(TF + ((size_t)(g * 512 + n)) * 640 + 8 * kc) = o; }
        for (int e = tid; e < 32 * 64; e += 512) { const int n = 32 * q + (e >> 6), kc = e & 63, p = n & 63, im = n >> 6, lp = kc >> 1; float v[8];
            const float pr = PWr[(31 - lp) * 64 + p], pi = PWi[(31 - lp) * 64 + p];
#pragma unroll
            for (int i = 0; i < 8; ++i) { const int ci = 8 * (kc & 1) + i; const float br = BBr[p * 16 + ci], bi = BBi[p * 16 + ci]; v[i] = im ? (pr * bi + pi * br) : (pr * br - pi * bi); }
            u32x4 o; o.x = pk_bf16(v[0], v[1]); o.y = pk_bf16(v[2], v[3]); o.z = pk_bf16(v[4], v[5]); o.w = pk_bf16(v[6], v[7]);
            *(u32x4*)(Eb + ((size_t)(g * 256 + n)) * 512 + 8 * kc) = o; }
    }
}

DI void s5_scan(const Params& P, int wid, int lane, int bid) {
    unsigned char* ws_ = P.ws; asm volatile("" : "+s"(ws_));
    asm volatile("" : "+v"(lane));
    if (wid != 0) return;
    const float* lam_re = P.in[22]; const float* lam_im = P.in[23]; const float* log_dt = P.in[24];
    const float* XE = (const float*)(ws_ + O_AR + 96 * MiB); bf16_t* UG = (bf16_t*)(ws_ + O_AR);
    for (int g = bid; g < 64; g += gridDim.x) {
        const int p = lane; const float dt = expf(log_dt[g]); const float lr = lam_re[g * 64 + p], li = lam_im[g * 64 + p];
        const float mag = expf(32.f * (lr * dt)); float sn, cs; sincosf(32.f * (li * dt), &sn, &cs); const float ar = mag * cs, ai = mag * sn;
        float cr = 0.f, ci = 0.f;
        const float* xe = XE + (size_t)g * 512 * 128; bf16_t* ug = UG + (size_t)g * 512 * 640;
        for (int c0 = 0; c0 < 512; c0 += 16) {
            float xr[16], xi[16];
#pragma unroll
            for (int i = 0; i < 16; ++i) { xr[i] = xe[(size_t)(c0 + i) * 128 + p]; xi[i] = xe[(size_t)(c0 + i) * 128 + 64 + p]; }
#pragma unroll
            for (int i = 0; i < 16; ++i) { ug[(size_t)(c0 + i) * 640 + 512 + p] = f2bf(cr); ug[(size_t)(c0 + i) * 640 + 576 + p] = f2bf(ci);
                const float nr = ar * cr - ai * ci + xr[i], ni = ar * ci + ai * cr + xi[i]; cr = nr; ci = ni; }
        }
    }
}

DI void cs_table(const Params& P, int gtid, int nthreads) {
    unsigned char* ws_ = P.ws; asm volatile("" : "+s"(ws_));
    asm volatile("" : "+v"(gtid));
    const int* pos = (const int*)P.in[1]; float* CS = (float*)(ws_ + O_CS);
    for (int e = gtid; e < S * 32; e += nthreads) { const int row = e >> 5, j = e & 31;
        const float invf = exp2f(-(float)j * (13.287712379549449f / 32.f)); const float ang = (float)pos[row] * invf; float sn, cs; sincosf(ang, &sn, &cs);
        *(f32x2*)(CS + (size_t)e * 2) = (f32x2){cs, sn}; }
}


#define XB_TMO      128
#define XB_XCNT(j)  (256  + 64 * (j))
#define XB_XSUB(j)  (1280 + 64 * (j))
#define XB_XGEN(j)  (2304 + 64 * (j))
#define XB_TOP      3328
#define XB_TOPGEN   3392
#define XCD_BAR_WORDS 3456
#define XB_SPIN_CAP (1u << 18)
DI unsigned xb_ld(unsigned* p)              { return __hip_atomic_load(p, __ATOMIC_RELAXED, __HIP_MEMORY_SCOPE_AGENT); }
DI unsigned xb_add(unsigned* p, unsigned v) { return __hip_atomic_fetch_add(p, v, __ATOMIC_RELAXED, __HIP_MEMORY_SCOPE_AGENT); }
DI unsigned xb_xcc_id() { return (unsigned)__builtin_amdgcn_s_getreg((3 << 11) | 20) & 0xFu; }
#define XB_SPIN(cond, bar) do { unsigned _sp = 0; while (cond) { __builtin_amdgcn_s_sleep(1); \
    if ((++_sp & 255u) == 0u) { if (xb_ld(&(bar)[XB_TMO])) break; if (_sp > XB_SPIN_CAP) { atomicAdd(&(bar)[XB_TMO], 1u); break; } } } } while (0)
struct XcdBarrier { unsigned* bar; unsigned x; volatile LAS unsigned* st; };
DI XcdBarrier xcd_barrier_post(unsigned* bar, volatile LAS unsigned* st) {
    XcdBarrier b; b.bar = bar; b.x = xb_xcc_id(); b.st = st;
    if (threadIdx.x == 0) (void)xb_add(&bar[XB_XCNT(b.x)], 1u);
    return b;
}
DI void xcd_barrier_complete(unsigned* bar, unsigned x, unsigned& nloc, unsigned& nx) {
    const unsigned G = gridDim.x * gridDim.y * gridDim.z;
    unsigned sum, cnt, mine, sp = 0u;
    for (;;) {
        sum = 0u; cnt = 0u; mine = 0u;
#pragma unroll
        for (unsigned j = 0; j < 16; ++j) { const unsigned c = xb_ld(&bar[XB_XCNT(j)]); sum += c; cnt += (c > 0u) ? 1u : 0u; mine = (j == x) ? c : mine; }
        if (sum == G) break;
        __builtin_amdgcn_s_sleep(1);
        if ((++sp & 255u) == 0u) { if (xb_ld(&bar[XB_TMO])) break; if (sp > XB_SPIN_CAP) { atomicAdd(&bar[XB_TMO], 1u); break; } }
    }
    nloc = mine > 0u ? mine : 1u; nx = cnt > 0u ? cnt : 1u;
}
DI void xcd_barrier(const XcdBarrier& b) {
    asm volatile("s_waitcnt vmcnt(0)" ::: "memory");
    __syncthreads();
    if (threadIdx.x == 0) {
        unsigned* bar = b.bar;
        __builtin_amdgcn_s_waitcnt(0);
        unsigned nloc = b.st[0], nx = b.st[1];
        if (nloc == 0u) { xcd_barrier_complete(bar, b.x, nloc, nx); b.st[0] = nloc; b.st[1] = nx; }
        const unsigned old = xb_add(&bar[XB_XSUB(b.x)], 1u);
        const unsigned gen = old / nloc;
        if (old + 1u == (gen + 1u) * nloc) {
            __builtin_amdgcn_fence(__ATOMIC_RELEASE, "agent");
            asm volatile("s_waitcnt vmcnt(0)" ::: "memory");
            const unsigned og = xb_add(&bar[XB_TOP], 1u);
            const unsigned tg = og / nx;
            if (og + 1u == (tg + 1u) * nx) xb_add(&bar[XB_TOPGEN], 1u);
            else XB_SPIN(xb_ld(&bar[XB_TOPGEN]) == tg, bar);
            __builtin_amdgcn_fence(__ATOMIC_ACQUIRE, "agent");
            xb_add(&bar[XB_XGEN(b.x)], 1u);
            asm volatile("s_waitcnt vmcnt(0)" ::: "memory");
        } else {
            XB_SPIN(xb_ld(&bar[XB_XGEN(b.x)]) == gen, bar);
            __builtin_amdgcn_fence(__ATOMIC_ACQUIRE, "agent");
            asm volatile("s_waitcnt vmcnt(0)" ::: "memory");
        }
    }
    __syncthreads();
}

__global__ void __launch_bounds__(512, 2) __attribute__((amdgpu_waves_per_eu(2, 2))) mega_fwd(Params P) {
    extern __shared__ __attribute__((aligned(16))) unsigned char smem[];
    LAS unsigned char* lds = (LAS unsigned char*)smem;
    cg::grid_group grid = cg::this_grid();
    __shared__ uint4 xb_words;
    if (threadIdx.x == 0) xb_words = make_uint4(0u, 0u, 0u, 0u);
    __syncthreads();
    const XcdBarrier xb = xcd_barrier_post((unsigned*)(P.ws + O_BAR), (volatile LAS unsigned*)&xb_words);
    const int G = gridDim.x, nthreads = G * 512, NGW = G * 8;
#pragma nounroll
    for (int st = 0; st < NSTEPS; ++st) {
        int nrep = PROBE_REP(st); asm volatile("" : "+s"(nrep));
_Pragma("nounroll") for (int rep = 0; rep < nrep; ++rep) {
        if (rep) __syncthreads();
        int tid = threadIdx.x; asm volatile("" : "+v"(tid));
        int bid = blockIdx.x; asm volatile("" : "+s"(bid));
        unsigned char* ws = P.ws; asm volatile("" : "+s"(ws));
        float* outp_ = P.out; asm volatile("" : "+s"(outp_));
        const float* ng = P.in[2];
        bf16_t* XN = (bf16_t*)(ws + O_XN); const bf16_t* Zb = (const bf16_t*)(ws + O_Z);
        GemmDesc g;
        if (get_gemm(P, st, g)) gemm_phase(lds, P, g, G, bid, tid);
        else switch (st) {
        case 0: conv_layer(P, 0, GW_, NGW, LANE_); cs_table(P, GTID_, nthreads);
                row_pass<RP_BF>(P.in[0], outp_, nullptr, nullptr, ng, XN, GW_, NGW, LANE_); break;
        case 3: gate_phase(P, lds, tid, WID_, LANE_, bid); break;
        case 5: case 11: case 14: case 22: case 30: {
            const int L = (st == 5) ? 0 : (st <= 14 ? 1 : (st == 22 ? 2 : 3)); const bool mlp = (st == 14);
            const float* hin = (st == 5) ? P.in[0] : outp_;
            const float* gpost = ng + (L * 4 + (mlp ? 3 : 1)) * 1024; const float* gpre = mlp ? ng + ((L + 1) * 4) * 1024 : ng + (L * 4 + 2) * 1024;
            row_pass<RP_BF>(hin, outp_, Zb, gpost, gpre, XN, GW_, NGW, LANE_);
            if (mlp) conv_layer(P, L + 1, GW_, NGW, LANE_);
        } break;
        case 8: row_pass<RP_F32>(outp_, outp_, Zb, ng + 3 * 1024, ng + 4 * 1024, ws + O_AR, GW_, NGW, LANE_); conv_layer(P, 1, GW_, NGW, LANE_); break;
        case 9: pool_phase(P, GTID_, nthreads); break;
        case 16: mla_rows(P, GW_, NGW, LANE_); break;
        case 20: attn_phase(P, lds, tid, WID_, LANE_, bid); break;
        case 25: row_pass<RP_S5>(outp_, outp_, Zb, ng + 11 * 1024, ng + 12 * 1024, ws + O_AR, GW_, NGW, LANE_); conv_layer(P, 3, GW_, NGW, LANE_); s5_precompute(P, lds, tid, bid); break;
        case 27: s5_scan(P, WID_, LANE_, bid); break;
        case 33: row_pass<RP_FINAL>(outp_, outp_, Zb, ng + 15 * 1024, nullptr, nullptr, GW_, NGW, LANE_); break;
        default: break;
        }
        }
        if (st == 0) grid.sync();
        else if (st != 2 && st != 17 && st != 18 && st != NSTEPS - 1) { xcd_barrier(xb); if (PROBE_SYNC) xcd_barrier(xb); }
    }
}
}

extern "C" void kernel_launch(void* const* d_in, const int* in_sizes, int n_in, void* d_out, int out_size, void* d_ws, size_t ws_size, hipStream_t stream) {
    static int grid = 0;
    if (grid == 0) {
        int dev = 0, cus = 0, per_cu = 0;
        hipGetDevice(&dev);
        hipDeviceGetAttribute(&cus, hipDeviceAttributeMultiprocessorCount, dev);
        hipFuncSetAttribute((const void*)mega_fwd, hipFuncAttributeMaxDynamicSharedMemorySize, LDS_BYTES);
        if (hipOccupancyMaxActiveBlocksPerMultiprocessor(&per_cu, (const void*)mega_fwd, 512, LDS_BYTES) != hipSuccess || per_cu < 1) per_cu = 1;
        (void)hipGetLastError();
        grid = cus * per_cu;
        if (grid <= 0) grid = 256;
    }
    Params p{};
    for (int i = 0; i < 32 && i < n_in; ++i) p.in[i] = (const float*)d_in[i];
    p.out = (float*)d_out; p.ws = (unsigned char*)d_ws;
    hipMemsetAsync((unsigned char*)d_ws + O_BAR, 0, XCD_BAR_WORDS * 4, stream);
    void* args[] = {&p};
    hipError_t e = hipLaunchCooperativeKernel((const void*)mega_fwd, dim3(grid), dim3(512), args, LDS_BYTES, stream);
    if (e != hipSuccess) fprintf(stderr, "cooperative launch failed: %s (grid %d)\n", hipGetErrorString(e), grid);
}
```

```cpp
#include <hip/hip_runtime.h>
#include <hip/hip_cooperative_groups.h>
#include <cstdio>
namespace cg = cooperative_groups;

#define DI __device__ __forceinline__
#define LAS __attribute__((address_space(3)))
typedef unsigned short bf16_t;
typedef short bf16x8 __attribute__((ext_vector_type(8)));
typedef float f32x2 __attribute__((ext_vector_type(2)));
typedef float f32x4 __attribute__((ext_vector_type(4)));
typedef float f32x16 __attribute__((ext_vector_type(16)));
typedef unsigned u32x2 __attribute__((ext_vector_type(2)));
typedef unsigned u32x4 __attribute__((ext_vector_type(4)));
typedef __bf16 bf16v2 __attribute__((ext_vector_type(2)));

#define LANE_ (tid & 63)
#define WID_ (__builtin_amdgcn_readfirstlane(tid >> 6))
#define GW_ (bid * 8 + WID_)
#define GTID_ (bid * 512 + tid)
#ifndef PROBE_REP
#define PROBE_REP(st) 1
#endif
#ifndef PROBE_SYNC
#define PROBE_SYNC 0
#endif
#define IS_GEMM_STEP(st) ((st)==1||(st)==4||(st)==6||(st)==7||(st)==10||(st)==12||(st)==13||(st)==15||(st)==17||(st)==18||(st)==19||(st)==21||(st)==23||(st)==24||(st)==26||(st)==28||(st)==29||(st)==31||(st)==32)
#define IS_MLP_STEP(st) ((st)==6||(st)==7||(st)==12||(st)==13||(st)==23||(st)==24||(st)==31||(st)==32)
namespace {
constexpr int S = 16384;
constexpr size_t MiB = (size_t)1 << 20;
constexpr size_t O_CS = 0, O_WUP = 4 * MiB, O_WDN = 12 * MiB, O_WMIX = 20 * MiB, O_XN = 28 * MiB, O_Z = 60 * MiB, O_AR = 92 * MiB;
constexpr int LDS_BYTES = 131072;
constexpr size_t O_BAR = 254 * MiB;
constexpr size_t O_STAT = 254 * MiB + 65536;
constexpr int NSTEPS = 34;
constexpr float RMS_EPS = 1e-6f;
constexpr float QSCALE = 0.07216878364870322f * 1.4426950408889634f;

enum { E_Z = 0, E_HID, E_UV, E_POOL, E_LAT, E_Q, E_KN, E_VT, E_XE, E_S5Y, E_GLU };

struct Params { const float* in[32]; float* out; unsigned char* ws; };

DI unsigned pk_bf16(float a, float b) { f32x2 f = {a, b}; bf16v2 h = __builtin_convertvector(f, bf16v2); return __builtin_bit_cast(unsigned, h); }
DI bf16_t f2bf(float x) { return (bf16_t)(pk_bf16(x, 0.f) & 0xffffu); }
DI float bf2f(bf16_t b) { return __uint_as_float(((unsigned)b) << 16); }
DI float bflo(unsigned u) { return __uint_as_float(u << 16); }
DI float bfhi(unsigned u) { return __uint_as_float(u & 0xffff0000u); }
DI float shx(float v, int o, int lane) { return __int_as_float(__builtin_amdgcn_ds_bpermute((lane ^ o) << 2, __float_as_int(v))); }
DI float wave_sum(float v, int lane) {
#pragma unroll
    for (int o = 1; o < 64; o <<= 1) v += shx(v, o, lane);
    return v;
}
DI void store_bf4(bf16_t* p, f32x4 v) { u32x2 w; w.x = pk_bf16(v[0], v[1]); w.y = pk_bf16(v[2], v[3]); *(u32x2*)p = w; }
DI float gelu_tanh(float x) {
    const float u = 0.7978845608028654f * (x + 0.044715f * x * x * x);
    const float e = __expf(-2.f * u);
    return x * __builtin_amdgcn_rcpf(1.f + e);
}

constexpr int BM = 256, BK = 64, HALF = 128, HTB = HALF * BK * 2, NXCD = 8, WGM = 8;
DI int lds_byte(int r, int c) { const int st = (r >> 4) * 2 + (c >> 5), rr = r & 15, cc = c & 31, ob = rr * 64 + cc * 2; return st * 1024 + (ob ^ (((ob >> 9) & 1) << 5)); }
DI void stage_rc(int b, int& R, int& C) { const int st = b / 1024, sb = b % 1024, swz = sb ^ (((sb >> 9) & 1) << 5); R = (st >> 1) * 16 + swz / 64; C = (st & 1) * 32 + (swz % 64) / 2; }

struct GemmDesc { const bf16_t* A; const bf16_t* Bt; long a_gs, b_gs; int K, lda, ldb, nM, nN, ngrp, mode; };
struct Unit { int pm, pn, grp; };

DI bool unit_next(const GemmDesc& g, int i, int G, int c, Unit& u) {
    const int nper = g.nM * g.nN;
    const long L = (long)i * G + c;
    const bool ok = L < (long)nper * g.ngrp;
    const int grp2 = (int)(L / nper), w = (int)(L - (long)grp2 * nper);
    const int nwg = nper, nM = g.nM, nN = g.nN;
    int wgid = w;
    { const int q = nwg / NXCD, r = nwg % NXCD, xcd = wgid % NXCD, off = wgid / NXCD; wgid = (xcd < r ? xcd * (q + 1) : r * (q + 1) + (xcd - r) * q) + off; }
    const int nig = WGM * nN, gid = wgid / nig, fm = gid * WGM, gsz = (nM - fm) < WGM ? (nM - fm) : WGM;
    const int gszc = gsz > 0 ? gsz : 1;
    const int pm1 = fm + ((wgid % nig) % gszc), pn1 = (wgid % nig) / gszc;
    const int pm2 = w % nM, pn2 = w / nM;
    const bool single = (g.ngrp == 1);
    Unit r; r.pm = single ? pm1 : pm2; r.pn = single ? pn1 : pn2; r.grp = single ? 0 : grp2;
    u = r;
    return ok;
}

DI int perm32(int rho) { const int n = rho >> 4, i = rho & 15; return 8 * (i >> 2) + 4 * n + (i & 3); }
DI void store_bf8(bf16_t* p, f32x4 a, f32x4 b) { u32x4 w; w.x = pk_bf16(a[0], a[1]); w.y = pk_bf16(a[2], a[3]); w.z = pk_bf16(b[0], b[1]); w.w = pk_bf16(b[2], b[3]); *(u32x4*)p = w; }
#define EPI_LOOP(...) \
    _Pragma("unroll") for (int ai = 0; ai < 2; ++ai) _Pragma("unroll") for (int m = 0; m < 4; ++m) { const int row = row0 + ai * HALF + m * 16; \
        _Pragma("unroll") for (int bj = 0; bj < 2; ++bj) { const int col = col0 + bj * HALF; f32x4 v0 = acc[ai][bj][m][0], v1 = acc[ai][bj][m][1]; __VA_ARGS__ } }

DI void epilogue(const Params& P, const GemmDesc& g, const f32x4 (&acc)[2][2][4][2], const Unit& u, int wr, int wc, int fr, int fq) {
    unsigned char* ws_ = P.ws; asm volatile("" : "+s"(ws_));
    unsigned char* ws = ws_;
    const int row0 = u.pm * BM + wr * 64 + fr, col0 = u.pn * BM + wc * 32 + 8 * fq;
    bf16_t* Zb = (bf16_t*)(ws + O_Z);
    bf16_t* AR = (bf16_t*)(ws + O_AR);
    switch (g.mode) {
    case E_Z: { EPI_LOOP( store_bf8(Zb + (size_t)row * 1024 + col, v0, v1); ) } break;
    case E_HID: { EPI_LOOP( _Pragma("unroll") for (int j = 0; j < 4; ++j) { const float t0 = fmaxf(v0[j], 0.f), t1 = fmaxf(v1[j], 0.f); v0[j] = t0 * t0; v1[j] = t1 * t1; } store_bf8(AR + (size_t)row * 4096 + col, v0, v1); ) } break;
    case E_UV: { const float* bin = P.in[6]; float* STAT = (float*)(ws + O_AR + 96 * MiB); const int lane_ = fr + 16 * fq;
#pragma unroll
        for (int ai = 0; ai < 2; ++ai)
#pragma unroll
            for (int m = 0; m < 4; ++m) { const int row = row0 + ai * HALF + m * 16; float s1 = 0.f, s2 = 0.f;
#pragma unroll
                for (int bj = 0; bj < 2; ++bj) { const int col = col0 + bj * HALF; f32x4 v0 = acc[ai][bj][m][0], v1 = acc[ai][bj][m][1];
                    const f32x4 b0 = *(const f32x4*)(bin + col); const f32x4 b1 = *(const f32x4*)(bin + col + 4);
#pragma unroll
                    for (int j = 0; j < 4; ++j) { v0[j] = gelu_tanh(v0[j] + b0[j]); v1[j] = gelu_tanh(v1[j] + b1[j]); s1 += v0[j] + v1[j]; s2 += v0[j] * v0[j] + v1[j] * v1[j]; }
                    bf16_t* dst = (col < 1024) ? (AR + (size_t)row * 1024 + col) : (AR + 16 * MiB + (size_t)row * 1024 + (col - 1024)); store_bf8(dst, v0, v1); }
                if (col0 >= 1024) {
                    s1 += shx(s1, 16, lane_); s2 += shx(s2, 16, lane_); s1 += shx(s1, 32, lane_); s2 += shx(s2, 32, lane_);
                    if (fq == 0) *(f32x2*)(STAT + ((size_t)row * 16 + (u.pn - 4) * 4 + wc) * 2) = (f32x2){s1, s2}; }
            }
    } break;
    case E_POOL: { const float* sc = P.in[13];
        EPI_LOOP( const int cgc = 256 * u.grp + col; const f32x4 s0 = *(const f32x4*)(sc + cgc); const f32x4 s1 = *(const f32x4*)(sc + cgc + 4); store_bf8(Zb + (size_t)row * 1024 + cgc, v0 * s0, v1 * s1); ) } break;
    case E_LAT: { EPI_LOOP( store_bf8(AR + (size_t)row * 768 + col, v0, v1); ) } break;
    case E_Q: { const float* CS = (const float*)(ws + O_CS); bf16_t* Qb = AR + 24 * MiB;
        EPI_LOOP( const int w = col % 192;
                  if (w >= 128) { const int j = (w - 128) >> 1; const f32x4 c0 = *(const f32x4*)(CS + ((size_t)row * 32 + j) * 2); const f32x4 c1 = *(const f32x4*)(CS + ((size_t)row * 32 + j) * 2 + 4);
                      const float a0 = v0[0] * c0[0] - v0[1] * c0[1]; const float a1 = v0[0] * c0[1] + v0[1] * c0[0]; const float a2 = v0[2] * c0[2] - v0[3] * c0[3]; const float a3 = v0[2] * c0[3] + v0[3] * c0[2];
                      const float e0 = v1[0] * c1[0] - v1[1] * c1[1]; const float e1 = v1[0] * c1[1] + v1[1] * c1[0]; const float e2 = v1[2] * c1[2] - v1[3] * c1[3]; const float e3 = v1[2] * c1[3] + v1[3] * c1[2];
                      v0[0] = a0; v0[1] = a1; v0[2] = a2; v0[3] = a3; v1[0] = e0; v1[1] = e1; v1[2] = e2; v1[3] = e3; }
                  store_bf8(Qb + (size_t)row * 1536 + col, v0 * QSCALE, v1 * QSCALE); ) } break;
    case E_KN: { bf16_t* KN = AR + 48 * MiB; EPI_LOOP( store_bf8(KN + (size_t)row * 1024 + col, v0, v1); ) } break;
    case E_VT: { bf16_t* VT = AR + 64 * MiB; EPI_LOOP( store_bf8(VT + (size_t)row * 16384 + col, v0, v1); ) } break;
    case E_XE: { float* XE = (float*)(ws + O_AR + 96 * MiB);
        EPI_LOOP( if (col < 128) { float* xp = XE + ((size_t)(u.grp * 512 + row)) * 128 + col; *(f32x4*)xp = v0; *(f32x4*)(xp + 4) = v1; } ) } break;
    case E_S5Y: { bf16_t* Y5 = AR + 56 * MiB;
        EPI_LOOP( const int l = col >> 4, c = col & 15; const int token = row * 32 + l; _Pragma("unroll") for (int j = 0; j < 4; ++j) { v0[j] = gelu_tanh(v0[j]); v1[j] = gelu_tanh(v1[j]); }
                  store_bf8(Y5 + (size_t)token * 1024 + u.grp * 16 + c, v0, v1); ) } break;
    case E_GLU: {
#pragma unroll
        for (int ai = 0; ai < 2; ++ai)
#pragma unroll
            for (int m = 0; m < 4; ++m) { const int row = row0 + ai * HALF + m * 16; const int oc = u.pn * 128 + wc * 32 + 8 * fq;
                const f32x4 a0 = acc[ai][0][m][0], a1 = acc[ai][0][m][1], b0 = acc[ai][1][m][0], b1 = acc[ai][1][m][1]; f32x4 v0, v1;
#pragma unroll
                for (int j = 0; j < 4; ++j) { v0[j] = a0[j] * __builtin_amdgcn_rcpf(1.f + __expf(-b0[j])); v1[j] = a1[j] * __builtin_amdgcn_rcpf(1.f + __expf(-b1[j])); }
                store_bf8(Zb + (size_t)row * 1024 + oc, v0, v1); }
    } break;
    default: break;
    }
}

DI void gemm_phase(LAS unsigned char* lds, const Params& P, const GemmDesc g, const int G, const int cidx, int tid) {
    asm volatile("" : "+v"(tid));
    const int wid = __builtin_amdgcn_readfirstlane(tid >> 6), lane = tid & 63, wr = wid >> 2, wc = wid & 3, fr = lane & 15, fq = lane >> 4;
    const int K = g.K, nt = K / BK;
    unsigned voffA[2], voffB[2];
#pragma unroll
    for (int i = 0; i < 2; ++i) { int R, C; stage_rc(tid * 16 + i * 8192, R, C); const int Rb = (R & ~31) + perm32(R & 31); voffA[i] = (unsigned)(R * g.lda + C) * 2u; voffB[i] = (unsigned)(Rb * g.ldb + C) * 2u; }
    const size_t kstep = (size_t)(BK * 2);
    const size_t hstepA = (size_t)HALF * g.lda * 2, hstepB = (size_t)HALF * g.ldb * 2;
    const unsigned ldsw = (unsigned)wid * 1024u;
    const int aoff = lds_byte(wr * 64 + fr, fq * 8), boff = lds_byte(wc * 32 + fr, fq * 8);
#define PG8_SA(b, h) (((b) * 2 + (h)) * HTB)
#define PG8_SB(b, h) ((4 + (b) * 2 + (h)) * HTB)
#define PG8_STAGE(bufoff, gbase, voff) do { _Pragma("unroll") for (int _i = 0; _i < 2; ++_i) \
        __builtin_amdgcn_global_load_lds((const unsigned*)((const char*)(gbase) + (voff)[_i]), (LAS unsigned*)(lds + (bufoff) + ldsw + _i * 8192), 16, 0, 0); } while (0)
#define PG8_LDA(dst, b, h) do { _Pragma("unroll") for (int m = 0; m < 4; ++m) _Pragma("unroll") for (int k = 0; k < 2; ++k) dst[m][k] = *(const LAS bf16x8*)(lds + PG8_SA(b, h) + aoff + m * 2048 + k * 1024); } while (0)
#define PG8_LDB(dst, b, h) do { _Pragma("unroll") for (int n = 0; n < 2; ++n) _Pragma("unroll") for (int k = 0; k < 2; ++k) dst[n][k] = *(const LAS bf16x8*)(lds + PG8_SB(b, h) + boff + n * 2048 + k * 1024); } while (0)
#define PG8_MMA(ai, bj, At, Bt) do { __builtin_amdgcn_s_setprio(1); _Pragma("unroll") for (int m = 0; m < 4; ++m) _Pragma("unroll") for (int n = 0; n < 2; ++n) _Pragma("unroll") for (int k = 0; k < 2; ++k) \
        acc[ai][bj][m][n] = __builtin_amdgcn_mfma_f32_16x16x32_bf16(Bt[n][k], At[m][k], acc[ai][bj][m][n], 0, 0, 0); __builtin_amdgcn_s_setprio(0); } while (0)
#define PG8_WAIT_V(n) asm volatile("s_waitcnt vmcnt(" #n ")" ::: "memory")
#define PG8_WAIT_L(n) asm volatile("s_waitcnt lgkmcnt(" #n ")" ::: "memory")
#define PG8_BAR __builtin_amdgcn_s_barrier()
#define PG8_SCHED __builtin_amdgcn_sched_barrier(0)
    Unit cur, nxt; int ui = 0;
    if (!unit_next(g, 0, G, cidx, cur)) return;
    f32x4 acc[2][2][4][2];
#pragma unroll
    for (int a = 0; a < 2; ++a)
#pragma unroll
        for (int b = 0; b < 2; ++b)
#pragma unroll
            for (int m = 0; m < 4; ++m)
#pragma unroll
                for (int n = 0; n < 2; ++n) acc[a][b][m][n] = (f32x4){0.f, 0.f, 0.f, 0.f};
    bf16x8 At[4][2], B0[2][2], B1[2][2];
    const char* cA = (const char*)g.A + ((size_t)cur.grp * g.a_gs + (size_t)cur.pm * BM * g.lda) * 2;
    const char* cB = (const char*)g.Bt + ((size_t)cur.grp * g.b_gs + (size_t)cur.pn * BM * g.ldb) * 2;
    PG8_STAGE(PG8_SB(0, 0), cB, voffB); PG8_STAGE(PG8_SA(0, 0), cA, voffA); PG8_STAGE(PG8_SB(0, 1), cB + hstepB, voffB); PG8_STAGE(PG8_SA(0, 1), cA + hstepA, voffA);
    if (wr == 1) PG8_BAR;
    PG8_WAIT_V(4); PG8_BAR;
    PG8_STAGE(PG8_SB(1, 0), cB + kstep, voffB); PG8_STAGE(PG8_SA(1, 0), cA + kstep, voffA); PG8_STAGE(PG8_SB(1, 1), cB + hstepB + kstep, voffB);
    PG8_WAIT_V(6); PG8_BAR;
    for (;;) {
        const bool has_next = unit_next(g, ui + 1, G, cidx, nxt);
        const char* nA = has_next ? (const char*)g.A + ((size_t)nxt.grp * g.a_gs + (size_t)nxt.pm * BM * g.lda) * 2 : cA;
        const char* nB = has_next ? (const char*)g.Bt + ((size_t)nxt.grp * g.b_gs + (size_t)nxt.pn * BM * g.ldb) * 2 : cB;
        for (int t = 0; t < nt; t += 2) {
            const bool last = (t == nt - 2);
            const char* a1 = cA + (size_t)(t + 1) * kstep;
            const char* a2 = last ? nA : cA + (size_t)(t + 2) * kstep; const char* b2 = last ? nB : cB + (size_t)(t + 2) * kstep;
            const char* a3 = a2 + kstep; const char* b3 = b2 + kstep;
            PG8_LDB(B0, 0, 0); PG8_SCHED; PG8_LDA(At, 0, 0); PG8_STAGE(PG8_SA(1, 1), a1 + hstepA, voffA);
            PG8_WAIT_L(8); PG8_BAR; PG8_WAIT_L(0); PG8_MMA(0, 0, At, B0); PG8_BAR; PG8_SCHED;
            PG8_LDB(B1, 0, 1); PG8_STAGE(PG8_SB(0, 0), b2, voffB);
            PG8_BAR; PG8_WAIT_L(0); PG8_MMA(0, 1, At, B1); PG8_BAR;
            PG8_LDA(At, 0, 1); PG8_STAGE(PG8_SA(0, 0), a2, voffA);
            PG8_BAR; PG8_WAIT_L(0); PG8_MMA(1, 0, At, B0); PG8_BAR; PG8_SCHED;
            PG8_STAGE(PG8_SB(0, 1), b2 + hstepB, voffB);
            PG8_WAIT_V(6); PG8_BAR; PG8_MMA(1, 1, At, B1); PG8_BAR;
            PG8_LDB(B0, 1, 0); PG8_SCHED; PG8_LDA(At, 1, 0); PG8_STAGE(PG8_SA(0, 1), a2 + hstepA, voffA);
            PG8_WAIT_L(8); PG8_BAR; PG8_WAIT_L(0); PG8_MMA(0, 0, At, B0); PG8_BAR; PG8_SCHED;
            PG8_LDB(B1, 1, 1); PG8_STAGE(PG8_SB(1, 0), b3, voffB);
            PG8_BAR; PG8_WAIT_L(0); PG8_MMA(0, 1, At, B1); PG8_BAR;
            PG8_LDA(At, 1, 1); PG8_STAGE(PG8_SA(1, 0), a3, voffA);
            PG8_BAR; PG8_WAIT_L(0); PG8_MMA(1, 0, At, B0); PG8_BAR; PG8_SCHED;
            PG8_STAGE(PG8_SB(1, 1), b3 + hstepB, voffB);
            PG8_WAIT_V(6); PG8_BAR; PG8_MMA(1, 1, At, B1); PG8_BAR;
        }
        epilogue(P, g, acc, cur, wr, wc, fr, fq);
        if (!has_next) break;
#pragma unroll
        for (int a = 0; a < 2; ++a)
#pragma unroll
            for (int b = 0; b < 2; ++b)
#pragma unroll
                for (int m = 0; m < 4; ++m)
#pragma unroll
                    for (int n = 0; n < 2; ++n) acc[a][b][m][n] = (f32x4){0.f, 0.f, 0.f, 0.f};
        cur = nxt; cA = nA; cB = nB; ++ui;
    }
    PG8_WAIT_V(0);
    if (wr == 0) PG8_BAR;
    PG8_BAR;
}

DI bool get_gemm(const Params& P, int st, GemmDesc& g) {
    unsigned char* ws_ = P.ws; asm volatile("" : "+s"(ws_));
    unsigned char* ws = ws_;
    const bf16_t* XN = (const bf16_t*)(ws + O_XN);
    const bf16_t* WMIX = (const bf16_t*)(ws + O_WMIX);
    const bf16_t* AR = (const bf16_t*)(ws + O_AR);
    g.a_gs = 0; g.b_gs = 0; g.ngrp = 1; g.nM = 64; g.K = 1024; g.lda = 1024; g.ldb = 1024; g.A = XN; g.Bt = WMIX; g.nN = 4; g.mode = E_Z;
    switch (st) {
    case 1: g.nN = 8; g.mode = E_UV; return true;
    case 4: g.A = AR + 32 * MiB; g.Bt = WMIX + 2 * MiB; return true;
    case 6: case 12: case 23: case 31: g.Bt = (const bf16_t*)(ws + O_WUP); g.nN = 16; g.mode = E_HID; return true;
    case 7: case 13: case 24: case 32: g.A = AR; g.Bt = (const bf16_t*)(ws + O_WDN); g.K = 4096; g.lda = 4096; g.ldb = 4096; return true;
    case 10: g.A = AR + 32 * MiB; g.K = 256; g.ldb = 256; g.nN = 1; g.ngrp = 4; g.a_gs = 256; g.b_gs = 65536; g.mode = E_POOL; return true;
    case 15: g.nN = 3; g.mode = E_LAT; return true;
    case 17: g.A = AR + 12 * MiB; g.Bt = WMIX + 1 * MiB; g.K = 384; g.lda = 384; g.ldb = 384; g.nN = 6; g.mode = E_Q; return true;
    case 18: g.A = AR + 18 * MiB; g.Bt = WMIX + 2 * MiB; g.K = 256; g.lda = 256; g.ldb = 256; g.nN = 4; g.mode = E_KN; return true;
    case 19: g.A = WMIX + (5 * MiB) / 2; g.Bt = AR + 18 * MiB; g.K = 256; g.lda = 256; g.ldb = 256; g.nM = 4; g.nN = 64; g.mode = E_VT; return true;
    case 21: g.Bt = WMIX + 3 * MiB; return true;
    case 26: g.A = AR; g.Bt = AR + 40 * MiB; g.K = 512; g.lda = 640; g.ldb = 512; g.nM = 2; g.nN = 1; g.ngrp = 64; g.a_gs = 512 * 640; g.b_gs = 256 * 512; g.mode = E_XE; return true;
    case 28: g.A = AR; g.Bt = AR + 20 * MiB; g.K = 640; g.lda = 640; g.ldb = 640; g.nM = 2; g.nN = 2; g.ngrp = 64; g.a_gs = 512 * 640; g.b_gs = 512 * 640; g.mode = E_S5Y; return true;
    case 29: g.A = AR + 56 * MiB; g.nN = 8; g.mode = E_GLU; return true;
    default: return false;
    }
}

enum { RP_BF = 0, RP_F32 = 1, RP_S5 = 2, RP_FINAL = 3 };
template <int MODE>
DI void row_pass(const float* hin, float* hout, const bf16_t* z, const float* gpost, const float* gpre, void* outp, int gw, int NGW, int lane) {
    asm volatile("" : "+v"(lane));
    for (int rowa = gw; rowa < S; rowa += 2 * NGW) {
        f32x4 h[2][4];
#pragma unroll
        for (int q = 0; q < 2; ++q) { const int row = rowa + q * NGW;
#pragma unroll
            for (int j = 0; j < 4; ++j) { const int cb = (MODE == RP_S5) ? 16 * lane + 4 * j : 4 * lane + 256 * j; h[q][j] = *(const f32x4*)(hin + (size_t)row * 1024 + cb); } }
        if (z) {
            f32x4 zz[2][4]; float ss[2] = {0.f, 0.f};
#pragma unroll
            for (int q = 0; q < 2; ++q) { const int row = rowa + q * NGW;
#pragma unroll
                for (int j = 0; j < 4; ++j) { const int cb = (MODE == RP_S5) ? 16 * lane + 4 * j : 4 * lane + 256 * j; const u32x2 w = *(const u32x2*)(z + (size_t)row * 1024 + cb);
                    zz[q][j] = (f32x4){bflo(w.x), bfhi(w.x), bflo(w.y), bfhi(w.y)}; ss[q] += zz[q][j][0] * zz[q][j][0] + zz[q][j][1] * zz[q][j][1] + zz[q][j][2] * zz[q][j][2] + zz[q][j][3] * zz[q][j][3]; } }
#pragma unroll
            for (int q = 0; q < 2; ++q) { const int row = rowa + q * NGW;
                const float rz = rsqrtf(wave_sum(ss[q], lane) * (1.f / 1024.f) + RMS_EPS);
#pragma unroll
                for (int j = 0; j < 4; ++j) { const int cb = (MODE == RP_S5) ? 16 * lane + 4 * j : 4 * lane + 256 * j; const f32x4 gp = *(const f32x4*)(gpost + cb); h[q][j] += zz[q][j] * rz * gp;
                    *(f32x4*)(hout + (size_t)row * 1024 + cb) = h[q][j]; } }
        }
        if (MODE != RP_FINAL) {
#pragma unroll
            for (int q = 0; q < 2; ++q) { const int row = rowa + q * NGW;
                float s2 = 0.f;
#pragma unroll
                for (int j = 0; j < 4; ++j) s2 += h[q][j][0] * h[q][j][0] + h[q][j][1] * h[q][j][1] + h[q][j][2] * h[q][j][2] + h[q][j][3] * h[q][j][3];
                const float rn = rsqrtf(wave_sum(s2, lane) * (1.f / 1024.f) + RMS_EPS);
#pragma unroll
                for (int j = 0; j < 4; ++j) { const int cb = (MODE == RP_S5) ? 16 * lane + 4 * j : 4 * lane + 256 * j; const f32x4 gq = *(const f32x4*)(gpre + cb); const f32x4 xn = h[q][j] * rn * gq;
                    if (MODE == RP_BF) store_bf4((bf16_t*)outp + (size_t)row * 1024 + cb, xn);
                    if (MODE == RP_F32) *(f32x4*)((float*)outp + (size_t)row * 1024 + cb) = xn;
                    if (MODE == RP_S5) store_bf4((bf16_t*)outp + ((size_t)(lane * 512 + (row >> 5))) * 640 + (row & 31) * 16 + 4 * j, xn); } }
        }
    }
}

enum { MAP_ID = 0, MAP_UQ = 1, MAP_GLUA = 2, MAP_GLUB = 3 };
DI int dstrow(int mode, int n) {
    if (mode == MAP_UQ) { const int hd = n / 192, w = n - hd * 192; if (w < 128) return n; const int r = w - 128; return hd * 192 + 128 + 2 * (r & 31) + (r >> 5); }
    if (mode == MAP_GLUA) return (n >> 7) * 256 + (n & 127);
    if (mode == MAP_GLUB) return (n >> 7) * 256 + 128 + (n & 127);
    return n;
}
DI void convT(const float* src, int K, int N, bf16_t* dst, int ldT, int mapmode, int gw, int NGW, int lane) {
    asm volatile("" : "+v"(lane));
    const int nnb = N >> 4, nitems = nnb * (K >> 5);
    for (int it = gw; it < nitems; it += NGW) {
        const int kb = it / nnb, nb = it - kb * nnb;
        const int n = nb * 16 + (lane >> 2), k = kb * 32 + 8 * (lane & 3);
        const float* s = src + (size_t)k * N + n;
        float v[8];
#pragma unroll
        for (int i = 0; i < 8; ++i) v[i] = s[(size_t)i * N];
        u32x4 o; o.x = pk_bf16(v[0], v[1]); o.y = pk_bf16(v[2], v[3]); o.z = pk_bf16(v[4], v[5]); o.w = pk_bf16(v[6], v[7]);
        *(u32x4*)(dst + (size_t)dstrow(mapmode, n) * ldT + k) = o;
    }
}
DI void conv_layer(const Params& P, int L, int gw, int NGW, int lane) {
    unsigned char* ws_ = P.ws; asm volatile("" : "+s"(ws_));
    unsigned char* ws = ws_;
    bf16_t* WMIX = (bf16_t*)(ws + O_WMIX);
    convT(P.in[3] + (size_t)L * 1024 * 4096, 1024, 4096, (bf16_t*)(ws + O_WUP), 1024, MAP_ID, gw, NGW, lane);
    convT(P.in[4] + (size_t)L * 1024 * 4096, 4096, 1024, (bf16_t*)(ws + O_WDN), 4096, MAP_ID, gw, NGW, lane);
    if (L == 0) {
        convT(P.in[5], 1024, 2048, WMIX, 1024, MAP_ID, gw, NGW, lane);
        convT(P.in[11], 1024, 1024, WMIX + 2 * MiB, 1024, MAP_ID, gw, NGW, lane);
        const float* wsrc = P.in[9]; bf16_t* wd = WMIX + 3 * MiB;
        for (int e = gw * 64 + lane; e < 8 * 128 * 128 / 4; e += NGW * 64) { const int s0 = (e * 4) & 127, t = ((e * 4) >> 7) & 127; f32x4 w = *(const f32x4*)(wsrc + (size_t)e * 4);
#pragma unroll
            for (int j = 0; j < 4; ++j) if (s0 + j > t) w[j] = 0.f;
            store_bf4(wd + (size_t)e * 4, w); }
    } else if (L == 1) {
        for (int gg = 0; gg < 4; ++gg) convT(P.in[12] + gg * 65536, 256, 256, WMIX + gg * 65536, 256, MAP_ID, gw, NGW, lane);
    } else if (L == 2) {
        convT(P.in[14], 1024, 384, WMIX, 1024, MAP_ID, gw, NGW, lane);
        convT(P.in[17], 1024, 320, WMIX + 384 * 1024, 1024, MAP_ID, gw, NGW, lane);
        convT(P.in[16], 384, 1536, WMIX + 1 * MiB, 384, MAP_UQ, gw, NGW, lane);
        convT(P.in[19], 256, 1024, WMIX + 2 * MiB, 256, MAP_ID, gw, NGW, lane);
        convT(P.in[20], 256, 1024, WMIX + (5 * MiB) / 2, 256, MAP_ID, gw, NGW, lane);
        convT(P.in[21], 1024, 1024, WMIX + 3 * MiB, 1024, MAP_ID, gw, NGW, lane);
    } else {
        convT(P.in[30], 1024, 1024, WMIX, 1024, MAP_GLUA, gw, NGW, lane);
        convT(P.in[31], 1024, 1024, WMIX, 1024, MAP_GLUB, gw, NGW, lane);
    }
}

DI void lnv_phase(const Params& P, int gw, int NGW, int lane) {
    unsigned char* ws_ = P.ws; asm volatile("" : "+s"(ws_));
    asm volatile("" : "+v"(lane));
    bf16_t* V = (bf16_t*)(ws_ + O_AR + 32 * MiB);
    const float* gv = P.in[7]; const float* bv = P.in[8];
    for (int row = gw; row < S; row += NGW) {
        f32x4 x[4]; float s = 0.f;
#pragma unroll
        for (int j = 0; j < 4; ++j) { const u32x2 w = *(const u32x2*)(V + (size_t)row * 1024 + 4 * lane + 256 * j); x[j] = (f32x4){bflo(w.x), bfhi(w.x), bflo(w.y), bfhi(w.y)}; s += x[j][0] + x[j][1] + x[j][2] + x[j][3]; }
        const float mu = wave_sum(s, lane) * (1.f / 1024.f); float s2 = 0.f;
#pragma unroll
        for (int j = 0; j < 4; ++j) { x[j] = x[j] - mu; s2 += x[j][0] * x[j][0] + x[j][1] * x[j][1] + x[j][2] * x[j][2] + x[j][3] * x[j][3]; }
        const float rs = rsqrtf(wave_sum(s2, lane) * (1.f / 1024.f) + RMS_EPS);
#pragma unroll
        for (int j = 0; j < 4; ++j) { const int cb = 4 * lane + 256 * j; const f32x4 g4 = *(const f32x4*)(gv + cb), b4 = *(const f32x4*)(bv + cb); store_bf4(V + (size_t)row * 1024 + cb, x[j] * rs * g4 + b4); }
    }
}

DI void gate_phase(const Params& P, LAS unsigned char* lds, int tid, int wid, int lane, int bid) {
    unsigned char* ws_ = P.ws; asm volatile("" : "+s"(ws_));
    asm volatile("" : "+v"(tid)); lane = tid & 63; wid = __builtin_amdgcn_readfirstlane(tid >> 6);
    LAS bf16_t* Wt = (LAS bf16_t*)lds;
    LAS bf16_t* Vt = Wt + 128 * 136;
    const bf16_t* Wsb = (const bf16_t*)(ws_ + O_WMIX + 6 * MiB);
    const bf16_t* U = (const bf16_t*)(ws_ + O_AR);
    const bf16_t* V = (const bf16_t*)(ws_ + O_AR + 32 * MiB);
    bf16_t* Y = (bf16_t*)(ws_ + O_AR + 64 * MiB);
    const float* bs = P.in[10]; const float* gv = P.in[7]; const float* bv = P.in[8]; const float* STAT = (const float*)(ws_ + O_AR + 96 * MiB);
    LAS float* mus = (LAS float*)(lds + 69632); LAS float* rss = mus + 128;
    const int r16 = lane & 15, quad = lane >> 4;
    for (int item = bid; item < 1024; item += gridDim.x) {
        const int hd = item & 7, c = item >> 3;
        __syncthreads();
        if (tid < 128) { const f32x4* pp = (const f32x4*)(STAT + (size_t)(c * 128 + tid) * 32); float a1 = 0.f, a2 = 0.f;
#pragma unroll
            for (int i = 0; i < 8; ++i) { const f32x4 t4 = pp[i]; a1 += t4[0] + t4[2]; a2 += t4[1] + t4[3]; }
            const float mu = a1 * (1.f / 1024.f); mus[tid] = mu; rss[tid] = rsqrtf(fmaxf(a2 * (1.f / 1024.f) - mu * mu, 0.f) + RMS_EPS); }
#pragma unroll
        for (int i = 0; i < 4; ++i) { const int cid = tid + 512 * i, t = cid >> 4, sc = cid & 15;
            const u32x4 w = *(const u32x4*)(Wsb + ((size_t)(hd * 128 + t)) * 128 + 8 * sc); *(LAS u32x4*)(Wt + t * 136 + 8 * sc) = w; }
        __syncthreads();
#pragma unroll
        for (int i = 0; i < 4; ++i) { const int cid = tid + 512 * i, s = cid >> 4, dc = cid & 15;
            const int grow = c * 128 + s, gcol = hd * 128 + 8 * dc;
            const u32x4 w = *(const u32x4*)(V + (size_t)grow * 1024 + gcol);
            const float mu = mus[s], rs = rss[s];
            const f32x4 g0 = *(const f32x4*)(gv + gcol), g1 = *(const f32x4*)(gv + gcol + 4), b0 = *(const f32x4*)(bv + gcol), b1 = *(const f32x4*)(bv + gcol + 4);
            float y[8];
#pragma unroll
            for (int e = 0; e < 8; ++e) { const float x = (e & 1) ? bfhi(w[e >> 1]) : bflo(w[e >> 1]); y[e] = (x - mu) * rs * ((e < 4) ? g0[e & 3] : g1[e & 3]) + ((e < 4) ? b0[e & 3] : b1[e & 3]); }
#pragma unroll
            for (int e = 0; e < 8; ++e) Vt[(8 * dc + e) * 136 + s] = f2bf(y[e]); }
        __syncthreads();
        const int t = 16 * wid + r16;
        const int nks = (16 * wid + 15) / 32 + 1;
        bf16x8 bw[4];
#pragma unroll
        for (int ks = 0; ks < 4; ++ks) bw[ks] = *(const LAS bf16x8*)(Wt + t * 136 + 32 * ks + 8 * quad);
        const int token = c * 128 + t;
        const float bias = bs[hd * 128 + t];
#pragma unroll
        for (int dt = 0; dt < 8; ++dt) {
            f32x4 acc = {0.f, 0.f, 0.f, 0.f};
#pragma unroll
            for (int ks = 0; ks < 4; ++ks) if (ks < nks) {
                const bf16x8 a = *(const LAS bf16x8*)(Vt + (16 * dt + r16) * 136 + 32 * ks + 8 * quad);
                acc = __builtin_amdgcn_mfma_f32_16x16x32_bf16(a, bw[ks], acc, 0, 0, 0); }
            const int col = hd * 128 + 16 * dt + 4 * quad;
            const u32x2 uu = *(const u32x2*)(U + (size_t)token * 1024 + col);
            f32x4 y; y[0] = (acc[0] + bias) * bflo(uu.x); y[1] = (acc[1] + bias) * bfhi(uu.x); y[2] = (acc[2] + bias) * bflo(uu.y); y[3] = (acc[3] + bias) * bfhi(uu.y);
            store_bf4(Y + (size_t)token * 1024 + col, y);
        }
    }
}

DI void pool_phase(const Params& P, int gtid, int nthreads) {
    unsigned char* ws_ = P.ws; asm volatile("" : "+s"(ws_));
    asm volatile("" : "+v"(gtid));
    const float* ZF = (const float*)(ws_ + O_AR);
    bf16_t* Pb = (bf16_t*)(ws_ + O_AR + 64 * MiB);
    for (int e = gtid; e < 1024 * 256; e += nthreads) {
        const int cgi = e & 255, tb = e >> 8, col = 4 * cgi, w = 2 << (cgi >> 6), t0 = 16 * tb;
        f32x4 W = {0.f, 0.f, 0.f, 0.f};
        for (int j = 1; j < w; ++j) if (t0 - j >= 0) W += *(const f32x4*)(ZF + (size_t)(t0 - j) * 1024 + col);
        for (int i = 0; i < 16; ++i) { const int t = t0 + i; const f32x4 z = *(const f32x4*)(ZF + (size_t)t * 1024 + col); W += z;
            const float cnt = (float)((t + 1 < w) ? (t + 1) : w); const f32x4 o = W / cnt - z; store_bf4(Pb + (size_t)t * 1024 + col, o);
            if (t - w + 1 >= 0) W -= *(const f32x4*)(ZF + (size_t)(t - w + 1) * 1024 + col); }
    }
}

DI void mla_rows(const Params& P, int gw, int NGW, int lane) {
    unsigned char* ws_ = P.ws; asm volatile("" : "+s"(ws_));
    asm volatile("" : "+v"(lane));
    unsigned char* ar = ws_ + O_AR;
    const bf16_t* LAT = (const bf16_t*)ar; bf16_t* QL = (bf16_t*)(ar + 24 * MiB); bf16_t* Cb = (bf16_t*)(ar + 36 * MiB); bf16_t* KR = (bf16_t*)(ar + 44 * MiB);
    const float* CS = (const float*)(ws_ + O_CS); const float* gq = P.in[15]; const float* gkv = P.in[18];
    for (int row = gw; row < S; row += NGW) {
        const bf16_t* lat = LAT + (size_t)row * 768;
        float q[6]; float ss = 0.f;
#pragma unroll
        for (int i = 0; i < 3; ++i) { const unsigned w = *(const unsigned*)(lat + 2 * lane + 128 * i); q[2 * i] = bflo(w); q[2 * i + 1] = bfhi(w); ss += q[2 * i] * q[2 * i] + q[2 * i + 1] * q[2 * i + 1]; }
        ss = wave_sum(ss, lane); const float rq = rsqrtf(ss * (1.f / 384.f) + RMS_EPS);
#pragma unroll
        for (int i = 0; i < 3; ++i) { const f32x2 g2 = *(const f32x2*)(gq + 2 * lane + 128 * i); *(unsigned*)(QL + (size_t)row * 384 + 2 * lane + 128 * i) = pk_bf16(q[2 * i] * rq * g2.x, q[2 * i + 1] * rq * g2.y); }
        float cc[4]; float s2 = 0.f;
#pragma unroll
        for (int i = 0; i < 2; ++i) { const unsigned w = *(const unsigned*)(lat + 384 + 2 * lane + 128 * i); cc[2 * i] = bflo(w); cc[2 * i + 1] = bfhi(w); s2 += cc[2 * i] * cc[2 * i] + cc[2 * i + 1] * cc[2 * i + 1]; }
        s2 = wave_sum(s2, lane); const float rc = rsqrtf(s2 * (1.f / 256.f) + RMS_EPS);
#pragma unroll
        for (int i = 0; i < 2; ++i) { const f32x2 g2 = *(const f32x2*)(gkv + 2 * lane + 128 * i); *(unsigned*)(Cb + (size_t)row * 256 + 2 * lane + 128 * i) = pk_bf16(cc[2 * i] * rc * g2.x, cc[2 * i + 1] * rc * g2.y); }
        if (lane < 32) { const float x1 = bf2f(lat[640 + lane]), x2 = bf2f(lat[672 + lane]); const f32x2 cs = *(const f32x2*)(CS + ((size_t)row * 32 + lane) * 2);
            *(unsigned*)(KR + (size_t)row * 64 + 2 * lane) = pk_bf16(x1 * cs.x - x2 * cs.y, x1 * cs.y + x2 * cs.x); }
    }
}

#define MFMA32(a, b, c) __builtin_amdgcn_mfma_f32_32x32x16_bf16((a), (b), (c), 0, 0, 0)
DI int crow(int reg, int h) { return (reg & 3) + 8 * (reg >> 2) + 4 * h; }

DI void attn_phase(const Params& P, LAS unsigned char* lds, int tid, int wid, int lane, int bid) {
    unsigned char* ws_ = P.ws; asm volatile("" : "+s"(ws_));
    asm volatile("" : "+v"(tid)); lane = tid & 63; wid = __builtin_amdgcn_readfirstlane(tid >> 6);
    unsigned char* ar = ws_ + O_AR;
    const bf16_t* Q = (const bf16_t*)(ar + 48 * MiB); const bf16_t* KN = (const bf16_t*)(ar + 96 * MiB); const bf16_t* VT = (const bf16_t*)(ar + 128 * MiB); const bf16_t* KR = (const bf16_t*)(ar + 44 * MiB);
    bf16_t* AO = (bf16_t*)(ws_ + O_XN);
    const int l32 = lane & 31, h2 = lane >> 5;
    constexpr int BUFB = 43008, VOFF = 25600;
    const unsigned kn_off0 = (unsigned)(((tid >> 4) * 1024 + 8 * (tid & 15)) * 2);
    const unsigned kr_off = (unsigned)(((tid >> 3) * 64 + 8 * (tid & 7)) * 2);
    const unsigned vt_off0 = (unsigned)(((tid >> 3) * 16384 + 8 * (tid & 7)) * 2);
    const unsigned kn_l0 = (unsigned)((tid >> 4) * 400 + 16 * (tid & 15));
    const unsigned kr_l = (unsigned)((tid >> 3) * 400 + 256 + 16 * (tid & 7));
    const unsigned vt_l0 = (unsigned)(25600 + (tid >> 3) * 136 + 16 * (tid & 7));
    for (int item = bid; item < 256; item += gridDim.x) {
        const int head = item & 7, pair = item >> 3;
        for (int half = 0; half < 2; ++half) {
            const int qb = half ? 63 - pair : pair;
            const int wrow0 = qb * 256 + wid * 32, qrow = wrow0 + l32;
            bf16x8 Qf[12];
#pragma unroll
            for (int s = 0; s < 12; ++s) Qf[s] = *(const bf16x8*)(Q + (size_t)qrow * 1536 + head * 192 + 16 * s + 8 * h2);
            f32x16 o[4];
#pragma unroll
            for (int d = 0; d < 4; ++d)
#pragma unroll
                for (int r = 0; r < 16; ++r) o[d][r] = 0.f;
            float mrun = -INFINITY, lsum = 0.f;
            const int ntiles = 4 * (qb + 1);
            u32x4 kreg[3], vreg[2];
#define ATT_ISSUE(kt) do { \
    unsigned o0_ = kn_off0, o1_ = kr_off, o2_ = vt_off0; asm volatile("" : "+v"(o0_), "+v"(o1_), "+v"(o2_)); \
    const char* knb = (const char*)(KN + (size_t)(kt) * 65536 + head * 128); const char* krb = (const char*)(KR + (size_t)(kt) * 4096); \
    const char* vtb = (const char*)(VT + (size_t)head * 128 * 16384 + 64 * (kt)); \
    kreg[0] = *(const u32x4*)(knb + o0_); kreg[1] = *(const u32x4*)(knb + 65536 + o0_); kreg[2] = *(const u32x4*)(krb + o1_); \
    vreg[0] = *(const u32x4*)(vtb + o2_); vreg[1] = *(const u32x4*)(vtb + 2097152 + o2_); } while (0)
#define ATT_WRITE(b) do { LAS unsigned char* base = lds + (b) * BUFB; \
    *(LAS u32x4*)(base + kn_l0) = kreg[0]; *(LAS u32x4*)(base + kn_l0 + 12800) = kreg[1]; *(LAS u32x4*)(base + kr_l) = kreg[2]; \
    *(LAS u32x2*)(base + vt_l0) = (u32x2){vreg[0].x, vreg[0].y}; *(LAS u32x2*)(base + vt_l0 + 8) = (u32x2){vreg[0].z, vreg[0].w}; \
    *(LAS u32x2*)(base + vt_l0 + 8704) = (u32x2){vreg[1].x, vreg[1].y}; *(LAS u32x2*)(base + vt_l0 + 8712) = (u32x2){vreg[1].z, vreg[1].w}; } while (0)
            ATT_ISSUE(0); ATT_WRITE(0); __syncthreads();
            for (int kt = 0; kt < ntiles; ++kt) {
                const bool more = (kt + 1 < ntiles);
                if (more) ATT_ISSUE(kt + 1);
                if (64 * kt <= wrow0 + 31) {
                    LAS unsigned char* base = lds + (kt & 1) * BUFB;
                    f32x16 st0, st1;
#pragma unroll
                    for (int r = 0; r < 16; ++r) { st0[r] = 0.f; st1[r] = 0.f; }
                    {
                        const LAS unsigned char* kp = base + l32 * 400 + 16 * h2;
                        bf16x8 ka[2][4];
#define ATT_LDK(bf, gq) do { _Pragma("unroll") for (int sl = 0; sl < 2; ++sl) { ka[bf][2 * sl] = *(const LAS bf16x8*)(kp + 32 * (2 * (gq) + sl)); ka[bf][2 * sl + 1] = *(const LAS bf16x8*)(kp + 12800 + 32 * (2 * (gq) + sl)); } } while (0)
#define ATT_MMK(bf, gq) do { _Pragma("unroll") for (int sl = 0; sl < 2; ++sl) { st0 = MFMA32(ka[bf][2 * sl], Qf[2 * (gq) + sl], st0); st1 = MFMA32(ka[bf][2 * sl + 1], Qf[2 * (gq) + sl], st1); } } while (0)
                        ATT_LDK(0, 0); __builtin_amdgcn_sched_barrier(0);
                        ATT_LDK(1, 1); __builtin_amdgcn_sched_barrier(0);
                        ATT_MMK(0, 0); __builtin_amdgcn_sched_barrier(0);
                        ATT_LDK(0, 2); __builtin_amdgcn_sched_barrier(0);
                        ATT_MMK(1, 1); __builtin_amdgcn_sched_barrier(0);
                        ATT_LDK(1, 3); __builtin_amdgcn_sched_barrier(0);
                        ATT_MMK(0, 2); __builtin_amdgcn_sched_barrier(0);
                        ATT_LDK(0, 4); __builtin_amdgcn_sched_barrier(0);
                        ATT_MMK(1, 3); __builtin_amdgcn_sched_barrier(0);
                        ATT_LDK(1, 5); __builtin_amdgcn_sched_barrier(0);
                        ATT_MMK(0, 4); __builtin_amdgcn_sched_barrier(0);
                        ATT_MMK(1, 5); __builtin_amdgcn_sched_barrier(0);
#undef ATT_LDK
#undef ATT_MMK
                    }
                    if (64 * kt + 63 > wrow0) {
#pragma unroll
                        for (int r = 0; r < 16; ++r) { const int key0 = 64 * kt + crow(r, h2); if (key0 > qrow) st0[r] = -INFINITY; if (key0 + 32 > qrow) st1[r] = -INFINITY; }
                    }
                    float mx = st0[0];
#pragma unroll
                    for (int r = 1; r < 16; ++r) mx = fmaxf(mx, st0[r]);
#pragma unroll
                    for (int r = 0; r < 16; ++r) mx = fmaxf(mx, st1[r]);
                    mx = fmaxf(mx, shx(mx, 32, lane));
                    const float mn = fmaxf(mrun, mx);
                    const float alpha = __builtin_amdgcn_exp2f(mrun - mn);
                    mrun = mn;
                    float psum = 0.f;
#pragma unroll
                    for (int r = 0; r < 16; ++r) { st0[r] = __builtin_amdgcn_exp2f(st0[r] - mn); st1[r] = __builtin_amdgcn_exp2f(st1[r] - mn); psum += st0[r] + st1[r]; }
                    lsum = lsum * alpha + psum;
                    if (__builtin_amdgcn_ballot_w64(alpha != 1.f) != 0ull) {
#pragma unroll
                        for (int d = 0; d < 4; ++d)
#pragma unroll
                            for (int r = 0; r < 16; ++r) o[d][r] *= alpha;
                    }
                    {
                        const LAS unsigned char* vb = base + VOFF + l32 * 136 + 8 * h2;
                        u32x4 va[2][4];
#define ATT_LDV(bf, stp) do { _Pragma("unroll") for (int d = 0; d < 4; ++d) { const LAS unsigned char* vp = vb + d * 4352 + 32 * (stp); \
        const u32x2 lo = *(const LAS u32x2*)vp, hi = *(const LAS u32x2*)(vp + 16); va[bf][d] = (u32x4){lo.x, lo.y, hi.x, hi.y}; } } while (0)
#define ATT_MMV(bf, stv, sp) do { u32x4 pw; pw.x = pk_bf16(stv[8 * (sp)], stv[8 * (sp) + 1]); pw.y = pk_bf16(stv[8 * (sp) + 2], stv[8 * (sp) + 3]); pw.z = pk_bf16(stv[8 * (sp) + 4], stv[8 * (sp) + 5]); pw.w = pk_bf16(stv[8 * (sp) + 6], stv[8 * (sp) + 7]); \
        const bf16x8 pf = __builtin_bit_cast(bf16x8, pw); _Pragma("unroll") for (int d = 0; d < 4; ++d) o[d] = MFMA32(__builtin_bit_cast(bf16x8, va[bf][d]), pf, o[d]); } while (0)
                        ATT_LDV(0, 0); __builtin_amdgcn_sched_barrier(0);
                        ATT_LDV(1, 1); __builtin_amdgcn_sched_barrier(0);
                        ATT_MMV(0, st0, 0); __builtin_amdgcn_sched_barrier(0);
                        ATT_LDV(0, 2); __builtin_amdgcn_sched_barrier(0);
                        ATT_MMV(1, st0, 1); __builtin_amdgcn_sched_barrier(0);
                        ATT_LDV(1, 3); __builtin_amdgcn_sched_barrier(0);
                        ATT_MMV(0, st1, 0); __builtin_amdgcn_sched_barrier(0);
                        ATT_MMV(1, st1, 1); __builtin_amdgcn_sched_barrier(0);
#undef ATT_LDV
#undef ATT_MMV
                    }
                }
                if (more) ATT_WRITE((kt + 1) & 1);
                __syncthreads();
            }
            int t2_ = tid; asm volatile("" : "+v"(t2_));
            const int qrow2 = qb * 256 + (t2_ >> 6) * 32 + (t2_ & 31), h2b = (t2_ >> 5) & 1;
            const float ltot = lsum + shx(lsum, 32, lane);
            const float inv = 1.f / ltot;
#pragma unroll
            for (int d = 0; d < 4; ++d)
#pragma unroll
                for (int rg = 0; rg < 4; ++rg) { f32x4 v = {o[d][4 * rg] * inv, o[d][4 * rg + 1] * inv, o[d][4 * rg + 2] * inv, o[d][4 * rg + 3] * inv};
                    store_bf4(AO + (size_t)qrow2 * 1024 + head * 128 + d * 32 + 8 * rg + 4 * h2b, v); }
        }
    }
#undef ATT_ISSUE
#undef ATT_WRITE
}

DI void s5_precompute(const Params& P, LAS unsigned char* lds, int tid, int bid) {
    unsigned char* ws_ = P.ws; asm volatile("" : "+s"(ws_));
    asm volatile("" : "+v"(tid));
    LAS float* PWr = (LAS float*)lds;
    LAS float* PWi = PWr + 33 * 64;
    LAS float* BBr = PWi + 33 * 64;
    LAS float* BBi = BBr + 1024;
    LAS float* CRe = BBi + 1024;
    LAS float* CIm = CRe + 1024;
    LAS float* KT = CIm + 1024;
    const float* lam_re = P.in[22]; const float* lam_im = P.in[23]; const float* log_dt = P.in[24];
    const float* b_re = P.in[25]; const float* b_im = P.in[26]; const float* c_re = P.in[27]; const float* c_im = P.in[28]; const float* dsk = P.in[29];
    bf16_t* TF = (bf16_t*)(ws_ + O_AR + 40 * MiB); bf16_t* Eb = (bf16_t*)(ws_ + O_AR + 80 * MiB);
    for (int item = bid; item < 256; item += gridDim.x) {
        const int g = item >> 2, q = item & 3;
        __syncthreads();
        const float dt = expf(log_dt[g]);
        for (int e = tid; e < 33 * 64; e += 512) { const int j = e >> 6, p = e & 63; const float lr = lam_re[g * 64 + p], li = lam_im[g * 64 + p];
            const float mag = expf((float)j * (lr * dt)); float sn, cs; sincosf((float)j * (li * dt), &sn, &cs); PWr[e] = mag * cs; PWi[e] = mag * sn; }
        for (int e = tid; e < 1024; e += 512) { const int p = e >> 4; const float lr = lam_re[g * 64 + p], li = lam_im[g * 64 + p];
            const float mag = expf(lr * dt); float sn, cs; sincosf(li * dt, &sn, &cs); const float ar = mag * cs, ai = mag * sn;
            const float den = lr * lr + li * li; const float fre = ((ar - 1.f) * lr + ai * li) / den, fim = (ai * lr - (ar - 1.f) * li) / den;
            const float br = b_re[(size_t)g * 1024 + e], bi = b_im[(size_t)g * 1024 + e];
            BBr[e] = fre * br - fim * bi; BBi[e] = fre * bi + fim * br; }
        for (int e = tid; e < 1024; e += 512) { CRe[e] = c_re[(size_t)g * 1024 + e]; CIm[e] = c_im[(size_t)g * 1024 + e]; }
        __syncthreads();
        {
            const int pr_ = tid & 255, co = pr_ >> 4, ci = pr_ & 15, j0 = (tid >> 8) * 16;
            float a[16];
#pragma unroll
            for (int jj = 0; jj < 16; ++jj) a[jj] = 0.f;
            for (int p = 0; p < 64; ++p) {
                const float cr = CRe[co * 64 + p], cm = CIm[co * 64 + p], br = BBr[p * 16 + ci], bi = BBi[p * 16 + ci];
                const float xr = cr * br - cm * bi, xi = cr * bi + cm * br;
#pragma unroll
                for (int jj = 0; jj < 16; ++jj) a[jj] += xr * PWr[(j0 + jj) * 64 + p] - xi * PWi[(j0 + jj) * 64 + p];
            }
            if (j0 == 0 && co == ci) a[0] += dsk[g * 16 + co];
#pragma unroll
            for (int jj = 0; jj < 16; ++jj) KT[((j0 + jj) * 16 + co) * 16 + ci] = a[jj];
        }
        __syncthreads();
        for (int e = tid; e < 128 * 80; e += 512) { const int rr = e / 80, kc = e - rr * 80, n = 128 * q + rr, l = n >> 4, co = n & 15; float v[8];
            if (kc < 64) { const int lp = kc >> 1;
#pragma unroll
                for (int i = 0; i < 8; ++i) v[i] = (lp <= l) ? KT[((l - lp) * 16 + co) * 16 + 8 * (kc & 1) + i] : 0.f;
            } else {
                const bool im = kc >= 72; const int p0 = 8 * (kc - (im ? 72 : 64));
#pragma unroll
                for (int i = 0; i < 8; ++i) { const int p = p0 + i; const float cr = CRe[co * 64 + p], cm = CIm[co * 64 + p], pr = PWr[(l + 1) * 64 + p], pi = PWi[(l + 1) * 64 + p];
                    v[i] = im ? -(cr * pi + cm * pr) : (cr * pr - cm * pi); }
            }
            u32x4 o; o.x = pk_bf16(v[0], v[1]); o.y = pk_bf16(v[2], v[3]); o.z = pk_bf16(v[4], v[5]); o.w = pk_bf16(v[6], v[7]);
            *(u32x4*)(TF + ((size_t)(g * 512 + n)) * 640 + 8 * kc) = o; }
        for (int e = tid; e < 32 * 64; e += 512) { const int n = 32 * q + (e >> 6), kc = e & 63, p = n & 63, im = n >> 6, lp = kc >> 1; float v[8];
            const float pr = PWr[(31 - lp) * 64 + p], pi = PWi[(31 - lp) * 64 + p];
#pragma unroll
            for (int i = 0; i < 8; ++i) { const int ci = 8 * (kc & 1) + i; const float br = BBr[p * 16 + ci], bi = BBi[p * 16 + ci]; v[i] = im ? (pr * bi + pi * br) : (pr * br - pi * bi); }
            u32x4 o; o.x = pk_bf16(v[0], v[1]); o.y = pk_bf16(v[2], v[3]); o.z = pk_bf16(v[4], v[5]); o.w = pk_bf16(v[6], v[7]);
            *(u32x4*)(Eb + ((size_t)(g * 256 + n)) * 512 + 8 * kc) = o; }
    }
}

DI void s5_scan(const Params& P, int wid, int lane, int bid) {
    unsigned char* ws_ = P.ws; asm volatile("" : "+s"(ws_));
    asm volatile("" : "+v"(lane));
    if (wid != 0) return;
    const float* lam_re = P.in[22]; const float* lam_im = P.in[23]; const float* log_dt = P.in[24];
    const float* XE = (const float*)(ws_ + O_AR + 96 * MiB); bf16_t* UG = (bf16_t*)(ws_ + O_AR);
    for (int g = bid; g < 64; g += gridDim.x) {
        const int p = lane; const float dt = expf(log_dt[g]); const float lr = lam_re[g * 64 + p], li = lam_im[g * 64 + p];
        const float mag = expf(32.f * (lr * dt)); float sn, cs; sincosf(32.f * (li * dt), &sn, &cs); const float ar = mag * cs, ai = mag * sn;
        float cr = 0.f, ci = 0.f;
        const float* xe = XE + (size_t)g * 512 * 128; bf16_t* ug = UG + (size_t)g * 512 * 640;
        for (int c0 = 0; c0 < 512; c0 += 16) {
            float xr[16], xi[16];
#pragma unroll
            for (int i = 0; i < 16; ++i) { xr[i] = xe[(size_t)(c0 + i) * 128 + p]; xi[i] = xe[(size_t)(c0 + i) * 128 + 64 + p]; }
#pragma unroll
            for (int i = 0; i < 16; ++i) { ug[(size_t)(c0 + i) * 640 + 512 + p] = f2bf(cr); ug[(size_t)(c0 + i) * 640 + 576 + p] = f2bf(ci);
                const float nr = ar * cr - ai * ci + xr[i], ni = ar * ci + ai * cr + xi[i]; cr = nr; ci = ni; }
        }
    }
}

DI void cs_table(const Params& P, int gtid, int nthreads) {
    unsigned char* ws_ = P.ws; asm volatile("" : "+s"(ws_));
    asm volatile("" : "+v"(gtid));
    const int* pos = (const int*)P.in[1]; float* CS = (float*)(ws_ + O_CS);
    for (int e = gtid; e < S * 32; e += nthreads) { const int row = e >> 5, j = e & 31;
        const float invf = exp2f(-(float)j * (13.287712379549449f / 32.f)); const float ang = (float)pos[row] * invf; float sn, cs; sincosf(ang, &sn, &cs);
        *(f32x2*)(CS + (size_t)e * 2) = (f32x2){cs, sn}; }
}


#define XB_TMO      128
#define XB_XCNT(j)  (256  + 64 * (j))
#define XB_XSUB(j)  (1280 + 64 * (j))
#define XB_XGEN(j)  (2304 + 64 * (j))
#define XB_TOP      3328
#define XB_TOPGEN   3392
#define XCD_BAR_WORDS 3456
#define XB_SPIN_CAP (1u << 18)
DI unsigned xb_ld(unsigned* p)              { return __hip_atomic_load(p, __ATOMIC_RELAXED, __HIP_MEMORY_SCOPE_AGENT); }
DI unsigned xb_add(unsigned* p, unsigned v) { return __hip_atomic_fetch_add(p, v, __ATOMIC_RELAXED, __HIP_MEMORY_SCOPE_AGENT); }
DI unsigned xb_xcc_id() { return (unsigned)__builtin_amdgcn_s_getreg((3 << 11) | 20) & 0xFu; }
#define XB_SPIN(cond, bar) do { unsigned _sp = 0; while (cond) { __builtin_amdgcn_s_sleep(1); \
    if ((++_sp & 255u) == 0u) { if (xb_ld(&(bar)[XB_TMO])) break; if (_sp > XB_SPIN_CAP) { atomicAdd(&(bar)[XB_TMO], 1u); break; } } } } while (0)
struct XcdBarrier { unsigned* bar; unsigned x; volatile LAS unsigned* st; };
DI XcdBarrier xcd_barrier_post(unsigned* bar, volatile LAS unsigned* st) {
    XcdBarrier b; b.bar = bar; b.x = xb_xcc_id(); b.st = st;
    if (threadIdx.x == 0) (void)xb_add(&bar[XB_XCNT(b.x)], 1u);
    return b;
}
DI void xcd_barrier_complete(unsigned* bar, unsigned x, unsigned& nloc, unsigned& nx) {
    const unsigned G = gridDim.x * gridDim.y * gridDim.z;
    unsigned sum, cnt, mine, sp = 0u;
    for (;;) {
        sum = 0u; cnt = 0u; mine = 0u;
#pragma unroll
        for (unsigned j = 0; j < 16; ++j) { const unsigned c = xb_ld(&bar[XB_XCNT(j)]); sum += c; cnt += (c > 0u) ? 1u : 0u; mine = (j == x) ? c : mine; }
        if (sum == G) break;
        __builtin_amdgcn_s_sleep(1);
        if ((++sp & 255u) == 0u) { if (xb_ld(&bar[XB_TMO])) break; if (sp > XB_SPIN_CAP) { atomicAdd(&bar[XB_TMO], 1u); break; } }
    }
    nloc = mine > 0u ? mine : 1u; nx = cnt > 0u ? cnt : 1u;
}
DI void xcd_barrier(const XcdBarrier& b) {
    asm volatile("s_waitcnt vmcnt(0)" ::: "memory");
    __syncthreads();
    if (threadIdx.x == 0) {
        unsigned* bar = b.bar;
        __builtin_amdgcn_s_waitcnt(0);
        unsigned nloc = b.st[0], nx = b.st[1];
        if (nloc == 0u) { xcd_barrier_complete(bar, b.x, nloc, nx); b.st[0] = nloc; b.st[1] = nx; }
        const unsigned old = xb_add(&bar[XB_XSUB(b.x)], 1u);
        const unsigned gen = old / nloc;
        if (old + 1u == (gen + 1u) * nloc) {
            __builtin_amdgcn_fence(__ATOMIC_RELEASE, "agent");
            asm volatile("s_waitcnt vmcnt(0)" ::: "memory");
            const unsigned og = xb_add(&bar[XB_TOP], 1u);
            const unsigned tg = og / nx;
            if (og + 1u == (tg + 1u) * nx) xb_add(&bar[XB_TOPGEN], 1u);
            else XB_SPIN(xb_ld(&bar[XB_TOPGEN]) == tg, bar);
            __builtin_amdgcn_fence(__ATOMIC_ACQUIRE, "agent");
            xb_add(&bar[XB_XGEN(b.x)], 1u);
            asm volatile("s_waitcnt vmcnt(0)" ::: "memory");
        } else {
            XB_SPIN(xb_ld(&bar[XB_XGEN(b.x)]) == gen, bar);
            __builtin_amdgcn_fence(__ATOMIC_ACQUIRE, "agent");
            asm volatile("s_waitcnt vmcnt(0)" ::: "memory");
        }
    }
    __syncthreads();
}

__global__ void __launch_bounds__(512, 2) __attribute__((amdgpu_waves_per_eu(2, 2))) mega_fwd(Params P) {
    extern __shared__ __attribute__((aligned(16))) unsigned char smem[];
    LAS unsigned char* lds = (LAS unsigned char*)smem;
    cg::grid_group grid = cg::this_grid();
    __shared__ uint4 xb_words;
    if (threadIdx.x == 0) xb_words = make_uint4(0u, 0u, 0u, 0u);
    __syncthreads();
    const XcdBarrier xb = xcd_barrier_post((unsigned*)(P.ws + O_BAR), (volatile LAS unsigned*)&xb_words);
    const int G = gridDim.x, nthreads = G * 512, NGW = G * 8;
#pragma nounroll
    for (int st = 0; st < NSTEPS; ++st) {
        int nrep = PROBE_REP(st); asm volatile("" : "+s"(nrep));
_Pragma("nounroll") for (int rep = 0; rep < nrep; ++rep) {
        if (rep) __syncthreads();
        int tid = threadIdx.x; asm volatile("" : "+v"(tid));
        int bid = blockIdx.x; asm volatile("" : "+s"(bid));
        unsigned char* ws = P.ws; asm volatile("" : "+s"(ws));
        float* outp_ = P.out; asm volatile("" : "+s"(outp_));
        const float* ng = P.in[2];
        bf16_t* XN = (bf16_t*)(ws + O_XN); const bf16_t* Zb = (const bf16_t*)(ws + O_Z);
        GemmDesc g;
        if (get_gemm(P, st, g)) gemm_phase(lds, P, g, G, bid, tid);
        else switch (st) {
        case 0: conv_layer(P, 0, GW_, NGW, LANE_); cs_table(P, GTID_, nthreads);
                row_pass<RP_BF>(P.in[0], outp_, nullptr, nullptr, ng, XN, GW_, NGW, LANE_); break;
        case 3: gate_phase(P, lds, tid, WID_, LANE_, bid); break;
        case 5: case 11: case 14: case 22: case 30: {
            const int L = (st == 5) ? 0 : (st <= 14 ? 1 : (st == 22 ? 2 : 3)); const bool mlp = (st == 14);
            const float* hin = (st == 5) ? P.in[0] : outp_;
            const float* gpost = ng + (L * 4 + (mlp ? 3 : 1)) * 1024; const float* gpre = mlp ? ng + ((L + 1) * 4) * 1024 : ng + (L * 4 + 2) * 1024;
            row_pass<RP_BF>(hin, outp_, Zb, gpost, gpre, XN, GW_, NGW, LANE_);
            if (mlp) conv_layer(P, L + 1, GW_, NGW, LANE_);
        } break;
        case 8: row_pass<RP_F32>(outp_, outp_, Zb, ng + 3 * 1024, ng + 4 * 1024, ws + O_AR, GW_, NGW, LANE_); conv_layer(P, 1, GW_, NGW, LANE_); break;
        case 9: pool_phase(P, GTID_, nthreads); break;
        case 16: mla_rows(P, GW_, NGW, LANE_); break;
        case 20: attn_phase(P, lds, tid, WID_, LANE_, bid); break;
        case 25: row_pass<RP_S5>(outp_, outp_, Zb, ng + 11 * 1024, ng + 12 * 1024, ws + O_AR, GW_, NGW, LANE_); conv_layer(P, 3, GW_, NGW, LANE_); s5_precompute(P, lds, tid, bid); break;
        case 27: s5_scan(P, WID_, LANE_, bid); break;
        case 33: row_pass<RP_FINAL>(outp_, outp_, Zb, ng + 15 * 1024, nullptr, nullptr, GW_, NGW, LANE_); break;
        default: break;
        }
        }
        if (G == 0) grid.sync();
        if (st != 2 && st != 17 && st != 18 && st != NSTEPS - 1) { xcd_barrier(xb); if (PROBE_SYNC) xcd_barrier(xb); }
    }
}
}

extern "C" void kernel_launch(void* const* d_in, const int* in_sizes, int n_in, void* d_out, int out_size, void* d_ws, size_t ws_size, hipStream_t stream) {
    static int grid = 0;
    if (grid == 0) {
        int dev = 0, cus = 0, per_cu = 0;
        hipGetDevice(&dev);
        hipDeviceGetAttribute(&cus, hipDeviceAttributeMultiprocessorCount, dev);
        hipFuncSetAttribute((const void*)mega_fwd, hipFuncAttributeMaxDynamicSharedMemorySize, LDS_BYTES);
        if (hipOccupancyMaxActiveBlocksPerMultiprocessor(&per_cu, (const void*)mega_fwd, 512, LDS_BYTES) != hipSuccess || per_cu < 1) per_cu = 1;
        (void)hipGetLastError();
        grid = cus * per_cu;
        if (grid <= 0) grid = 256;
    }
    Params p{};
    for (int i = 0; i < 32 && i < n_in; ++i) p.in[i] = (const float*)d_in[i];
    p.out = (float*)d_out; p.ws = (unsigned char*)d_ws;
    hipMemsetAsync((unsigned char*)d_ws + O_BAR, 0, XCD_BAR_WORDS * 4, stream);
    void* args[] = {&p};
    hipError_t e = hipLaunchCooperativeKernel((const void*)mega_fwd, dim3(grid), dim3(512), args, LDS_BYTES, stream);
    if (e != hipSuccess) fprintf(stderr, "cooperative launch failed: %s (grid %d)\n", hipGetErrorString(e), grid);
}
```

```cpp
#include <hip/hip_runtime.h>
#include <hip/hip_cooperative_groups.h>
#include <cstdio>
namespace cg = cooperative_groups;

#define DI __device__ __forceinline__
#define LAS __attribute__((address_space(3)))
#define GAS __attribute__((address_space(1)))
typedef unsigned short bf16_t;
typedef short bf16x8 __attribute__((ext_vector_type(8)));
typedef float f32x2 __attribute__((ext_vector_type(2)));
typedef float f32x4 __attribute__((ext_vector_type(4)));
typedef float f32x16 __attribute__((ext_vector_type(16)));
typedef unsigned u32x2 __attribute__((ext_vector_type(2)));
typedef unsigned u32x4 __attribute__((ext_vector_type(4)));
typedef __bf16 bf16v2 __attribute__((ext_vector_type(2)));

#define LANE_ (tid & 63)
#define WID_ (__builtin_amdgcn_readfirstlane(tid >> 6))
#define GW_ (bid * 8 + WID_)
#define GTID_ (bid * 512 + tid)
#ifndef PROBE_REP
#define PROBE_REP(st) 1
#endif
#ifndef PROBE_SYNC
#define PROBE_SYNC 0
#endif
#define IS_GEMM_STEP(st) ((st)==1||(st)==4||(st)==6||(st)==7||(st)==10||(st)==12||(st)==13||(st)==15||(st)==17||(st)==18||(st)==19||(st)==21||(st)==23||(st)==24||(st)==26||(st)==28||(st)==29||(st)==31||(st)==32)
#define IS_MLP_STEP(st) ((st)==6||(st)==7||(st)==12||(st)==13||(st)==23||(st)==24||(st)==31||(st)==32)
namespace {
constexpr int S = 16384;
constexpr size_t MiB = (size_t)1 << 20;
constexpr size_t O_CS = 0, O_WUP = 4 * MiB, O_WDN = 12 * MiB, O_WMIX = 20 * MiB, O_XN = 28 * MiB, O_Z = 60 * MiB, O_AR = 92 * MiB;
constexpr int LDS_BYTES = 131072;
constexpr size_t O_BAR = 254 * MiB;
constexpr size_t O_STAT = 254 * MiB + 65536;
constexpr int NSTEPS = 34;
constexpr float RMS_EPS = 1e-6f;
constexpr float QSCALE = 0.07216878364870322f * 1.4426950408889634f;

enum { E_Z = 0, E_HID, E_UV, E_POOL, E_LAT, E_Q, E_KN, E_VT, E_XE, E_S5Y, E_GLU };

struct Params { const float* in[32]; float* out; unsigned char* ws; };

DI unsigned pk_bf16(float a, float b) { f32x2 f = {a, b}; bf16v2 h = __builtin_convertvector(f, bf16v2); return __builtin_bit_cast(unsigned, h); }
DI bf16_t f2bf(float x) { return (bf16_t)(pk_bf16(x, 0.f) & 0xffffu); }
DI float bf2f(bf16_t b) { return __uint_as_float(((unsigned)b) << 16); }
DI float bflo(unsigned u) { return __uint_as_float(u << 16); }
DI float bfhi(unsigned u) { return __uint_as_float(u & 0xffff0000u); }
DI float shx(float v, int o, int lane) { return __int_as_float(__builtin_amdgcn_ds_bpermute((lane ^ o) << 2, __float_as_int(v))); }
DI float wave_sum(float v, int lane) {
#pragma unroll
    for (int o = 1; o < 64; o <<= 1) v += shx(v, o, lane);
    return v;
}
DI void store_bf4(bf16_t* p, f32x4 v) { u32x2 w; w.x = pk_bf16(v[0], v[1]); w.y = pk_bf16(v[2], v[3]); *(GAS u32x2*)p = w; }
DI float gelu_tanh(float x) {
    const float u = 0.7978845608028654f * (x + 0.044715f * x * x * x);
    const float e = __expf(-2.f * u);
    return x * __builtin_amdgcn_rcpf(1.f + e);
}

constexpr int BM = 256, BK = 64, HALF = 128, HTB = HALF * BK * 2, NXCD = 8, WGM = 8;
DI int lds_byte(int r, int c) { const int st = (r >> 4) * 2 + (c >> 5), rr = r & 15, cc = c & 31, ob = rr * 64 + cc * 2; return st * 1024 + (ob ^ (((ob >> 9) & 1) << 5)); }
DI void stage_rc(int b, int& R, int& C) { const int st = b / 1024, sb = b % 1024, swz = sb ^ (((sb >> 9) & 1) << 5); R = (st >> 1) * 16 + swz / 64; C = (st & 1) * 32 + (swz % 64) / 2; }

struct GemmDesc { const bf16_t* A; const bf16_t* Bt; long a_gs, b_gs; int K, lda, ldb, nM, nN, ngrp, mode; };
struct Unit { int pm, pn, grp; };

DI bool unit_next(const GemmDesc& g, int i, int G, int c, Unit& u) {
    const int nper = g.nM * g.nN;
    const long L = (long)i * G + c;
    const bool ok = L < (long)nper * g.ngrp;
    const int grp2 = (int)(L / nper), w = (int)(L - (long)grp2 * nper);
    const int nwg = nper, nM = g.nM, nN = g.nN;
    int wgid = w;
    { const int q = nwg / NXCD, r = nwg % NXCD, xcd = wgid % NXCD, off = wgid / NXCD; wgid = (xcd < r ? xcd * (q + 1) : r * (q + 1) + (xcd - r) * q) + off; }
    const int nig = WGM * nN, gid = wgid / nig, fm = gid * WGM, gsz = (nM - fm) < WGM ? (nM - fm) : WGM;
    const int gszc = gsz > 0 ? gsz : 1;
    const int pm1 = fm + ((wgid % nig) % gszc), pn1 = (wgid % nig) / gszc;
    const int pm2 = w % nM, pn2 = w / nM;
    const bool single = (g.ngrp == 1);
    Unit r; r.pm = single ? pm1 : pm2; r.pn = single ? pn1 : pn2; r.grp = single ? 0 : grp2;
    u = r;
    return ok;
}

DI int perm32(int rho) { const int n = rho >> 4, i = rho & 15; return 8 * (i >> 2) + 4 * n + (i & 3); }
DI void store_bf8(bf16_t* p, f32x4 a, f32x4 b) { u32x4 w; w.x = pk_bf16(a[0], a[1]); w.y = pk_bf16(a[2], a[3]); w.z = pk_bf16(b[0], b[1]); w.w = pk_bf16(b[2], b[3]); *(GAS u32x4*)p = w; }
#define EPI_LOOP(...) \
    _Pragma("unroll") for (int ai = 0; ai < 2; ++ai) _Pragma("unroll") for (int m = 0; m < 4; ++m) { const int row = row0 + ai * HALF + m * 16; \
        _Pragma("unroll") for (int bj = 0; bj < 2; ++bj) { const int col = col0 + bj * HALF; f32x4 v0 = acc[ai][bj][m][0], v1 = acc[ai][bj][m][1]; __VA_ARGS__ } }

DI void epilogue(const Params& P, const GemmDesc& g, const f32x4 (&acc)[2][2][4][2], const Unit& u, int wr, int wc, int fr, int fq) {
    unsigned char* ws_ = P.ws; asm volatile("" : "+s"(ws_));
    unsigned char* ws = ws_;
    const int row0 = u.pm * BM + wr * 64 + fr, col0 = u.pn * BM + wc * 32 + 8 * fq;
    bf16_t* Zb = (bf16_t*)(ws + O_Z);
    bf16_t* AR = (bf16_t*)(ws + O_AR);
    switch (g.mode) {
    case E_Z: { EPI_LOOP( store_bf8(Zb + (size_t)row * 1024 + col, v0, v1); ) } break;
    case E_HID: { EPI_LOOP( _Pragma("unroll") for (int j = 0; j < 4; ++j) { const float t0 = fmaxf(v0[j], 0.f), t1 = fmaxf(v1[j], 0.f); v0[j] = t0 * t0; v1[j] = t1 * t1; } store_bf8(AR + (size_t)row * 4096 + col, v0, v1); ) } break;
    case E_UV: { const float* bin = P.in[6]; float* STAT = (float*)(ws + O_AR + 96 * MiB); const int lane_ = fr + 16 * fq;
#pragma unroll
        for (int ai = 0; ai < 2; ++ai)
#pragma unroll
            for (int m = 0; m < 4; ++m) { const int row = row0 + ai * HALF + m * 16; float s1 = 0.f, s2 = 0.f;
#pragma unroll
                for (int bj = 0; bj < 2; ++bj) { const int col = col0 + bj * HALF; f32x4 v0 = acc[ai][bj][m][0], v1 = acc[ai][bj][m][1];
                    const f32x4 b0 = *(const GAS f32x4*)(bin + col); const f32x4 b1 = *(const GAS f32x4*)(bin + col + 4);
#pragma unroll
                    for (int j = 0; j < 4; ++j) { v0[j] = gelu_tanh(v0[j] + b0[j]); v1[j] = gelu_tanh(v1[j] + b1[j]); s1 += v0[j] + v1[j]; s2 += v0[j] * v0[j] + v1[j] * v1[j]; }
                    bf16_t* dst = (col < 1024) ? (AR + (size_t)row * 1024 + col) : (AR + 16 * MiB + (size_t)row * 1024 + (col - 1024)); store_bf8(dst, v0, v1); }
                if (col0 >= 1024) {
                    s1 += shx(s1, 16, lane_); s2 += shx(s2, 16, lane_); s1 += shx(s1, 32, lane_); s2 += shx(s2, 32, lane_);
                    if (fq == 0) *(f32x2*)(STAT + ((size_t)row * 16 + (u.pn - 4) * 4 + wc) * 2) = (f32x2){s1, s2}; }
            }
    } break;
    case E_POOL: { const float* sc = P.in[13];
        EPI_LOOP( const int cgc = 256 * u.grp + col; const f32x4 s0 = *(const GAS f32x4*)(sc + cgc); const f32x4 s1 = *(const GAS f32x4*)(sc + cgc + 4); store_bf8(Zb + (size_t)row * 1024 + cgc, v0 * s0, v1 * s1); ) } break;
    case E_LAT: { EPI_LOOP( store_bf8(AR + (size_t)row * 768 + col, v0, v1); ) } break;
    case E_Q: { const float* CS = (const float*)(ws + O_CS); bf16_t* Qb = AR + 24 * MiB;
        EPI_LOOP( const int w = col % 192;
                  if (w >= 128) { const int j = (w - 128) >> 1; const f32x4 c0 = *(const GAS f32x4*)(CS + ((size_t)row * 32 + j) * 2); const f32x4 c1 = *(const GAS f32x4*)(CS + ((size_t)row * 32 + j) * 2 + 4);
                      const float a0 = v0[0] * c0[0] - v0[1] * c0[1]; const float a1 = v0[0] * c0[1] + v0[1] * c0[0]; const float a2 = v0[2] * c0[2] - v0[3] * c0[3]; const float a3 = v0[2] * c0[3] + v0[3] * c0[2];
                      const float e0 = v1[0] * c1[0] - v1[1] * c1[1]; const float e1 = v1[0] * c1[1] + v1[1] * c1[0]; const float e2 = v1[2] * c1[2] - v1[3] * c1[3]; const float e3 = v1[2] * c1[3] + v1[3] * c1[2];
                      v0[0] = a0; v0[1] = a1; v0[2] = a2; v0[3] = a3; v1[0] = e0; v1[1] = e1; v1[2] = e2; v1[3] = e3; }
                  store_bf8(Qb + (size_t)row * 1536 + col, v0 * QSCALE, v1 * QSCALE); ) } break;
    case E_KN: { bf16_t* KN = AR + 48 * MiB; EPI_LOOP( store_bf8(KN + (size_t)row * 1024 + col, v0, v1); ) } break;
    case E_VT: { bf16_t* VT = AR + 64 * MiB; EPI_LOOP( store_bf8(VT + (size_t)row * 16384 + col, v0, v1); ) } break;
    case E_XE: { float* XE = (float*)(ws + O_AR + 96 * MiB);
        EPI_LOOP( if (col < 128) { float* xp = XE + ((size_t)(u.grp * 512 + row)) * 128 + col; *(f32x4*)xp = v0; *(f32x4*)(xp + 4) = v1; } ) } break;
    case E_S5Y: { bf16_t* Y5 = AR + 56 * MiB;
        EPI_LOOP( const int l = col >> 4, c = col & 15; const int token = row * 32 + l; _Pragma("unroll") for (int j = 0; j < 4; ++j) { v0[j] = gelu_tanh(v0[j]); v1[j] = gelu_tanh(v1[j]); }
                  store_bf8(Y5 + (size_t)token * 1024 + u.grp * 16 + c, v0, v1); ) } break;
    case E_GLU: {
#pragma unroll
        for (int ai = 0; ai < 2; ++ai)
#pragma unroll
            for (int m = 0; m < 4; ++m) { const int row = row0 + ai * HALF + m * 16; const int oc = u.pn * 128 + wc * 32 + 8 * fq;
                const f32x4 a0 = acc[ai][0][m][0], a1 = acc[ai][0][m][1], b0 = acc[ai][1][m][0], b1 = acc[ai][1][m][1]; f32x4 v0, v1;
#pragma unroll
                for (int j = 0; j < 4; ++j) { v0[j] = a0[j] * __builtin_amdgcn_rcpf(1.f + __expf(-b0[j])); v1[j] = a1[j] * __builtin_amdgcn_rcpf(1.f + __expf(-b1[j])); }
                store_bf8(Zb + (size_t)row * 1024 + oc, v0, v1); }
    } break;
    default: break;
    }
}

DI void gemm_phase(LAS unsigned char* lds, const Params& P, const GemmDesc g, const int G, const int cidx, int tid) {
    asm volatile("" : "+v"(tid));
    const int wid = __builtin_amdgcn_readfirstlane(tid >> 6), lane = tid & 63, wr = wid >> 2, wc = wid & 3, fr = lane & 15, fq = lane >> 4;
    const int K = g.K, nt = K / BK;
    unsigned voffA[2], voffB[2];
#pragma unroll
    for (int i = 0; i < 2; ++i) { int R, C; stage_rc(tid * 16 + i * 8192, R, C); const int Rb = (R & ~31) + perm32(R & 31); voffA[i] = (unsigned)(R * g.lda + C) * 2u; voffB[i] = (unsigned)(Rb * g.ldb + C) * 2u; }
    const size_t kstep = (size_t)(BK * 2);
    const size_t hstepA = (size_t)HALF * g.lda * 2, hstepB = (size_t)HALF * g.ldb * 2;
    const unsigned ldsw = (unsigned)wid * 1024u;
    const int aoff = lds_byte(wr * 64 + fr, fq * 8), boff = lds_byte(wc * 32 + fr, fq * 8);
#define PG8_SA(b, h) (((b) * 2 + (h)) * HTB)
#define PG8_SB(b, h) ((4 + (b) * 2 + (h)) * HTB)
#define PG8_STAGE(bufoff, gbase, voff) do { _Pragma("unroll") for (int _i = 0; _i < 2; ++_i) \
        __builtin_amdgcn_global_load_lds((const unsigned*)((const char*)(gbase) + (voff)[_i]), (LAS unsigned*)(lds + (bufoff) + ldsw + _i * 8192), 16, 0, 0); } while (0)
#define PG8_LDA(dst, b, h) do { _Pragma("unroll") for (int m = 0; m < 4; ++m) _Pragma("unroll") for (int k = 0; k < 2; ++k) dst[m][k] = *(const LAS bf16x8*)(lds + PG8_SA(b, h) + aoff + m * 2048 + k * 1024); } while (0)
#define PG8_LDB(dst, b, h) do { _Pragma("unroll") for (int n = 0; n < 2; ++n) _Pragma("unroll") for (int k = 0; k < 2; ++k) dst[n][k] = *(const LAS bf16x8*)(lds + PG8_SB(b, h) + boff + n * 2048 + k * 1024); } while (0)
#define PG8_MMA(ai, bj, At, Bt) do { __builtin_amdgcn_s_setprio(1); _Pragma("unroll") for (int m = 0; m < 4; ++m) _Pragma("unroll") for (int n = 0; n < 2; ++n) _Pragma("unroll") for (int k = 0; k < 2; ++k) \
        acc[ai][bj][m][n] = __builtin_amdgcn_mfma_f32_16x16x32_bf16(Bt[n][k], At[m][k], acc[ai][bj][m][n], 0, 0, 0); __builtin_amdgcn_s_setprio(0); } while (0)
#define PG8_WAIT_V(n) asm volatile("s_waitcnt vmcnt(" #n ")" ::: "memory")
#define PG8_WAIT_L(n) asm volatile("s_waitcnt lgkmcnt(" #n ")" ::: "memory")
#define PG8_BAR __builtin_amdgcn_s_barrier()
#define PG8_SCHED __builtin_amdgcn_sched_barrier(0)
    Unit cur, nxt; int ui = 0;
    if (!unit_next(g, 0, G, cidx, cur)) return;
    f32x4 acc[2][2][4][2];
#pragma unroll
    for (int a = 0; a < 2; ++a)
#pragma unroll
        for (int b = 0; b < 2; ++b)
#pragma unroll
            for (int m = 0; m < 4; ++m)
#pragma unroll
                for (int n = 0; n < 2; ++n) acc[a][b][m][n] = (f32x4){0.f, 0.f, 0.f, 0.f};
    bf16x8 At[4][2], B0[2][2], B1[2][2];
    const char* cA = (const char*)g.A + ((size_t)cur.grp * g.a_gs + (size_t)cur.pm * BM * g.lda) * 2;
    const char* cB = (const char*)g.Bt + ((size_t)cur.grp * g.b_gs + (size_t)cur.pn * BM * g.ldb) * 2;
    PG8_STAGE(PG8_SB(0, 0), cB, voffB); PG8_STAGE(PG8_SA(0, 0), cA, voffA); PG8_STAGE(PG8_SB(0, 1), cB + hstepB, voffB); PG8_STAGE(PG8_SA(0, 1), cA + hstepA, voffA);
    if (wr == 1) PG8_BAR;
    PG8_WAIT_V(4); PG8_BAR;
    PG8_STAGE(PG8_SB(1, 0), cB + kstep, voffB); PG8_STAGE(PG8_SA(1, 0), cA + kstep, voffA); PG8_STAGE(PG8_SB(1, 1), cB + hstepB + kstep, voffB);
    PG8_WAIT_V(6); PG8_BAR;
    for (;;) {
        const bool has_next = unit_next(g, ui + 1, G, cidx, nxt);
        const char* nA = has_next ? (const char*)g.A + ((size_t)nxt.grp * g.a_gs + (size_t)nxt.pm * BM * g.lda) * 2 : cA;
        const char* nB = has_next ? (const char*)g.Bt + ((size_t)nxt.grp * g.b_gs + (size_t)nxt.pn * BM * g.ldb) * 2 : cB;
        for (int t = 0; t < nt; t += 2) {
            const bool last = (t == nt - 2);
            const char* a1 = cA + (size_t)(t + 1) * kstep;
            const char* a2 = last ? nA : cA + (size_t)(t + 2) * kstep; const char* b2 = last ? nB : cB + (size_t)(t + 2) * kstep;
            const char* a3 = a2 + kstep; const char* b3 = b2 + kstep;
            PG8_LDB(B0, 0, 0); PG8_SCHED; PG8_LDA(At, 0, 0); PG8_STAGE(PG8_SA(1, 1), a1 + hstepA, voffA);
            PG8_WAIT_L(8); PG8_BAR; PG8_WAIT_L(0); PG8_MMA(0, 0, At, B0); PG8_BAR; PG8_SCHED;
            PG8_LDB(B1, 0, 1); PG8_STAGE(PG8_SB(0, 0), b2, voffB);
            PG8_BAR; PG8_WAIT_L(0); PG8_MMA(0, 1, At, B1); PG8_BAR;
            PG8_LDA(At, 0, 1); PG8_STAGE(PG8_SA(0, 0), a2, voffA);
            PG8_BAR; PG8_WAIT_L(0); PG8_MMA(1, 0, At, B0); PG8_BAR; PG8_SCHED;
            PG8_STAGE(PG8_SB(0, 1), b2 + hstepB, voffB);
            PG8_WAIT_V(6); PG8_BAR; PG8_MMA(1, 1, At, B1); PG8_BAR;
            PG8_LDB(B0, 1, 0); PG8_SCHED; PG8_LDA(At, 1, 0); PG8_STAGE(PG8_SA(0, 1), a2 + hstepA, voffA);
            PG8_WAIT_L(8); PG8_BAR; PG8_WAIT_L(0); PG8_MMA(0, 0, At, B0); PG8_BAR; PG8_SCHED;
            PG8_LDB(B1, 1, 1); PG8_STAGE(PG8_SB(1, 0), b3, voffB);
            PG8_BAR; PG8_WAIT_L(0); PG8_MMA(0, 1, At, B1); PG8_BAR;
            PG8_LDA(At, 1, 1); PG8_STAGE(PG8_SA(1, 0), a3, voffA);
            PG8_BAR; PG8_WAIT_L(0); PG8_MMA(1, 0, At, B0); PG8_BAR; PG8_SCHED;
            PG8_STAGE(PG8_SB(1, 1), b3 + hstepB, voffB);
            PG8_WAIT_V(6); PG8_BAR; PG8_MMA(1, 1, At, B1); PG8_BAR;
        }
        epilogue(P, g, acc, cur, wr, wc, fr, fq);
        if (!has_next) break;
#pragma unroll
        for (int a = 0; a < 2; ++a)
#pragma unroll
            for (int b = 0; b < 2; ++b)
#pragma unroll
                for (int m = 0; m < 4; ++m)
#pragma unroll
                    for (int n = 0; n < 2; ++n) acc[a][b][m][n] = (f32x4){0.f, 0.f, 0.f, 0.f};
        cur = nxt; cA = nA; cB = nB; ++ui;
    }
    PG8_WAIT_V(0);
    if (wr == 0) PG8_BAR;
    PG8_BAR;
}

DI bool get_gemm(const Params& P, int st, GemmDesc& g) {
    unsigned char* ws_ = P.ws; asm volatile("" : "+s"(ws_));
    unsigned char* ws = ws_;
    const bf16_t* XN = (const bf16_t*)(ws + O_XN);
    const bf16_t* WMIX = (const bf16_t*)(ws + O_WMIX);
    const bf16_t* AR = (const bf16_t*)(ws + O_AR);
    g.a_gs = 0; g.b_gs = 0; g.ngrp = 1; g.nM = 64; g.K = 1024; g.lda = 1024; g.ldb = 1024; g.A = XN; g.Bt = WMIX; g.nN = 4; g.mode = E_Z;
    switch (st) {
    case 1: g.nN = 8; g.mode = E_UV; return true;
    case 4: g.A = AR + 32 * MiB; g.Bt = WMIX + 2 * MiB; return true;
    case 6: case 12: case 23: case 31: g.Bt = (const bf16_t*)(ws + O_WUP); g.nN = 16; g.mode = E_HID; return true;
    case 7: case 13: case 24: case 32: g.A = AR; g.Bt = (const bf16_t*)(ws + O_WDN); g.K = 4096; g.lda = 4096; g.ldb = 4096; return true;
    case 10: g.A = AR + 32 * MiB; g.K = 256; g.ldb = 256; g.nN = 1; g.ngrp = 4; g.a_gs = 256; g.b_gs = 65536; g.mode = E_POOL; return true;
    case 15: g.nN = 3; g.mode = E_LAT; return true;
    case 17: g.A = AR + 12 * MiB; g.Bt = WMIX + 1 * MiB; g.K = 384; g.lda = 384; g.ldb = 384; g.nN = 6; g.mode = E_Q; return true;
    case 18: g.A = AR + 18 * MiB; g.Bt = WMIX + 2 * MiB; g.K = 256; g.lda = 256; g.ldb = 256; g.nN = 4; g.mode = E_KN; return true;
    case 19: g.A = WMIX + (5 * MiB) / 2; g.Bt = AR + 18 * MiB; g.K = 256; g.lda = 256; g.ldb = 256; g.nM = 4; g.nN = 64; g.mode = E_VT; return true;
    case 21: g.Bt = WMIX + 3 * MiB; return true;
    case 26: g.A = AR; g.Bt = AR + 40 * MiB; g.K = 512; g.lda = 640; g.ldb = 512; g.nM = 2; g.nN = 1; g.ngrp = 64; g.a_gs = 512 * 640; g.b_gs = 256 * 512; g.mode = E_XE; return true;
    case 28: g.A = AR; g.Bt = AR + 20 * MiB; g.K = 640; g.lda = 640; g.ldb = 640; g.nM = 2; g.nN = 2; g.ngrp = 64; g.a_gs = 512 * 640; g.b_gs = 512 * 640; g.mode = E_S5Y; return true;
    case 29: g.A = AR + 56 * MiB; g.nN = 8; g.mode = E_GLU; return true;
    default: return false;
    }
}

enum { RP_BF = 0, RP_F32 = 1, RP_S5 = 2, RP_FINAL = 3 };
template <int MODE>
DI void row_pass(const float* hin, float* hout, const bf16_t* z, const float* gpost, const float* gpre, void* outp, int gw, int NGW, int lane) {
    asm volatile("" : "+v"(lane));
    for (int rowa = gw; rowa < S; rowa += 2 * NGW) {
        f32x4 h[2][4];
#pragma unroll
        for (int q = 0; q < 2; ++q) { const int row = rowa + q * NGW;
#pragma unroll
            for (int j = 0; j < 4; ++j) { const int cb = (MODE == RP_S5) ? 16 * lane + 4 * j : 4 * lane + 256 * j; h[q][j] = *(const GAS f32x4*)(hin + (size_t)row * 1024 + cb); } }
        if (z) {
            f32x4 zz[2][4]; float ss[2] = {0.f, 0.f};
#pragma unroll
            for (int q = 0; q < 2; ++q) { const int row = rowa + q * NGW;
#pragma unroll
                for (int j = 0; j < 4; ++j) { const int cb = (MODE == RP_S5) ? 16 * lane + 4 * j : 4 * lane + 256 * j; const u32x2 w = *(const GAS u32x2*)(z + (size_t)row * 1024 + cb);
                    zz[q][j] = (f32x4){bflo(w.x), bfhi(w.x), bflo(w.y), bfhi(w.y)}; ss[q] += zz[q][j][0] * zz[q][j][0] + zz[q][j][1] * zz[q][j][1] + zz[q][j][2] * zz[q][j][2] + zz[q][j][3] * zz[q][j][3]; } }
#pragma unroll
            for (int q = 0; q < 2; ++q) { const int row = rowa + q * NGW;
                const float rz = rsqrtf(wave_sum(ss[q], lane) * (1.f / 1024.f) + RMS_EPS);
#pragma unroll
                for (int j = 0; j < 4; ++j) { const int cb = (MODE == RP_S5) ? 16 * lane + 4 * j : 4 * lane + 256 * j; const f32x4 gp = *(const GAS f32x4*)(gpost + cb); h[q][j] += zz[q][j] * rz * gp;
                    *(GAS f32x4*)(hout + (size_t)row * 1024 + cb) = h[q][j]; } }
        }
        if (MODE != RP_FINAL) {
#pragma unroll
            for (int q = 0; q < 2; ++q) { const int row = rowa + q * NGW;
                float s2 = 0.f;
#pragma unroll
                for (int j = 0; j < 4; ++j) s2 += h[q][j][0] * h[q][j][0] + h[q][j][1] * h[q][j][1] + h[q][j][2] * h[q][j][2] + h[q][j][3] * h[q][j][3];
                const float rn = rsqrtf(wave_sum(s2, lane) * (1.f / 1024.f) + RMS_EPS);
#pragma unroll
                for (int j = 0; j < 4; ++j) { const int cb = (MODE == RP_S5) ? 16 * lane + 4 * j : 4 * lane + 256 * j; const f32x4 gq = *(const GAS f32x4*)(gpre + cb); const f32x4 xn = h[q][j] * rn * gq;
                    if (MODE == RP_BF) store_bf4((bf16_t*)outp + (size_t)row * 1024 + cb, xn);
                    if (MODE == RP_F32) *(GAS f32x4*)((float*)outp + (size_t)row * 1024 + cb) = xn;
                    if (MODE == RP_S5) store_bf4((bf16_t*)outp + ((size_t)(lane * 512 + (row >> 5))) * 640 + (row & 31) * 16 + 4 * j, xn); } }
        }
    }
}

enum { MAP_ID = 0, MAP_UQ = 1, MAP_GLUA = 2, MAP_GLUB = 3 };
DI int dstrow(int mode, int n) {
    if (mode == MAP_UQ) { const int hd = n / 192, w = n - hd * 192; if (w < 128) return n; const int r = w - 128; return hd * 192 + 128 + 2 * (r & 31) + (r >> 5); }
    if (mode == MAP_GLUA) return (n >> 7) * 256 + (n & 127);
    if (mode == MAP_GLUB) return (n >> 7) * 256 + 128 + (n & 127);
    return n;
}
DI void convT(const float* src, int K, int N, bf16_t* dst, int ldT, int mapmode, int gw, int NGW, int lane) {
    asm volatile("" : "+v"(lane));
    const int nnb = N >> 4, nitems = nnb * (K >> 5);
    for (int it = gw; it < nitems; it += NGW) {
        const int kb = it / nnb, nb = it - kb * nnb;
        const int n = nb * 16 + (lane >> 2), k = kb * 32 + 8 * (lane & 3);
        const float* s = src + (size_t)k * N + n;
        float v[8];
#pragma unroll
        for (int i = 0; i < 8; ++i) v[i] = ((const GAS float*)s)[(size_t)i * N];
        u32x4 o; o.x = pk_bf16(v[0], v[1]); o.y = pk_bf16(v[2], v[3]); o.z = pk_bf16(v[4], v[5]); o.w = pk_bf16(v[6], v[7]);
        *(GAS u32x4*)(dst + (size_t)dstrow(mapmode, n) * ldT + k) = o;
    }
}
DI void conv_layer(const Params& P, int L, int gw, int NGW, int lane) {
    unsigned char* ws_ = P.ws; asm volatile("" : "+s"(ws_));
    unsigned char* ws = ws_;
    bf16_t* WMIX = (bf16_t*)(ws + O_WMIX);
    convT(P.in[3] + (size_t)L * 1024 * 4096, 1024, 4096, (bf16_t*)(ws + O_WUP), 1024, MAP_ID, gw, NGW, lane);
    convT(P.in[4] + (size_t)L * 1024 * 4096, 4096, 1024, (bf16_t*)(ws + O_WDN), 4096, MAP_ID, gw, NGW, lane);
    if (L == 0) {
        convT(P.in[5], 1024, 2048, WMIX, 1024, MAP_ID, gw, NGW, lane);
        convT(P.in[11], 1024, 1024, WMIX + 2 * MiB, 1024, MAP_ID, gw, NGW, lane);
        const float* wsrc = P.in[9]; bf16_t* wd = WMIX + 3 * MiB;
        for (int e = gw * 64 + lane; e < 8 * 128 * 128 / 4; e += NGW * 64) { const int s0 = (e * 4) & 127, t = ((e * 4) >> 7) & 127; f32x4 w = *(const f32x4*)(wsrc + (size_t)e * 4);
#pragma unroll
            for (int j = 0; j < 4; ++j) if (s0 + j > t) w[j] = 0.f;
            store_bf4(wd + (size_t)e * 4, w); }
    } else if (L == 1) {
        for (int gg = 0; gg < 4; ++gg) convT(P.in[12] + gg * 65536, 256, 256, WMIX + gg * 65536, 256, MAP_ID, gw, NGW, lane);
    } else if (L == 2) {
        convT(P.in[14], 1024, 384, WMIX, 1024, MAP_ID, gw, NGW, lane);
        convT(P.in[17], 1024, 320, WMIX + 384 * 1024, 1024, MAP_ID, gw, NGW, lane);
        convT(P.in[16], 384, 1536, WMIX + 1 * MiB, 384, MAP_UQ, gw, NGW, lane);
        convT(P.in[19], 256, 1024, WMIX + 2 * MiB, 256, MAP_ID, gw, NGW, lane);
        convT(P.in[20], 256, 1024, WMIX + (5 * MiB) / 2, 256, MAP_ID, gw, NGW, lane);
        convT(P.in[21], 1024, 1024, WMIX + 3 * MiB, 1024, MAP_ID, gw, NGW, lane);
    } else {
        convT(P.in[30], 1024, 1024, WMIX, 1024, MAP_GLUA, gw, NGW, lane);
        convT(P.in[31], 1024, 1024, WMIX, 1024, MAP_GLUB, gw, NGW, lane);
    }
}

DI void lnv_phase(const Params& P, int gw, int NGW, int lane) {
    unsigned char* ws_ = P.ws; asm volatile("" : "+s"(ws_));
    asm volatile("" : "+v"(lane));
    bf16_t* V = (bf16_t*)(ws_ + O_AR + 32 * MiB);
    const float* gv = P.in[7]; const float* bv = P.in[8];
    for (int row = gw; row < S; row += NGW) {
        f32x4 x[4]; float s = 0.f;
#pragma unroll
        for (int j = 0; j < 4; ++j) { const u32x2 w = *(const u32x2*)(V + (size_t)row * 1024 + 4 * lane + 256 * j); x[j] = (f32x4){bflo(w.x), bfhi(w.x), bflo(w.y), bfhi(w.y)}; s += x[j][0] + x[j][1] + x[j][2] + x[j][3]; }
        const float mu = wave_sum(s, lane) * (1.f / 1024.f); float s2 = 0.f;
#pragma unroll
        for (int j = 0; j < 4; ++j) { x[j] = x[j] - mu; s2 += x[j][0] * x[j][0] + x[j][1] * x[j][1] + x[j][2] * x[j][2] + x[j][3] * x[j][3]; }
        const float rs = rsqrtf(wave_sum(s2, lane) * (1.f / 1024.f) + RMS_EPS);
#pragma unroll
        for (int j = 0; j < 4; ++j) { const int cb = 4 * lane + 256 * j; const f32x4 g4 = *(const f32x4*)(gv + cb), b4 = *(const f32x4*)(bv + cb); store_bf4(V + (size_t)row * 1024 + cb, x[j] * rs * g4 + b4); }
    }
}

DI void gate_phase(const Params& P, LAS unsigned char* lds, int tid, int wid, int lane, int bid) {
    unsigned char* ws_ = P.ws; asm volatile("" : "+s"(ws_));
    asm volatile("" : "+v"(tid)); lane = tid & 63; wid = __builtin_amdgcn_readfirstlane(tid >> 6);
    LAS bf16_t* Wt = (LAS bf16_t*)lds;
    LAS bf16_t* Vt = Wt + 128 * 136;
    const bf16_t* Wsb = (const bf16_t*)(ws_ + O_WMIX + 6 * MiB);
    const bf16_t* U = (const bf16_t*)(ws_ + O_AR);
    const bf16_t* V = (const bf16_t*)(ws_ + O_AR + 32 * MiB);
    bf16_t* Y = (bf16_t*)(ws_ + O_AR + 64 * MiB);
    const float* bs = P.in[10]; const float* gv = P.in[7]; const float* bv = P.in[8]; const float* STAT = (const float*)(ws_ + O_AR + 96 * MiB);
    LAS float* mus = (LAS float*)(lds + 69632); LAS float* rss = mus + 128;
    const int r16 = lane & 15, quad = lane >> 4;
    for (int item = bid; item < 1024; item += gridDim.x) {
        const int hd = item & 7, c = item >> 3;
        __syncthreads();
        if (tid < 128) { const f32x4* pp = (const f32x4*)(STAT + (size_t)(c * 128 + tid) * 32); float a1 = 0.f, a2 = 0.f;
#pragma unroll
            for (int i = 0; i < 8; ++i) { const f32x4 t4 = pp[i]; a1 += t4[0] + t4[2]; a2 += t4[1] + t4[3]; }
            const float mu = a1 * (1.f / 1024.f); mus[tid] = mu; rss[tid] = rsqrtf(fmaxf(a2 * (1.f / 1024.f) - mu * mu, 0.f) + RMS_EPS); }
#pragma unroll
        for (int i = 0; i < 4; ++i) { const int cid = tid + 512 * i, t = cid >> 4, sc = cid & 15;
            const u32x4 w = *(const GAS u32x4*)(Wsb + ((size_t)(hd * 128 + t)) * 128 + 8 * sc); *(LAS u32x4*)(Wt + t * 136 + 8 * sc) = w; }
        __syncthreads();
#pragma unroll
        for (int i = 0; i < 4; ++i) { const int cid = tid + 512 * i, s = cid >> 4, dc = cid & 15;
            const int grow = c * 128 + s, gcol = hd * 128 + 8 * dc;
            const u32x4 w = *(const GAS u32x4*)(V + (size_t)grow * 1024 + gcol);
            const float mu = mus[s], rs = rss[s];
            const f32x4 g0 = *(const f32x4*)(gv + gcol), g1 = *(const f32x4*)(gv + gcol + 4), b0 = *(const f32x4*)(bv + gcol), b1 = *(const f32x4*)(bv + gcol + 4);
            float y[8];
#pragma unroll
            for (int e = 0; e < 8; ++e) { const float x = (e & 1) ? bfhi(w[e >> 1]) : bflo(w[e >> 1]); y[e] = (x - mu) * rs * ((e < 4) ? g0[e & 3] : g1[e & 3]) + ((e < 4) ? b0[e & 3] : b1[e & 3]); }
#pragma unroll
            for (int e = 0; e < 8; ++e) Vt[(8 * dc + e) * 136 + s] = f2bf(y[e]); }
        __syncthreads();
        const int t = 16 * wid + r16;
        const int nks = (16 * wid + 15) / 32 + 1;
        bf16x8 bw[4];
#pragma unroll
        for (int ks = 0; ks < 4; ++ks) bw[ks] = *(const LAS bf16x8*)(Wt + t * 136 + 32 * ks + 8 * quad);
        const int token = c * 128 + t;
        const float bias = bs[hd * 128 + t];
#pragma unroll
        for (int dt = 0; dt < 8; ++dt) {
            f32x4 acc = {0.f, 0.f, 0.f, 0.f};
#pragma unroll
            for (int ks = 0; ks < 4; ++ks) if (ks < nks) {
                const bf16x8 a = *(const LAS bf16x8*)(Vt + (16 * dt + r16) * 136 + 32 * ks + 8 * quad);
                acc = __builtin_amdgcn_mfma_f32_16x16x32_bf16(a, bw[ks], acc, 0, 0, 0); }
            const int col = hd * 128 + 16 * dt + 4 * quad;
            const u32x2 uu = *(const GAS u32x2*)(U + (size_t)token * 1024 + col);
            f32x4 y; y[0] = (acc[0] + bias) * bflo(uu.x); y[1] = (acc[1] + bias) * bfhi(uu.x); y[2] = (acc[2] + bias) * bflo(uu.y); y[3] = (acc[3] + bias) * bfhi(uu.y);
            store_bf4(Y + (size_t)token * 1024 + col, y);
        }
    }
}

DI void pool_phase(const Params& P, int gtid, int nthreads) {
    unsigned char* ws_ = P.ws; asm volatile("" : "+s"(ws_));
    asm volatile("" : "+v"(gtid));
    const float* ZF = (const float*)(ws_ + O_AR);
    bf16_t* Pb = (bf16_t*)(ws_ + O_AR + 64 * MiB);
    for (int e = gtid; e < 1024 * 256; e += nthreads) {
        const int cgi = e & 255, tb = e >> 8, col = 4 * cgi, w = 2 << (cgi >> 6), t0 = 16 * tb;
        f32x4 W = {0.f, 0.f, 0.f, 0.f};
        for (int j = 1; j < w; ++j) if (t0 - j >= 0) W += *(const GAS f32x4*)(ZF + (size_t)(t0 - j) * 1024 + col);
        for (int i = 0; i < 16; ++i) { const int t = t0 + i; const f32x4 z = *(const GAS f32x4*)(ZF + (size_t)t * 1024 + col); W += z;
            const float cnt = (float)((t + 1 < w) ? (t + 1) : w); const f32x4 o = W / cnt - z; store_bf4(Pb + (size_t)t * 1024 + col, o);
            if (t - w + 1 >= 0) W -= *(const GAS f32x4*)(ZF + (size_t)(t - w + 1) * 1024 + col); }
    }
}

DI void mla_rows(const Params& P, int gw, int NGW, int lane) {
    unsigned char* ws_ = P.ws; asm volatile("" : "+s"(ws_));
    asm volatile("" : "+v"(lane));
    unsigned char* ar = ws_ + O_AR;
    const bf16_t* LAT = (const bf16_t*)ar; bf16_t* QL = (bf16_t*)(ar + 24 * MiB); bf16_t* Cb = (bf16_t*)(ar + 36 * MiB); bf16_t* KR = (bf16_t*)(ar + 44 * MiB);
    const float* CS = (const float*)(ws_ + O_CS); const float* gq = P.in[15]; const float* gkv = P.in[18];
    for (int row = gw; row < S; row += NGW) {
        const bf16_t* lat = LAT + (size_t)row * 768;
        float q[6]; float ss = 0.f;
#pragma unroll
        for (int i = 0; i < 3; ++i) { const unsigned w = *(const GAS unsigned*)(lat + 2 * lane + 128 * i); q[2 * i] = bflo(w); q[2 * i + 1] = bfhi(w); ss += q[2 * i] * q[2 * i] + q[2 * i + 1] * q[2 * i + 1]; }
        ss = wave_sum(ss, lane); const float rq = rsqrtf(ss * (1.f / 384.f) + RMS_EPS);
#pragma unroll
        for (int i = 0; i < 3; ++i) { const f32x2 g2 = *(const f32x2*)(gq + 2 * lane + 128 * i); *(unsigned*)(QL + (size_t)row * 384 + 2 * lane + 128 * i) = pk_bf16(q[2 * i] * rq * g2.x, q[2 * i + 1] * rq * g2.y); }
        float cc[4]; float s2 = 0.f;
#pragma unroll
        for (int i = 0; i < 2; ++i) { const unsigned w = *(const GAS unsigned*)(lat + 384 + 2 * lane + 128 * i); cc[2 * i] = bflo(w); cc[2 * i + 1] = bfhi(w); s2 += cc[2 * i] * cc[2 * i] + cc[2 * i + 1] * cc[2 * i + 1]; }
        s2 = wave_sum(s2, lane); const float rc = rsqrtf(s2 * (1.f / 256.f) + RMS_EPS);
#pragma unroll
        for (int i = 0; i < 2; ++i) { const f32x2 g2 = *(const f32x2*)(gkv + 2 * lane + 128 * i); *(unsigned*)(Cb + (size_t)row * 256 + 2 * lane + 128 * i) = pk_bf16(cc[2 * i] * rc * g2.x, cc[2 * i + 1] * rc * g2.y); }
        if (lane < 32) { const float x1 = bf2f(lat[640 + lane]), x2 = bf2f(lat[672 + lane]); const f32x2 cs = *(const f32x2*)(CS + ((size_t)row * 32 + lane) * 2);
            *(unsigned*)(KR + (size_t)row * 64 + 2 * lane) = pk_bf16(x1 * cs.x - x2 * cs.y, x1 * cs.y + x2 * cs.x); }
    }
}

#define MFMA32(a, b, c) __builtin_amdgcn_mfma_f32_32x32x16_bf16((a), (b), (c), 0, 0, 0)
DI int crow(int reg, int h) { return (reg & 3) + 8 * (reg >> 2) + 4 * h; }

DI void attn_phase(const Params& P, LAS unsigned char* lds, int tid, int wid, int lane, int bid) {
    unsigned char* ws_ = P.ws; asm volatile("" : "+s"(ws_));
    asm volatile("" : "+v"(tid)); lane = tid & 63; wid = __builtin_amdgcn_readfirstlane(tid >> 6);
    unsigned char* ar = ws_ + O_AR;
    const bf16_t* Q = (const bf16_t*)(ar + 48 * MiB); const bf16_t* KN = (const bf16_t*)(ar + 96 * MiB); const bf16_t* VT = (const bf16_t*)(ar + 128 * MiB); const bf16_t* KR = (const bf16_t*)(ar + 44 * MiB);
    bf16_t* AO = (bf16_t*)(ws_ + O_XN);
    const int l32 = lane & 31, h2 = lane >> 5;
    constexpr int BUFB = 43008, VOFF = 25600;
    const unsigned kn_off0 = (unsigned)(((tid >> 4) * 1024 + 8 * (tid & 15)) * 2);
    const unsigned kr_off = (unsigned)(((tid >> 3) * 64 + 8 * (tid & 7)) * 2);
    const unsigned vt_off0 = (unsigned)(((tid >> 3) * 16384 + 8 * (tid & 7)) * 2);
    const unsigned kn_l0 = (unsigned)((tid >> 4) * 400 + 16 * (tid & 15));
    const unsigned kr_l = (unsigned)((tid >> 3) * 400 + 256 + 16 * (tid & 7));
    const unsigned vt_l0 = (unsigned)(25600 + (tid >> 3) * 136 + 16 * (tid & 7));
    for (int item = bid; item < 256; item += gridDim.x) {
        const int head = item & 7, pair = item >> 3;
        for (int half = 0; half < 2; ++half) {
            const int qb = half ? 63 - pair : pair;
            const int wrow0 = qb * 256 + wid * 32, qrow = wrow0 + l32;
            bf16x8 Qf[12];
#pragma unroll
            for (int s = 0; s < 12; ++s) Qf[s] = *(const GAS bf16x8*)(Q + (size_t)qrow * 1536 + head * 192 + 16 * s + 8 * h2);
            f32x16 o[4];
#pragma unroll
            for (int d = 0; d < 4; ++d)
#pragma unroll
                for (int r = 0; r < 16; ++r) o[d][r] = 0.f;
            float mrun = -INFINITY, lsum = 0.f;
            const int ntiles = 4 * (qb + 1);
            u32x4 kreg[3], vreg[2];
#define ATT_ISSUE(kt) do { \
    unsigned o0_ = kn_off0, o1_ = kr_off, o2_ = vt_off0; asm volatile("" : "+v"(o0_), "+v"(o1_), "+v"(o2_)); \
    const char* knb = (const char*)(KN + (size_t)(kt) * 65536 + head * 128); const char* krb = (const char*)(KR + (size_t)(kt) * 4096); \
    const char* vtb = (const char*)(VT + (size_t)head * 128 * 16384 + 64 * (kt)); \
    kreg[0] = *(const GAS u32x4*)(knb + o0_); kreg[1] = *(const GAS u32x4*)(knb + 65536 + o0_); kreg[2] = *(const GAS u32x4*)(krb + o1_); \
    vreg[0] = *(const GAS u32x4*)(vtb + o2_); vreg[1] = *(const GAS u32x4*)(vtb + 2097152 + o2_); } while (0)
#define ATT_WRITE(b) do { LAS unsigned char* base = lds + (b) * BUFB; \
    *(LAS u32x4*)(base + kn_l0) = kreg[0]; *(LAS u32x4*)(base + kn_l0 + 12800) = kreg[1]; *(LAS u32x4*)(base + kr_l) = kreg[2]; \
    *(LAS u32x2*)(base + vt_l0) = (u32x2){vreg[0].x, vreg[0].y}; *(LAS u32x2*)(base + vt_l0 + 8) = (u32x2){vreg[0].z, vreg[0].w}; \
    *(LAS u32x2*)(base + vt_l0 + 8704) = (u32x2){vreg[1].x, vreg[1].y}; *(LAS u32x2*)(base + vt_l0 + 8712) = (u32x2){vreg[1].z, vreg[1].w}; } while (0)
            ATT_ISSUE(0); ATT_WRITE(0); __syncthreads();
            for (int kt = 0; kt < ntiles; ++kt) {
                const bool more = (kt + 1 < ntiles);
                if (more) ATT_ISSUE(kt + 1);
                if (64 * kt <= wrow0 + 31) {
                    LAS unsigned char* base = lds + (kt & 1) * BUFB;
                    f32x16 st0, st1;
#pragma unroll
                    for (int r = 0; r < 16; ++r) { st0[r] = 0.f; st1[r] = 0.f; }
                    {
                        const LAS unsigned char* kp = base + l32 * 400 + 16 * h2;
                        bf16x8 ka[2][4];
#define ATT_LDK(bf, gq) do { _Pragma("unroll") for (int sl = 0; sl < 2; ++sl) { ka[bf][2 * sl] = *(const LAS bf16x8*)(kp + 32 * (2 * (gq) + sl)); ka[bf][2 * sl + 1] = *(const LAS bf16x8*)(kp + 12800 + 32 * (2 * (gq) + sl)); } } while (0)
#define ATT_MMK(bf, gq) do { _Pragma("unroll") for (int sl = 0; sl < 2; ++sl) { st0 = MFMA32(ka[bf][2 * sl], Qf[2 * (gq) + sl], st0); st1 = MFMA32(ka[bf][2 * sl + 1], Qf[2 * (gq) + sl], st1); } } while (0)
                        ATT_LDK(0, 0); __builtin_amdgcn_sched_barrier(0);
                        ATT_LDK(1, 1); __builtin_amdgcn_sched_barrier(0);
                        ATT_MMK(0, 0); __builtin_amdgcn_sched_barrier(0);
                        ATT_LDK(0, 2); __builtin_amdgcn_sched_barrier(0);
                        ATT_MMK(1, 1); __builtin_amdgcn_sched_barrier(0);
                        ATT_LDK(1, 3); __builtin_amdgcn_sched_barrier(0);
                        ATT_MMK(0, 2); __builtin_amdgcn_sched_barrier(0);
                        ATT_LDK(0, 4); __builtin_amdgcn_sched_barrier(0);
                        ATT_MMK(1, 3); __builtin_amdgcn_sched_barrier(0);
                        ATT_LDK(1, 5); __builtin_amdgcn_sched_barrier(0);
                        ATT_MMK(0, 4); __builtin_amdgcn_sched_barrier(0);
                        ATT_MMK(1, 5); __builtin_amdgcn_sched_barrier(0);
#undef ATT_LDK
#undef ATT_MMK
                    }
                    if (64 * kt + 63 > wrow0) {
#pragma unroll
                        for (int r = 0; r < 16; ++r) { const int key0 = 64 * kt + crow(r, h2); if (key0 > qrow) st0[r] = -INFINITY; if (key0 + 32 > qrow) st1[r] = -INFINITY; }
                    }
                    float mx = st0[0];
#pragma unroll
                    for (int r = 1; r < 16; ++r) mx = fmaxf(mx, st0[r]);
#pragma unroll
                    for (int r = 0; r < 16; ++r) mx = fmaxf(mx, st1[r]);
                    mx = fmaxf(mx, shx(mx, 32, lane));
                    const float mn = fmaxf(mrun, mx);
                    const float alpha = __builtin_amdgcn_exp2f(mrun - mn);
                    mrun = mn;
                    float psum = 0.f;
#pragma unroll
                    for (int r = 0; r < 16; ++r) { st0[r] = __builtin_amdgcn_exp2f(st0[r] - mn); st1[r] = __builtin_amdgcn_exp2f(st1[r] - mn); psum += st0[r] + st1[r]; }
                    lsum = lsum * alpha + psum;
                    if (__builtin_amdgcn_ballot_w64(alpha != 1.f) != 0ull) {
#pragma unroll
                        for (int d = 0; d < 4; ++d)
#pragma unroll
                            for (int r = 0; r < 16; ++r) o[d][r] *= alpha;
                    }
                    {
                        const LAS unsigned char* vb = base + VOFF + l32 * 136 + 8 * h2;
                        u32x4 va[2][4];
#define ATT_LDV(bf, stp) do { _Pragma("unroll") for (int d = 0; d < 4; ++d) { const LAS unsigned char* vp = vb + d * 4352 + 32 * (stp); \
        const u32x2 lo = *(const LAS u32x2*)vp, hi = *(const LAS u32x2*)(vp + 16); va[bf][d] = (u32x4){lo.x, lo.y, hi.x, hi.y}; } } while (0)
#define ATT_MMV(bf, stv, sp) do { u32x4 pw; pw.x = pk_bf16(stv[8 * (sp)], stv[8 * (sp) + 1]); pw.y = pk_bf16(stv[8 * (sp) + 2], stv[8 * (sp) + 3]); pw.z = pk_bf16(stv[8 * (sp) + 4], stv[8 * (sp) + 5]); pw.w = pk_bf16(stv[8 * (sp) + 6], stv[8 * (sp) + 7]); \
        const bf16x8 pf = __builtin_bit_cast(bf16x8, pw); _Pragma("unroll") for (int d = 0; d < 4; ++d) o[d] = MFMA32(__builtin_bit_cast(bf16x8, va[bf][d]), pf, o[d]); } while (0)
                        ATT_LDV(0, 0); __builtin_amdgcn_sched_barrier(0);
                        ATT_LDV(1, 1); __builtin_amdgcn_sched_barrier(0);
                        ATT_MMV(0, st0, 0); __builtin_amdgcn_sched_barrier(0);
                        ATT_LDV(0, 2); __builtin_amdgcn_sched_barrier(0);
                        ATT_MMV(1, st0, 1); __builtin_amdgcn_sched_barrier(0);
                        ATT_LDV(1, 3); __builtin_amdgcn_sched_barrier(0);
                        ATT_MMV(0, st1, 0); __builtin_amdgcn_sched_barrier(0);
                        ATT_MMV(1, st1, 1); __builtin_amdgcn_sched_barrier(0);
#undef ATT_LDV
#undef ATT_MMV
                    }
                }
                if (more) ATT_WRITE((kt + 1) & 1);
                __syncthreads();
            }
            int t2_ = tid; asm volatile("" : "+v"(t2_));
            const int qrow2 = qb * 256 + (t2_ >> 6) * 32 + (t2_ & 31), h2b = (t2_ >> 5) & 1;
            const float ltot = lsum + shx(lsum, 32, lane);
            const float inv = 1.f / ltot;
#pragma unroll
            for (int d = 0; d < 4; ++d)
#pragma unroll
                for (int rg = 0; rg < 4; ++rg) { f32x4 v = {o[d][4 * rg] * inv, o[d][4 * rg + 1] * inv, o[d][4 * rg + 2] * inv, o[d][4 * rg + 3] * inv};
                    store_bf4(AO + (size_t)qrow2 * 1024 + head * 128 + d * 32 + 8 * rg + 4 * h2b, v); }
        }
    }
#undef ATT_ISSUE
#undef ATT_WRITE
}

DI void s5_precompute(const Params& P, LAS unsigned char* lds, int tid, int bid) {
    unsigned char* ws_ = P.ws; asm volatile("" : "+s"(ws_));
    asm volatile("" : "+v"(tid));
    LAS float* PWr = (LAS float*)lds;
    LAS float* PWi = PWr + 33 * 64;
    LAS float* BBr = PWi + 33 * 64;
    LAS float* BBi = BBr + 1024;
    LAS float* CRe = BBi + 1024;
    LAS float* CIm = CRe + 1024;
    LAS float* KT = CIm + 1024;
    const float* lam_re = P.in[22]; const float* lam_im = P.in[23]; const float* log_dt = P.in[24];
    const float* b_re = P.in[25]; const float* b_im = P.in[26]; const float* c_re = P.in[27]; const float* c_im = P.in[28]; const float* dsk = P.in[29];
    bf16_t* TF = (bf16_t*)(ws_ + O_AR + 40 * MiB); bf16_t* Eb = (bf16_t*)(ws_ + O_AR + 80 * MiB);
    for (int item = bid; item < 256; item += gridDim.x) {
        const int g = item >> 2, q = item & 3;
        __syncthreads();
        const float dt = expf(log_dt[g]);
        for (int e = tid; e < 33 * 64; e += 512) { const int j = e >> 6, p = e & 63; const float lr = lam_re[g * 64 + p], li = lam_im[g * 64 + p];
            const float mag = expf((float)j * (lr * dt)); float sn, cs; sincosf((float)j * (li * dt), &sn, &cs); PWr[e] = mag * cs; PWi[e] = mag * sn; }
        for (int e = tid; e < 1024; e += 512) { const int p = e >> 4; const float lr = lam_re[g * 64 + p], li = lam_im[g * 64 + p];
            const float mag = expf(lr * dt); float sn, cs; sincosf(li * dt, &sn, &cs); const float ar = mag * cs, ai = mag * sn;
            const float den = lr * lr + li * li; const float fre = ((ar - 1.f) * lr + ai * li) / den, fim = (ai * lr - (ar - 1.f) * li) / den;
            const float br = b_re[(size_t)g * 1024 + e], bi = b_im[(size_t)g * 1024 + e];
            BBr[e] = fre * br - fim * bi; BBi[e] = fre * bi + fim * br; }
        for (int e = tid; e < 1024; e += 512) { CRe[e] = c_re[(size_t)g * 1024 + e]; CIm[e] = c_im[(size_t)g * 1024 + e]; }
        __syncthreads();
        {
            const int pr_ = tid & 255, co = pr_ >> 4, ci = pr_ & 15, j0 = (tid >> 8) * 16;
            float a[16];
#pragma unroll
            for (int jj = 0; jj < 16; ++jj) a[jj] = 0.f;
            for (int p = 0; p < 64; ++p) {
                const float cr = CRe[co * 64 + p], cm = CIm[co * 64 + p], br = BBr[p * 16 + ci], bi = BBi[p * 16 + ci];
                const float xr = cr * br - cm * bi, xi = cr * bi + cm * br;
#pragma unroll
                for (int jj = 0; jj < 16; ++jj) a[jj] += xr * PWr[(j0 + jj) * 64 + p] - xi * PWi[(j0 + jj) * 64 + p];
            }
            if (j0 == 0 && co == ci) a[0] += dsk[g * 16 + co];
#pragma unroll
            for (int jj = 0; jj < 16; ++jj) KT[((j0 + jj) * 16 + co) * 16 + ci] = a[jj];
        }
        __syncthreads();
        for (int e = tid; e < 128 * 80; e += 512) { const int rr = e / 80, kc = e - rr * 80, n = 128 * q + rr, l = n >> 4, co = n & 15; float v[8];
            if (kc < 64) { const int lp = kc >> 1;
#pragma unroll
                for (int i = 0; i < 8; ++i) v[i] = (lp <= l) ? KT[((l - lp) * 16 + co) * 16 + 8 * (kc & 1) + i] : 0.f;
            } else {
                const bool im = kc >= 72; const int p0 = 8 * (kc - (im ? 72 : 64));
#pragma unroll
                for (int i = 0; i < 8; ++i) { const int p = p0 + i; const float cr = CRe[co * 64 + p], cm = CIm[co * 64 + p], pr = PWr[(l + 1) * 64 + p], pi = PWi[(l + 1) * 64 + p];
                    v[i] = im ? -(cr * pi + cm * pr) : (cr * pr - cm * pi); }
            }
            u32x4 o; o.x = pk_bf16(v[0], v[1]); o.y = pk_bf16(v[2], v[3]); o.z = pk_bf16(v[4], v[5]); o.w = pk_bf16(v[6], v[7]);
            *(u32x4*)(TF + ((size_t)(g * 512 + n)) * 640 + 8 * kc) = o; }
        for (int e = tid; e < 32 * 64; e += 512) { const int n = 32 * q + (e >> 6), kc = e & 63, p = n & 63, im = n >> 6, lp = kc >> 1; float v[8];
            const float pr = PWr[(31 - lp) * 64 + p], pi = PWi[(31 - lp) * 64 + p];
#pragma unroll
            for (int i = 0; i < 8; ++i) { const int ci = 8 * (kc & 1) + i; const float br = BBr[p * 16 + ci], bi = BBi[p * 16 + ci]; v[i] = im ? (pr * bi + pi * br) : (pr * br - pi * bi); }
            u32x4 o; o.x = pk_bf16(v[0], v[1]); o.y = pk_bf16(v[2], v[3]); o.z = pk_bf16(v[4], v[5]); o.w = pk_bf16(v[6], v[7]);
            *(u32x4*)(Eb + ((size_t)(g * 256 + n)) * 512 + 8 * kc) = o; }
    }
}

DI void s5_scan(const Params& P, int wid, int lane, int bid) {
    unsigned char* ws_ = P.ws; asm volatile("" : "+s"(ws_));
    asm volatile("" : "+v"(lane));
    if (wid != 0) return;
    const float* lam_re = P.in[22]; const float* lam_im = P.in[23]; const float* log_dt = P.in[24];
    const float* XE = (const float*)(ws_ + O_AR + 96 * MiB); bf16_t* UG = (bf16_t*)(ws_ + O_AR);
    for (int g = bid; g < 64; g += gridDim.x) {
        const int p = lane; const float dt = expf(log_dt[g]); const float lr = lam_re[g * 64 + p], li = lam_im[g * 64 + p];
        const float mag = expf(32.f * (lr * dt)); float sn, cs; sincosf(32.f * (li * dt), &sn, &cs); const float ar = mag * cs, ai = mag * sn;
        float cr = 0.f, ci = 0.f;
        const float* xe = XE + (size_t)g * 512 * 128; bf16_t* ug = UG + (size_t)g * 512 * 640;
        for (int c0 = 0; c0 < 512; c0 += 16) {
            float xr[16], xi[16];
#pragma unroll
            for (int i = 0; i < 16; ++i) { xr[i] = xe[(size_t)(c0 + i) * 128 + p]; xi[i] = xe[(size_t)(c0 + i) * 128 + 64 + p]; }
#pragma unroll
            for (int i = 0; i < 16; ++i) { ug[(size_t)(c0 + i) * 640 + 512 + p] = f2bf(cr); ug[(size_t)(c0 + i) * 640 + 576 + p] = f2bf(ci);
                const float nr = ar * cr - ai * ci + xr[i], ni = ar * ci + ai * cr + xi[i]; cr = nr; ci = ni; }
        }
    }
}

DI void cs_table(const Params& P, int gtid, int nthreads) {
    unsigned char* ws_ = P.ws; asm volatile("" : "+s"(ws_));
    asm volatile("" : "+v"(gtid));
    const int* pos = (const int*)P.in[1]; float* CS = (float*)(ws_ + O_CS);
    for (int e = gtid; e < S * 32; e += nthreads) { const int row = e >> 5, j = e & 31;
        const float invf = exp2f(-(float)j * (13.287712379549449f / 32.f)); const float ang = (float)pos[row] * invf; float sn, cs; sincosf(ang, &sn, &cs);
        *(f32x2*)(CS + (size_t)e * 2) = (f32x2){cs, sn}; }
}


#define XB_TMO      128
#define XB_XCNT(j)  (256  + 64 * (j))
#define XB_XSUB(j)  (1280 + 64 * (j))
#define XB_XGEN(j)  (2304 + 64 * (j))
#define XB_TOP      3328
#define XB_TOPGEN   3392
#define XCD_BAR_WORDS 3456
#define XB_SPIN_CAP (1u << 18)
DI unsigned xb_ld(unsigned* p)              { return __hip_atomic_load(p, __ATOMIC_RELAXED, __HIP_MEMORY_SCOPE_AGENT); }
DI unsigned xb_add(unsigned* p, unsigned v) { return __hip_atomic_fetch_add(p, v, __ATOMIC_RELAXED, __HIP_MEMORY_SCOPE_AGENT); }
DI unsigned xb_xcc_id() { return (unsigned)__builtin_amdgcn_s_getreg((3 << 11) | 20) & 0xFu; }
#define XB_SPIN(cond, bar) do { unsigned _sp = 0; while (cond) { __builtin_amdgcn_s_sleep(1); \
    if ((++_sp & 255u) == 0u) { if (xb_ld(&(bar)[XB_TMO])) break; if (_sp > XB_SPIN_CAP) { atomicAdd(&(bar)[XB_TMO], 1u); break; } } } } while (0)
struct XcdBarrier { unsigned* bar; unsigned x; volatile LAS unsigned* st; };
DI XcdBarrier xcd_barrier_post(unsigned* bar, volatile LAS unsigned* st) {
    XcdBarrier b; b.bar = bar; b.x = xb_xcc_id(); b.st = st;
    if (threadIdx.x == 0) (void)xb_add(&bar[XB_XCNT(b.x)], 1u);
    return b;
}
DI void xcd_barrier_complete(unsigned* bar, unsigned x, unsigned& nloc, unsigned& nx) {
    const unsigned G = gridDim.x * gridDim.y * gridDim.z;
    unsigned sum, cnt, mine, sp = 0u;
    for (;;) {
        sum = 0u; cnt = 0u; mine = 0u;
#pragma unroll
        for (unsigned j = 0; j < 16; ++j) { const unsigned c = xb_ld(&bar[XB_XCNT(j)]); sum += c; cnt += (c > 0u) ? 1u : 0u; mine = (j == x) ? c : mine; }
        if (sum == G) break;
        __builtin_amdgcn_s_sleep(1);
        if ((++sp & 255u) == 0u) { if (xb_ld(&bar[XB_TMO])) break; if (sp > XB_SPIN_CAP) { atomicAdd(&bar[XB_TMO], 1u); break; } }
    }
    nloc = mine > 0u ? mine : 1u; nx = cnt > 0u ? cnt : 1u;
}
DI void xcd_barrier(const XcdBarrier& b) {
    asm volatile("s_waitcnt vmcnt(0)" ::: "memory");
    __syncthreads();
    if (threadIdx.x == 0) {
        unsigned* bar = b.bar;
        __builtin_amdgcn_s_waitcnt(0);
        unsigned nloc = b.st[0], nx = b.st[1];
        if (nloc == 0u) { xcd_barrier_complete(bar, b.x, nloc, nx); b.st[0] = nloc; b.st[1] = nx; }
        const unsigned old = xb_add(&bar[XB_XSUB(b.x)], 1u);
        const unsigned gen = old / nloc;
        if (old + 1u == (gen + 1u) * nloc) {
            __builtin_amdgcn_fence(__ATOMIC_RELEASE, "agent");
            asm volatile("s_waitcnt vmcnt(0)" ::: "memory");
            const unsigned og = xb_add(&bar[XB_TOP], 1u);
            const unsigned tg = og / nx;
            if (og + 1u == (tg + 1u) * nx) xb_add(&bar[XB_TOPGEN], 1u);
            else XB_SPIN(xb_ld(&bar[XB_TOPGEN]) == tg, bar);
            __builtin_amdgcn_fence(__ATOMIC_ACQUIRE, "agent");
            xb_add(&bar[XB_XGEN(b.x)], 1u);
            asm volatile("s_waitcnt vmcnt(0)" ::: "memory");
        } else {
            XB_SPIN(xb_ld(&bar[XB_XGEN(b.x)]) == gen, bar);
            __builtin_amdgcn_fence(__ATOMIC_ACQUIRE, "agent");
            asm volatile("s_waitcnt vmcnt(0)" ::: "memory");
        }
    }
    __syncthreads();
}

__global__ void __launch_bounds__(512, 2) __attribute__((amdgpu_waves_per_eu(2, 2))) mega_fwd(Params P) {
    extern __shared__ __attribute__((aligned(16))) unsigned char smem[];
    LAS unsigned char* lds = (LAS unsigned char*)smem;
    cg::grid_group grid = cg::this_grid();
    __shared__ uint4 xb_words;
    if (threadIdx.x == 0) xb_words = make_uint4(0u, 0u, 0u, 0u);
    __syncthreads();
    const XcdBarrier xb = xcd_barrier_post((unsigned*)(P.ws + O_BAR), (volatile LAS unsigned*)&xb_words);
    const int G = gridDim.x, nthreads = G * 512, NGW = G * 8;
#pragma nounroll
    for (int st = 0; st < NSTEPS; ++st) {
        int nrep = PROBE_REP(st); asm volatile("" : "+s"(nrep));
_Pragma("nounroll") for (int rep = 0; rep < nrep; ++rep) {
        if (rep) __syncthreads();
        int tid = threadIdx.x; asm volatile("" : "+v"(tid));
        int bid = blockIdx.x; asm volatile("" : "+s"(bid));
        unsigned char* ws = P.ws; asm volatile("" : "+s"(ws));
        float* outp_ = P.out; asm volatile("" : "+s"(outp_));
        const float* ng = P.in[2];
        bf16_t* XN = (bf16_t*)(ws + O_XN); const bf16_t* Zb = (const bf16_t*)(ws + O_Z);
        GemmDesc g;
        if (get_gemm(P, st, g)) gemm_phase(lds, P, g, G, bid, tid);
        else switch (st) {
        case 0: conv_layer(P, 0, GW_, NGW, LANE_); cs_table(P, GTID_, nthreads);
                row_pass<RP_BF>(P.in[0], outp_, nullptr, nullptr, ng, XN, GW_, NGW, LANE_); break;
        case 3: gate_phase(P, lds, tid, WID_, LANE_, bid); break;
        case 5: case 11: case 14: case 22: case 30: {
            const int L = (st == 5) ? 0 : (st <= 14 ? 1 : (st == 22 ? 2 : 3)); const bool mlp = (st == 14);
            const float* hin = (st == 5) ? P.in[0] : outp_;
            const float* gpost = ng + (L * 4 + (mlp ? 3 : 1)) * 1024; const float* gpre = mlp ? ng + ((L + 1) * 4) * 1024 : ng + (L * 4 + 2) * 1024;
            row_pass<RP_BF>(hin, outp_, Zb, gpost, gpre, XN, GW_, NGW, LANE_);
            if (mlp) conv_layer(P, L + 1, GW_, NGW, LANE_);
        } break;
        case 8: row_pass<RP_F32>(outp_, outp_, Zb, ng + 3 * 1024, ng + 4 * 1024, ws + O_AR, GW_, NGW, LANE_); conv_layer(P, 1, GW_, NGW, LANE_); break;
        case 9: pool_phase(P, GTID_, nthreads); break;
        case 16: mla_rows(P, GW_, NGW, LANE_); break;
        case 20: attn_phase(P, lds, tid, WID_, LANE_, bid); break;
        case 25: row_pass<RP_S5>(outp_, outp_, Zb, ng + 11 * 1024, ng + 12 * 1024, ws + O_AR, GW_, NGW, LANE_); conv_layer(P, 3, GW_, NGW, LANE_); s5_precompute(P, lds, tid, bid); break;
        case 27: s5_scan(P, WID_, LANE_, bid); break;
        case 33: row_pass<RP_FINAL>(outp_, outp_, Zb, ng + 15 * 1024, nullptr, nullptr, GW_, NGW, LANE_); break;
        default: break;
        }
        }
        if (G == 0) grid.sync();
        if (st != 2 && st != 17 && st != 18 && st != NSTEPS - 1) { xcd_barrier(xb); if (PROBE_SYNC) xcd_barrier(xb); }
    }
}
}

extern "C" void kernel_launch(void* const* d_in, const int* in_sizes, int n_in, void* d_out, int out_size, void* d_ws, size_t ws_size, hipStream_t stream) {
    static int grid = 0;
    if (grid == 0) {
        int dev = 0, cus = 0, per_cu = 0;
        hipGetDevice(&dev);
        hipDeviceGetAttribute(&cus, hipDeviceAttributeMultiprocessorCount, dev);
        hipFuncSetAttribute((const void*)mega_fwd, hipFuncAttributeMaxDynamicSharedMemorySize, LDS_BYTES);
        if (hipOccupancyMaxActiveBlocksPerMultiprocessor(&per_cu, (const void*)mega_fwd, 512, LDS_BYTES) != hipSuccess || per_cu < 1) per_cu = 1;
        (void)hipGetLastError();
        grid = cus * per_cu;
        if (grid <= 0) grid = 256;
    }
    Params p{};
    for (int i = 0; i < 32 && i < n_in; ++i) p.in[i] = (const float*)d_in[i];
    p.out = (float*)d_out; p.ws = (unsigned char*)d_ws;
    hipMemsetAsync((unsigned char*)d_ws + O_BAR, 0, XCD_BAR_WORDS * 4, stream);
    void* args[] = {&p};
    hipError_t e = hipLaunchCooperativeKernel((const void*)mega_fwd, dim3(grid), dim3(512), args, LDS_BYTES, stream);
    if (e != hipSuccess) fprintf(stderr, "cooperative launch failed: %s (grid %d)\n", hipGetErrorString(e), grid);
}
```

```cpp
#include <hip/hip_runtime.h>
#include <hip/hip_cooperative_groups.h>
#include <cstdio>
namespace cg = cooperative_groups;

#define DI __device__ __forceinline__
#define LAS __attribute__((address_space(3)))
#define GAS __attribute__((address_space(1)))
typedef unsigned short bf16_t;
typedef short bf16x8 __attribute__((ext_vector_type(8)));
typedef float f32x2 __attribute__((ext_vector_type(2)));
typedef float f32x4 __attribute__((ext_vector_type(4)));
typedef float f32x16 __attribute__((ext_vector_type(16)));
typedef unsigned u32x2 __attribute__((ext_vector_type(2)));
typedef unsigned u32x4 __attribute__((ext_vector_type(4)));
typedef __bf16 bf16v2 __attribute__((ext_vector_type(2)));

#define LANE_ (tid & 63)
#define WID_ (__builtin_amdgcn_readfirstlane(tid >> 6))
#define GW_ (bid * 8 + WID_)
#define GTID_ (bid * 512 + tid)
#ifndef PROBE_REP
#define PROBE_REP(st) 1
#endif
#ifndef PROBE_SYNC
#define PROBE_SYNC 0
#endif
#define IS_GEMM_STEP(st) ((st)==1||(st)==4||(st)==6||(st)==7||(st)==10||(st)==12||(st)==13||(st)==15||(st)==17||(st)==18||(st)==19||(st)==21||(st)==23||(st)==24||(st)==26||(st)==28||(st)==29||(st)==31||(st)==32)
#define IS_MLP_STEP(st) ((st)==6||(st)==7||(st)==12||(st)==13||(st)==23||(st)==24||(st)==31||(st)==32)
namespace {
constexpr int S = 16384;
constexpr size_t MiB = (size_t)1 << 20;
constexpr size_t O_CS = 0, O_WUP = 4 * MiB, O_WDN = 12 * MiB, O_WMIX = 20 * MiB, O_XN = 28 * MiB, O_Z = 60 * MiB, O_AR = 92 * MiB;
constexpr int LDS_BYTES = 131072;
constexpr size_t O_BAR = 254 * MiB;
constexpr size_t O_STAT = 254 * MiB + 65536;
constexpr int NSTEPS = 34;
constexpr float RMS_EPS = 1e-6f;
constexpr float QSCALE = 0.07216878364870322f * 1.4426950408889634f;

enum { E_Z = 0, E_HID, E_UV, E_POOL, E_LAT, E_Q, E_KN, E_VT, E_XE, E_S5Y, E_GLU };

struct Params { const float* in[32]; float* out; unsigned char* ws; };

DI unsigned pk_bf16(float a, float b) { f32x2 f = {a, b}; bf16v2 h = __builtin_convertvector(f, bf16v2); return __builtin_bit_cast(unsigned, h); }
DI bf16_t f2bf(float x) { return (bf16_t)(pk_bf16(x, 0.f) & 0xffffu); }
DI float bf2f(bf16_t b) { return __uint_as_float(((unsigned)b) << 16); }
DI float bflo(unsigned u) { return __uint_as_float(u << 16); }
DI float bfhi(unsigned u) { return __uint_as_float(u & 0xffff0000u); }
DI float shx(float v, int o, int lane) { return __int_as_float(__builtin_amdgcn_ds_bpermute((lane ^ o) << 2, __float_as_int(v))); }
DI float wave_sum(float v, int lane) {
#pragma unroll
    for (int o = 1; o < 64; o <<= 1) v += shx(v, o, lane);
    return v;
}
DI void store_bf4(bf16_t* p, f32x4 v) { u32x2 w; w.x = pk_bf16(v[0], v[1]); w.y = pk_bf16(v[2], v[3]); *(GAS u32x2*)p = w; }
DI float gelu_tanh(float x) {
    const float u = 0.7978845608028654f * (x + 0.044715f * x * x * x);
    const float e = __expf(-2.f * u);
    return x * __builtin_amdgcn_rcpf(1.f + e);
}

constexpr int BM = 256, BK = 64, HALF = 128, HTB = HALF * BK * 2, NXCD = 8, WGM = 8;
DI int lds_byte(int r, int c) { const int st = (r >> 4) * 2 + (c >> 5), rr = r & 15, cc = c & 31, ob = rr * 64 + cc * 2; return st * 1024 + (ob ^ (((ob >> 9) & 1) << 5)); }
DI void stage_rc(int b, int& R, int& C) { const int st = b / 1024, sb = b % 1024, swz = sb ^ (((sb >> 9) & 1) << 5); R = (st >> 1) * 16 + swz / 64; C = (st & 1) * 32 + (swz % 64) / 2; }

struct GemmDesc { const bf16_t* A; const bf16_t* Bt; long a_gs, b_gs; int K, lda, ldb, nM, nN, ngrp, mode; };
struct Unit { int pm, pn, grp; };

DI bool unit_next(const GemmDesc& g, int i, int G, int c, Unit& u) {
    const int nper = g.nM * g.nN;
    const long L = (long)i * G + c;
    const bool ok = L < (long)nper * g.ngrp;
    const int grp2 = (int)(L / nper), w = (int)(L - (long)grp2 * nper);
    const int nwg = nper, nM = g.nM, nN = g.nN;
    int wgid = w;
    { const int q = nwg / NXCD, r = nwg % NXCD, xcd = wgid % NXCD, off = wgid / NXCD; wgid = (xcd < r ? xcd * (q + 1) : r * (q + 1) + (xcd - r) * q) + off; }
    const int nig = WGM * nN, gid = wgid / nig, fm = gid * WGM, gsz = (nM - fm) < WGM ? (nM - fm) : WGM;
    const int gszc = gsz > 0 ? gsz : 1;
    const int pm1 = fm + ((wgid % nig) % gszc), pn1 = (wgid % nig) / gszc;
    const int pm2 = w % nM, pn2 = w / nM;
    const bool single = (g.ngrp == 1);
    Unit r; r.pm = single ? pm1 : pm2; r.pn = single ? pn1 : pn2; r.grp = single ? 0 : grp2;
    u = r;
    return ok;
}

DI int perm32(int rho) { const int n = rho >> 4, i = rho & 15; return 8 * (i >> 2) + 4 * n + (i & 3); }
DI void store_bf8(bf16_t* p, f32x4 a, f32x4 b) { u32x4 w; w.x = pk_bf16(a[0], a[1]); w.y = pk_bf16(a[2], a[3]); w.z = pk_bf16(b[0], b[1]); w.w = pk_bf16(b[2], b[3]); *(GAS u32x4*)p = w; }
#define EPI_LOOP(...) \
    _Pragma("unroll") for (int ai = 0; ai < 2; ++ai) _Pragma("unroll") for (int m = 0; m < 4; ++m) { const int row = row0 + ai * HALF + m * 16; \
        _Pragma("unroll") for (int bj = 0; bj < 2; ++bj) { const int col = col0 + bj * HALF; f32x4 v0 = acc[ai][bj][m][0], v1 = acc[ai][bj][m][1]; __VA_ARGS__ } }

DI void epilogue(const Params& P, const GemmDesc& g, const f32x4 (&acc)[2][2][4][2], const Unit& u, int wr, int wc, int fr, int fq) {
    unsigned char* ws_ = P.ws; asm volatile("" : "+s"(ws_));
    unsigned char* ws = ws_;
    const int row0 = u.pm * BM + wr * 64 + fr, col0 = u.pn * BM + wc * 32 + 8 * fq;
    bf16_t* Zb = (bf16_t*)(ws + O_Z);
    bf16_t* AR = (bf16_t*)(ws + O_AR);
    switch (g.mode) {
    case E_Z: { EPI_LOOP( store_bf8(Zb + (size_t)row * 1024 + col, v0, v1); ) } break;
    case E_HID: { EPI_LOOP( _Pragma("unroll") for (int j = 0; j < 4; ++j) { const float t0 = fmaxf(v0[j], 0.f), t1 = fmaxf(v1[j], 0.f); v0[j] = t0 * t0; v1[j] = t1 * t1; } store_bf8(AR + (size_t)row * 4096 + col, v0, v1); ) } break;
    case E_UV: { const float* bin = P.in[6]; float* STAT = (float*)(ws + O_AR + 96 * MiB); const int lane_ = fr + 16 * fq;
#pragma unroll
        for (int ai = 0; ai < 2; ++ai)
#pragma unroll
            for (int m = 0; m < 4; ++m) { const int row = row0 + ai * HALF + m * 16; float s1 = 0.f, s2 = 0.f;
#pragma unroll
                for (int bj = 0; bj < 2; ++bj) { const int col = col0 + bj * HALF; f32x4 v0 = acc[ai][bj][m][0], v1 = acc[ai][bj][m][1];
                    const f32x4 b0 = *(const GAS f32x4*)(bin + col); const f32x4 b1 = *(const GAS f32x4*)(bin + col + 4);
#pragma unroll
                    for (int j = 0; j < 4; ++j) { v0[j] = gelu_tanh(v0[j] + b0[j]); v1[j] = gelu_tanh(v1[j] + b1[j]); s1 += v0[j] + v1[j]; s2 += v0[j] * v0[j] + v1[j] * v1[j]; }
                    bf16_t* dst = (col < 1024) ? (AR + (size_t)row * 1024 + col) : (AR + 16 * MiB + (size_t)row * 1024 + (col - 1024)); store_bf8(dst, v0, v1); }
                if (col0 >= 1024) {
                    s1 += shx(s1, 16, lane_); s2 += shx(s2, 16, lane_); s1 += shx(s1, 32, lane_); s2 += shx(s2, 32, lane_);
                    if (fq == 0) *(GAS f32x2*)(STAT + ((size_t)row * 16 + (u.pn - 4) * 4 + wc) * 2) = (f32x2){s1, s2}; }
            }
    } break;
    case E_POOL: { const float* sc = P.in[13];
        EPI_LOOP( const int cgc = 256 * u.grp + col; const f32x4 s0 = *(const GAS f32x4*)(sc + cgc); const f32x4 s1 = *(const GAS f32x4*)(sc + cgc + 4); store_bf8(Zb + (size_t)row * 1024 + cgc, v0 * s0, v1 * s1); ) } break;
    case E_LAT: { EPI_LOOP( store_bf8(AR + (size_t)row * 768 + col, v0, v1); ) } break;
    case E_Q: { const float* CS = (const float*)(ws + O_CS); bf16_t* Qb = AR + 24 * MiB;
        EPI_LOOP( const int w = col % 192;
                  if (w >= 128) { const int j = (w - 128) >> 1; const f32x4 c0 = *(const GAS f32x4*)(CS + ((size_t)row * 32 + j) * 2); const f32x4 c1 = *(const GAS f32x4*)(CS + ((size_t)row * 32 + j) * 2 + 4);
                      const float a0 = v0[0] * c0[0] - v0[1] * c0[1]; const float a1 = v0[0] * c0[1] + v0[1] * c0[0]; const float a2 = v0[2] * c0[2] - v0[3] * c0[3]; const float a3 = v0[2] * c0[3] + v0[3] * c0[2];
                      const float e0 = v1[0] * c1[0] - v1[1] * c1[1]; const float e1 = v1[0] * c1[1] + v1[1] * c1[0]; const float e2 = v1[2] * c1[2] - v1[3] * c1[3]; const float e3 = v1[2] * c1[3] + v1[3] * c1[2];
                      v0[0] = a0; v0[1] = a1; v0[2] = a2; v0[3] = a3; v1[0] = e0; v1[1] = e1; v1[2] = e2; v1[3] = e3; }
                  store_bf8(Qb + (size_t)row * 1536 + col, v0 * QSCALE, v1 * QSCALE); ) } break;
    case E_KN: { bf16_t* KN = AR + 48 * MiB; EPI_LOOP( store_bf8(KN + (size_t)row * 1024 + col, v0, v1); ) } break;
    case E_VT: { bf16_t* VT = AR + 64 * MiB; EPI_LOOP( store_bf8(VT + (size_t)row * 16384 + col, v0, v1); ) } break;
    case E_XE: { float* XE = (float*)(ws + O_AR + 96 * MiB);
        EPI_LOOP( if (col < 128) { float* xp = XE + ((size_t)(u.grp * 512 + row)) * 128 + col; *(GAS f32x4*)xp = v0; *(GAS f32x4*)(xp + 4) = v1; } ) } break;
    case E_S5Y: { bf16_t* Y5 = AR + 56 * MiB;
        EPI_LOOP( const int l = col >> 4, c = col & 15; const int token = row * 32 + l; _Pragma("unroll") for (int j = 0; j < 4; ++j) { v0[j] = gelu_tanh(v0[j]); v1[j] = gelu_tanh(v1[j]); }
                  store_bf8(Y5 + (size_t)token * 1024 + u.grp * 16 + c, v0, v1); ) } break;
    case E_GLU: {
#pragma unroll
        for (int ai = 0; ai < 2; ++ai)
#pragma unroll
            for (int m = 0; m < 4; ++m) { const int row = row0 + ai * HALF + m * 16; const int oc = u.pn * 128 + wc * 32 + 8 * fq;
                const f32x4 a0 = acc[ai][0][m][0], a1 = acc[ai][0][m][1], b0 = acc[ai][1][m][0], b1 = acc[ai][1][m][1]; f32x4 v0, v1;
#pragma unroll
                for (int j = 0; j < 4; ++j) { v0[j] = a0[j] * __builtin_amdgcn_rcpf(1.f + __expf(-b0[j])); v1[j] = a1[j] * __builtin_amdgcn_rcpf(1.f + __expf(-b1[j])); }
                store_bf8(Zb + (size_t)row * 1024 + oc, v0, v1); }
    } break;
    default: break;
    }
}

DI void gemm_phase(LAS unsigned char* lds, const Params& P, const GemmDesc g, const int G, const int cidx, int tid) {
    asm volatile("" : "+v"(tid));
    const int wid = __builtin_amdgcn_readfirstlane(tid >> 6), lane = tid & 63, wr = wid >> 2, wc = wid & 3, fr = lane & 15, fq = lane >> 4;
    const int K = g.K, nt = K / BK;
    unsigned voffA[2], voffB[2];
#pragma unroll
    for (int i = 0; i < 2; ++i) { int R, C; stage_rc(tid * 16 + i * 8192, R, C); const int Rb = (R & ~31) + perm32(R & 31); voffA[i] = (unsigned)(R * g.lda + C) * 2u; voffB[i] = (unsigned)(Rb * g.ldb + C) * 2u; }
    const size_t kstep = (size_t)(BK * 2);
    const size_t hstepA = (size_t)HALF * g.lda * 2, hstepB = (size_t)HALF * g.ldb * 2;
    const unsigned ldsw = (unsigned)wid * 1024u;
    const int aoff = lds_byte(wr * 64 + fr, fq * 8), boff = lds_byte(wc * 32 + fr, fq * 8);
#define PG8_SA(b, h) (((b) * 2 + (h)) * HTB)
#define PG8_SB(b, h) ((4 + (b) * 2 + (h)) * HTB)
#define PG8_STAGE(bufoff, gbase, voff) do { _Pragma("unroll") for (int _i = 0; _i < 2; ++_i) \
        __builtin_amdgcn_global_load_lds((const unsigned*)((const char*)(gbase) + (voff)[_i]), (LAS unsigned*)(lds + (bufoff) + ldsw + _i * 8192), 16, 0, 0); } while (0)
#define PG8_LDA(dst, b, h) do { _Pragma("unroll") for (int m = 0; m < 4; ++m) _Pragma("unroll") for (int k = 0; k < 2; ++k) dst[m][k] = *(const LAS bf16x8*)(lds + PG8_SA(b, h) + aoff + m * 2048 + k * 1024); } while (0)
#define PG8_LDB(dst, b, h) do { _Pragma("unroll") for (int n = 0; n < 2; ++n) _Pragma("unroll") for (int k = 0; k < 2; ++k) dst[n][k] = *(const LAS bf16x8*)(lds + PG8_SB(b, h) + boff + n * 2048 + k * 1024); } while (0)
#define PG8_MMA(ai, bj, At, Bt) do { __builtin_amdgcn_s_setprio(1); _Pragma("unroll") for (int m = 0; m < 4; ++m) _Pragma("unroll") for (int n = 0; n < 2; ++n) _Pragma("unroll") for (int k = 0; k < 2; ++k) \
        acc[ai][bj][m][n] = __builtin_amdgcn_mfma_f32_16x16x32_bf16(Bt[n][k], At[m][k], acc[ai][bj][m][n], 0, 0, 0); __builtin_amdgcn_s_setprio(0); } while (0)
#define PG8_WAIT_V(n) asm volatile("s_waitcnt vmcnt(" #n ")" ::: "memory")
#define PG8_WAIT_L(n) asm volatile("s_waitcnt lgkmcnt(" #n ")" ::: "memory")
#define PG8_BAR __builtin_amdgcn_s_barrier()
#define PG8_SCHED __builtin_amdgcn_sched_barrier(0)
    Unit cur, nxt; int ui = 0;
    if (!unit_next(g, 0, G, cidx, cur)) return;
    f32x4 acc[2][2][4][2];
#pragma unroll
    for (int a = 0; a < 2; ++a)
#pragma unroll
        for (int b = 0; b < 2; ++b)
#pragma unroll
            for (int m = 0; m < 4; ++m)
#pragma unroll
                for (int n = 0; n < 2; ++n) acc[a][b][m][n] = (f32x4){0.f, 0.f, 0.f, 0.f};
    bf16x8 At[4][2], B0[2][2], B1[2][2];
    const char* cA = (const char*)g.A + ((size_t)cur.grp * g.a_gs + (size_t)cur.pm * BM * g.lda) * 2;
    const char* cB = (const char*)g.Bt + ((size_t)cur.grp * g.b_gs + (size_t)cur.pn * BM * g.ldb) * 2;
    PG8_STAGE(PG8_SB(0, 0), cB, voffB); PG8_STAGE(PG8_SA(0, 0), cA, voffA); PG8_STAGE(PG8_SB(0, 1), cB + hstepB, voffB); PG8_STAGE(PG8_SA(0, 1), cA + hstepA, voffA);
    if (wr == 1) PG8_BAR;
    PG8_WAIT_V(4); PG8_BAR;
    PG8_STAGE(PG8_SB(1, 0), cB + kstep, voffB); PG8_STAGE(PG8_SA(1, 0), cA + kstep, voffA); PG8_STAGE(PG8_SB(1, 1), cB + hstepB + kstep, voffB);
    PG8_WAIT_V(6); PG8_BAR;
    for (;;) {
        const bool has_next = unit_next(g, ui + 1, G, cidx, nxt);
        const char* nA = has_next ? (const char*)g.A + ((size_t)nxt.grp * g.a_gs + (size_t)nxt.pm * BM * g.lda) * 2 : cA;
        const char* nB = has_next ? (const char*)g.Bt + ((size_t)nxt.grp * g.b_gs + (size_t)nxt.pn * BM * g.ldb) * 2 : cB;
        for (int t = 0; t < nt; t += 2) {
            const bool last = (t == nt - 2);
            const char* a1 = cA + (size_t)(t + 1) * kstep;
            const char* a2 = last ? nA : cA + (size_t)(t + 2) * kstep; const char* b2 = last ? nB : cB + (size_t)(t + 2) * kstep;
            const char* a3 = a2 + kstep; const char* b3 = b2 + kstep;
            PG8_LDB(B0, 0, 0); PG8_SCHED; PG8_LDA(At, 0, 0); PG8_STAGE(PG8_SA(1, 1), a1 + hstepA, voffA);
            PG8_WAIT_L(8); PG8_BAR; PG8_WAIT_L(0); PG8_MMA(0, 0, At, B0); PG8_BAR; PG8_SCHED;
            PG8_LDB(B1, 0, 1); PG8_STAGE(PG8_SB(0, 0), b2, voffB);
            PG8_BAR; PG8_WAIT_L(0); PG8_MMA(0, 1, At, B1); PG8_BAR;
            PG8_LDA(At, 0, 1); PG8_STAGE(PG8_SA(0, 0), a2, voffA);
            PG8_BAR; PG8_WAIT_L(0); PG8_MMA(1, 0, At, B0); PG8_BAR; PG8_SCHED;
            PG8_STAGE(PG8_SB(0, 1), b2 + hstepB, voffB);
            PG8_WAIT_V(6); PG8_BAR; PG8_MMA(1, 1, At, B1); PG8_BAR;
            PG8_LDB(B0, 1, 0); PG8_SCHED; PG8_LDA(At, 1, 0); PG8_STAGE(PG8_SA(0, 1), a2 + hstepA, voffA);
            PG8_WAIT_L(8); PG8_BAR; PG8_WAIT_L(0); PG8_MMA(0, 0, At, B0); PG8_BAR; PG8_SCHED;
            PG8_LDB(B1, 1, 1); PG8_STAGE(PG8_SB(1, 0), b3, voffB);
            PG8_BAR; PG8_WAIT_L(0); PG8_MMA(0, 1, At, B1); PG8_BAR;
            PG8_LDA(At, 1, 1); PG8_STAGE(PG8_SA(1, 0), a3, voffA);
            PG8_BAR; PG8_WAIT_L(0); PG8_MMA(1, 0, At, B0); PG8_BAR; PG8_SCHED;
            PG8_STAGE(PG8_SB(1, 1), b3 + hstepB, voffB);
            PG8_WAIT_V(6); PG8_BAR; PG8_MMA(1, 1, At, B1); PG8_BAR;
        }
        epilogue(P, g, acc, cur, wr, wc, fr, fq);
        if (!has_next) break;
#pragma unroll
        for (int a = 0; a < 2; ++a)
#pragma unroll
            for (int b = 0; b < 2; ++b)
#pragma unroll
                for (int m = 0; m < 4; ++m)
#pragma unroll
                    for (int n = 0; n < 2; ++n) acc[a][b][m][n] = (f32x4){0.f, 0.f, 0.f, 0.f};
        cur = nxt; cA = nA; cB = nB; ++ui;
    }
    PG8_WAIT_V(0);
    if (wr == 0) PG8_BAR;
    PG8_BAR;
}

DI bool get_gemm(const Params& P, int st, GemmDesc& g) {
    unsigned char* ws_ = P.ws; asm volatile("" : "+s"(ws_));
    unsigned char* ws = ws_;
    const bf16_t* XN = (const bf16_t*)(ws + O_XN);
    const bf16_t* WMIX = (const bf16_t*)(ws + O_WMIX);
    const bf16_t* AR = (const bf16_t*)(ws + O_AR);
    g.a_gs = 0; g.b_gs = 0; g.ngrp = 1; g.nM = 64; g.K = 1024; g.lda = 1024; g.ldb = 1024; g.A = XN; g.Bt = WMIX; g.nN = 4; g.mode = E_Z;
    switch (st) {
    case 1: g.nN = 8; g.mode = E_UV; return true;
    case 4: g.A = AR + 32 * MiB; g.Bt = WMIX + 2 * MiB; return true;
    case 6: case 12: case 23: case 31: g.Bt = (const bf16_t*)(ws + O_WUP); g.nN = 16; g.mode = E_HID; return true;
    case 7: case 13: case 24: case 32: g.A = AR; g.Bt = (const bf16_t*)(ws + O_WDN); g.K = 4096; g.lda = 4096; g.ldb = 4096; return true;
    case 10: g.A = AR + 32 * MiB; g.K = 256; g.ldb = 256; g.nN = 1; g.ngrp = 4; g.a_gs = 256; g.b_gs = 65536; g.mode = E_POOL; return true;
    case 15: g.nN = 3; g.mode = E_LAT; return true;
    case 17: g.A = AR + 12 * MiB; g.Bt = WMIX + 1 * MiB; g.K = 384; g.lda = 384; g.ldb = 384; g.nN = 6; g.mode = E_Q; return true;
    case 18: g.A = AR + 18 * MiB; g.Bt = WMIX + 2 * MiB; g.K = 256; g.lda = 256; g.ldb = 256; g.nN = 4; g.mode = E_KN; return true;
    case 19: g.A = WMIX + (5 * MiB) / 2; g.Bt = AR + 18 * MiB; g.K = 256; g.lda = 256; g.ldb = 256; g.nM = 4; g.nN = 64; g.mode = E_VT; return true;
    case 21: g.Bt = WMIX + 3 * MiB; return true;
    case 26: g.A = AR; g.Bt = AR + 40 * MiB; g.K = 512; g.lda = 640; g.ldb = 512; g.nM = 2; g.nN = 1; g.ngrp = 64; g.a_gs = 512 * 640; g.b_gs = 256 * 512; g.mode = E_XE; return true;
    case 28: g.A = AR; g.Bt = AR + 20 * MiB; g.K = 640; g.lda = 640; g.ldb = 640; g.nM = 2; g.nN = 2; g.ngrp = 64; g.a_gs = 512 * 640; g.b_gs = 512 * 640; g.mode = E_S5Y; return true;
    case 29: g.A = AR + 56 * MiB; g.nN = 8; g.mode = E_GLU; return true;
    default: return false;
    }
}

enum { RP_BF = 0, RP_F32 = 1, RP_S5 = 2, RP_FINAL = 3 };
template <int MODE>
DI void row_pass(const float* hin, float* hout, const bf16_t* z, const float* gpost, const float* gpre, void* outp, int gw, int NGW, int lane) {
    asm volatile("" : "+v"(lane));
    for (int rowa = gw; rowa < S; rowa += 2 * NGW) {
        f32x4 h[2][4];
#pragma unroll
        for (int q = 0; q < 2; ++q) { const int row = rowa + q * NGW;
#pragma unroll
            for (int j = 0; j < 4; ++j) { const int cb = (MODE == RP_S5) ? 16 * lane + 4 * j : 4 * lane + 256 * j; h[q][j] = *(const GAS f32x4*)(hin + (size_t)row * 1024 + cb); } }
        if (z) {
            f32x4 zz[2][4]; float ss[2] = {0.f, 0.f};
#pragma unroll
            for (int q = 0; q < 2; ++q) { const int row = rowa + q * NGW;
#pragma unroll
                for (int j = 0; j < 4; ++j) { const int cb = (MODE == RP_S5) ? 16 * lane + 4 * j : 4 * lane + 256 * j; const u32x2 w = *(const GAS u32x2*)(z + (size_t)row * 1024 + cb);
                    zz[q][j] = (f32x4){bflo(w.x), bfhi(w.x), bflo(w.y), bfhi(w.y)}; ss[q] += zz[q][j][0] * zz[q][j][0] + zz[q][j][1] * zz[q][j][1] + zz[q][j][2] * zz[q][j][2] + zz[q][j][3] * zz[q][j][3]; } }
#pragma unroll
            for (int q = 0; q < 2; ++q) { const int row = rowa + q * NGW;
                const float rz = rsqrtf(wave_sum(ss[q], lane) * (1.f / 1024.f) + RMS_EPS);
#pragma unroll
                for (int j = 0; j < 4; ++j) { const int cb = (MODE == RP_S5) ? 16 * lane + 4 * j : 4 * lane + 256 * j; const f32x4 gp = *(const GAS f32x4*)(gpost + cb); h[q][j] += zz[q][j] * rz * gp;
                    *(GAS f32x4*)(hout + (size_t)row * 1024 + cb) = h[q][j]; } }
        }
        if (MODE != RP_FINAL) {
#pragma unroll
            for (int q = 0; q < 2; ++q) { const int row = rowa + q * NGW;
                float s2 = 0.f;
#pragma unroll
                for (int j = 0; j < 4; ++j) s2 += h[q][j][0] * h[q][j][0] + h[q][j][1] * h[q][j][1] + h[q][j][2] * h[q][j][2] + h[q][j][3] * h[q][j][3];
                const float rn = rsqrtf(wave_sum(s2, lane) * (1.f / 1024.f) + RMS_EPS);
#pragma unroll
                for (int j = 0; j < 4; ++j) { const int cb = (MODE == RP_S5) ? 16 * lane + 4 * j : 4 * lane + 256 * j; const f32x4 gq = *(const GAS f32x4*)(gpre + cb); const f32x4 xn = h[q][j] * rn * gq;
                    if (MODE == RP_BF) store_bf4((bf16_t*)outp + (size_t)row * 1024 + cb, xn);
                    if (MODE == RP_F32) *(GAS f32x4*)((float*)outp + (size_t)row * 1024 + cb) = xn;
                    if (MODE == RP_S5) store_bf4((bf16_t*)outp + ((size_t)(lane * 512 + (row >> 5))) * 640 + (row & 31) * 16 + 4 * j, xn); } }
        }
    }
}

enum { MAP_ID = 0, MAP_UQ = 1, MAP_GLUA = 2, MAP_GLUB = 3 };
DI int dstrow(int mode, int n) {
    if (mode == MAP_UQ) { const int hd = n / 192, w = n - hd * 192; if (w < 128) return n; const int r = w - 128; return hd * 192 + 128 + 2 * (r & 31) + (r >> 5); }
    if (mode == MAP_GLUA) return (n >> 7) * 256 + (n & 127);
    if (mode == MAP_GLUB) return (n >> 7) * 256 + 128 + (n & 127);
    return n;
}
DI void convT(const float* src, int K, int N, bf16_t* dst, int ldT, int mapmode, int gw, int NGW, int lane) {
    asm volatile("" : "+v"(lane));
    const int nnb = N >> 4, nitems = nnb * (K >> 5);
    for (int it = gw; it < nitems; it += NGW) {
        const int kb = it / nnb, nb = it - kb * nnb;
        const int n = nb * 16 + (lane >> 2), k = kb * 32 + 8 * (lane & 3);
        const float* s = src + (size_t)k * N + n;
        float v[8];
#pragma unroll
        for (int i = 0; i < 8; ++i) v[i] = ((const GAS float*)s)[(size_t)i * N];
        u32x4 o; o.x = pk_bf16(v[0], v[1]); o.y = pk_bf16(v[2], v[3]); o.z = pk_bf16(v[4], v[5]); o.w = pk_bf16(v[6], v[7]);
        *(GAS u32x4*)(dst + (size_t)dstrow(mapmode, n) * ldT + k) = o;
    }
}
DI void conv_layer(const Params& P, int L, int gw, int NGW, int lane) {
    unsigned char* ws_ = P.ws; asm volatile("" : "+s"(ws_));
    unsigned char* ws = ws_;
    bf16_t* WMIX = (bf16_t*)(ws + O_WMIX);
    convT(P.in[3] + (size_t)L * 1024 * 4096, 1024, 4096, (bf16_t*)(ws + O_WUP), 1024, MAP_ID, gw, NGW, lane);
    convT(P.in[4] + (size_t)L * 1024 * 4096, 4096, 1024, (bf16_t*)(ws + O_WDN), 4096, MAP_ID, gw, NGW, lane);
    if (L == 0) {
        convT(P.in[5], 1024, 2048, WMIX, 1024, MAP_ID, gw, NGW, lane);
        convT(P.in[11], 1024, 1024, WMIX + 2 * MiB, 1024, MAP_ID, gw, NGW, lane);
        const float* wsrc = P.in[9]; bf16_t* wd = WMIX + 3 * MiB;
        for (int e = gw * 64 + lane; e < 8 * 128 * 128 / 4; e += NGW * 64) { const int s0 = (e * 4) & 127, t = ((e * 4) >> 7) & 127; f32x4 w = *(const f32x4*)(wsrc + (size_t)e * 4);
#pragma unroll
            for (int j = 0; j < 4; ++j) if (s0 + j > t) w[j] = 0.f;
            store_bf4(wd + (size_t)e * 4, w); }
    } else if (L == 1) {
        for (int gg = 0; gg < 4; ++gg) convT(P.in[12] + gg * 65536, 256, 256, WMIX + gg * 65536, 256, MAP_ID, gw, NGW, lane);
    } else if (L == 2) {
        convT(P.in[14], 1024, 384, WMIX, 1024, MAP_ID, gw, NGW, lane);
        convT(P.in[17], 1024, 320, WMIX + 384 * 1024, 1024, MAP_ID, gw, NGW, lane);
        convT(P.in[16], 384, 1536, WMIX + 1 * MiB, 384, MAP_UQ, gw, NGW, lane);
        convT(P.in[19], 256, 1024, WMIX + 2 * MiB, 256, MAP_ID, gw, NGW, lane);
        convT(P.in[20], 256, 1024, WMIX + (5 * MiB) / 2, 256, MAP_ID, gw, NGW, lane);
        convT(P.in[21], 1024, 1024, WMIX + 3 * MiB, 1024, MAP_ID, gw, NGW, lane);
    } else {
        convT(P.in[30], 1024, 1024, WMIX, 1024, MAP_GLUA, gw, NGW, lane);
        convT(P.in[31], 1024, 1024, WMIX, 1024, MAP_GLUB, gw, NGW, lane);
    }
}

DI void lnv_phase(const Params& P, int gw, int NGW, int lane) {
    unsigned char* ws_ = P.ws; asm volatile("" : "+s"(ws_));
    asm volatile("" : "+v"(lane));
    bf16_t* V = (bf16_t*)(ws_ + O_AR + 32 * MiB);
    const float* gv = P.in[7]; const float* bv = P.in[8];
    for (int row = gw; row < S; row += NGW) {
        f32x4 x[4]; float s = 0.f;
#pragma unroll
        for (int j = 0; j < 4; ++j) { const u32x2 w = *(const u32x2*)(V + (size_t)row * 1024 + 4 * lane + 256 * j); x[j] = (f32x4){bflo(w.x), bfhi(w.x), bflo(w.y), bfhi(w.y)}; s += x[j][0] + x[j][1] + x[j][2] + x[j][3]; }
        const float mu = wave_sum(s, lane) * (1.f / 1024.f); float s2 = 0.f;
#pragma unroll
        for (int j = 0; j < 4; ++j) { x[j] = x[j] - mu; s2 += x[j][0] * x[j][0] + x[j][1] * x[j][1] + x[j][2] * x[j][2] + x[j][3] * x[j][3]; }
        const float rs = rsqrtf(wave_sum(s2, lane) * (1.f / 1024.f) + RMS_EPS);
#pragma unroll
        for (int j = 0; j < 4; ++j) { const int cb = 4 * lane + 256 * j; const f32x4 g4 = *(const f32x4*)(gv + cb), b4 = *(const f32x4*)(bv + cb); store_bf4(V + (size_t)row * 1024 + cb, x[j] * rs * g4 + b4); }
    }
}

DI void gate_phase(const Params& P, LAS unsigned char* lds, int tid, int wid, int lane, int bid) {
    unsigned char* ws_ = P.ws; asm volatile("" : "+s"(ws_));
    asm volatile("" : "+v"(tid)); lane = tid & 63; wid = __builtin_amdgcn_readfirstlane(tid >> 6);
    LAS bf16_t* Wt = (LAS bf16_t*)lds;
    LAS bf16_t* Vt = Wt + 128 * 136;
    const bf16_t* Wsb = (const bf16_t*)(ws_ + O_WMIX + 6 * MiB);
    const bf16_t* U = (const bf16_t*)(ws_ + O_AR);
    const bf16_t* V = (const bf16_t*)(ws_ + O_AR + 32 * MiB);
    bf16_t* Y = (bf16_t*)(ws_ + O_AR + 64 * MiB);
    const float* bs = P.in[10]; const float* gv = P.in[7]; const float* bv = P.in[8]; const float* STAT = (const float*)(ws_ + O_AR + 96 * MiB);
    LAS float* mus = (LAS float*)(lds + 69632); LAS float* rss = mus + 128;
    const int r16 = lane & 15, quad = lane >> 4;
    for (int item = bid; item < 1024; item += gridDim.x) {
        const int hd = item & 7, c = item >> 3;
        __syncthreads();
        if (tid < 128) { const GAS f32x4* pp = (const GAS f32x4*)(STAT + (size_t)(c * 128 + tid) * 32); float a1 = 0.f, a2 = 0.f;
#pragma unroll
            for (int i = 0; i < 8; ++i) { const f32x4 t4 = pp[i]; a1 += t4[0] + t4[2]; a2 += t4[1] + t4[3]; }
            const float mu = a1 * (1.f / 1024.f); mus[tid] = mu; rss[tid] = rsqrtf(fmaxf(a2 * (1.f / 1024.f) - mu * mu, 0.f) + RMS_EPS); }
#pragma unroll
        for (int i = 0; i < 4; ++i) { const int cid = tid + 512 * i, t = cid >> 4, sc = cid & 15;
            const u32x4 w = *(const GAS u32x4*)(Wsb + ((size_t)(hd * 128 + t)) * 128 + 8 * sc); *(LAS u32x4*)(Wt + t * 136 + 8 * sc) = w; }
        __syncthreads();
#pragma unroll
        for (int i = 0; i < 4; ++i) { const int cid = tid + 512 * i, s = cid >> 4, dc = cid & 15;
            const int grow = c * 128 + s, gcol = hd * 128 + 8 * dc;
            const u32x4 w = *(const GAS u32x4*)(V + (size_t)grow * 1024 + gcol);
            const float mu = mus[s], rs = rss[s];
            const f32x4 g0 = *(const GAS f32x4*)(gv + gcol), g1 = *(const GAS f32x4*)(gv + gcol + 4), b0 = *(const GAS f32x4*)(bv + gcol), b1 = *(const GAS f32x4*)(bv + gcol + 4);
            float y[8];
#pragma unroll
            for (int e = 0; e < 8; ++e) { const float x = (e & 1) ? bfhi(w[e >> 1]) : bflo(w[e >> 1]); y[e] = (x - mu) * rs * ((e < 4) ? g0[e & 3] : g1[e & 3]) + ((e < 4) ? b0[e & 3] : b1[e & 3]); }
#pragma unroll
            for (int e = 0; e < 8; ++e) Vt[(8 * dc + e) * 136 + s] = f2bf(y[e]); }
        __syncthreads();
        const int t = 16 * wid + r16;
        const int nks = (16 * wid + 15) / 32 + 1;
        bf16x8 bw[4];
#pragma unroll
        for (int ks = 0; ks < 4; ++ks) bw[ks] = *(const LAS bf16x8*)(Wt + t * 136 + 32 * ks + 8 * quad);
        const int token = c * 128 + t;
        const float bias = bs[hd * 128 + t];
#pragma unroll
        for (int dt = 0; dt < 8; ++dt) {
            f32x4 acc = {0.f, 0.f, 0.f, 0.f};
#pragma unroll
            for (int ks = 0; ks < 4; ++ks) if (ks < nks) {
                const bf16x8 a = *(const LAS bf16x8*)(Vt + (16 * dt + r16) * 136 + 32 * ks + 8 * quad);
                acc = __builtin_amdgcn_mfma_f32_16x16x32_bf16(a, bw[ks], acc, 0, 0, 0); }
            const int col = hd * 128 + 16 * dt + 4 * quad;
            const u32x2 uu = *(const GAS u32x2*)(U + (size_t)token * 1024 + col);
            f32x4 y; y[0] = (acc[0] + bias) * bflo(uu.x); y[1] = (acc[1] + bias) * bfhi(uu.x); y[2] = (acc[2] + bias) * bflo(uu.y); y[3] = (acc[3] + bias) * bfhi(uu.y);
            store_bf4(Y + (size_t)token * 1024 + col, y);
        }
    }
}

DI void pool_phase(const Params& P, int gtid, int nthreads) {
    unsigned char* ws_ = P.ws; asm volatile("" : "+s"(ws_));
    asm volatile("" : "+v"(gtid));
    const float* ZF = (const float*)(ws_ + O_AR);
    bf16_t* Pb = (bf16_t*)(ws_ + O_AR + 64 * MiB);
    for (int e = gtid; e < 1024 * 256; e += nthreads) {
        const int cgi = e & 255, tb = e >> 8, col = 4 * cgi, w = 2 << (cgi >> 6), t0 = 16 * tb;
        f32x4 W = {0.f, 0.f, 0.f, 0.f};
        for (int j = 1; j < w; ++j) if (t0 - j >= 0) W += *(const GAS f32x4*)(ZF + (size_t)(t0 - j) * 1024 + col);
        for (int i = 0; i < 16; ++i) { const int t = t0 + i; const f32x4 z = *(const GAS f32x4*)(ZF + (size_t)t * 1024 + col); W += z;
            const float cnt = (float)((t + 1 < w) ? (t + 1) : w); const f32x4 o = W / cnt - z; store_bf4(Pb + (size_t)t * 1024 + col, o);
            if (t - w + 1 >= 0) W -= *(const GAS f32x4*)(ZF + (size_t)(t - w + 1) * 1024 + col); }
    }
}

DI void mla_rows(const Params& P, int gw, int NGW, int lane) {
    unsigned char* ws_ = P.ws; asm volatile("" : "+s"(ws_));
    asm volatile("" : "+v"(lane));
    unsigned char* ar = ws_ + O_AR;
    const bf16_t* LAT = (const bf16_t*)ar; bf16_t* QL = (bf16_t*)(ar + 24 * MiB); bf16_t* Cb = (bf16_t*)(ar + 36 * MiB); bf16_t* KR = (bf16_t*)(ar + 44 * MiB);
    const float* CS = (const float*)(ws_ + O_CS); const float* gq = P.in[15]; const float* gkv = P.in[18];
    for (int row = gw; row < S; row += NGW) {
        const bf16_t* lat = LAT + (size_t)row * 768;
        float q[6]; float ss = 0.f;
#pragma unroll
        for (int i = 0; i < 3; ++i) { const unsigned w = *(const GAS unsigned*)(lat + 2 * lane + 128 * i); q[2 * i] = bflo(w); q[2 * i + 1] = bfhi(w); ss += q[2 * i] * q[2 * i] + q[2 * i + 1] * q[2 * i + 1]; }
        ss = wave_sum(ss, lane); const float rq = rsqrtf(ss * (1.f / 384.f) + RMS_EPS);
#pragma unroll
        for (int i = 0; i < 3; ++i) { const f32x2 g2 = *(const f32x2*)(gq + 2 * lane + 128 * i); *(GAS unsigned*)(QL + (size_t)row * 384 + 2 * lane + 128 * i) = pk_bf16(q[2 * i] * rq * g2.x, q[2 * i + 1] * rq * g2.y); }
        float cc[4]; float s2 = 0.f;
#pragma unroll
        for (int i = 0; i < 2; ++i) { const unsigned w = *(const GAS unsigned*)(lat + 384 + 2 * lane + 128 * i); cc[2 * i] = bflo(w); cc[2 * i + 1] = bfhi(w); s2 += cc[2 * i] * cc[2 * i] + cc[2 * i + 1] * cc[2 * i + 1]; }
        s2 = wave_sum(s2, lane); const float rc = rsqrtf(s2 * (1.f / 256.f) + RMS_EPS);
#pragma unroll
        for (int i = 0; i < 2; ++i) { const f32x2 g2 = *(const f32x2*)(gkv + 2 * lane + 128 * i); *(GAS unsigned*)(Cb + (size_t)row * 256 + 2 * lane + 128 * i) = pk_bf16(cc[2 * i] * rc * g2.x, cc[2 * i + 1] * rc * g2.y); }
        if (lane < 32) { const float x1 = bf2f(lat[640 + lane]), x2 = bf2f(lat[672 + lane]); const f32x2 cs = *(const f32x2*)(CS + ((size_t)row * 32 + lane) * 2);
            *(GAS unsigned*)(KR + (size_t)row * 64 + 2 * lane) = pk_bf16(x1 * cs.x - x2 * cs.y, x1 * cs.y + x2 * cs.x); }
    }
}

#define MFMA32(a, b, c) __builtin_amdgcn_mfma_f32_32x32x16_bf16((a), (b), (c), 0, 0, 0)
DI int crow(int reg, int h) { return (reg & 3) + 8 * (reg >> 2) + 4 * h; }

DI void attn_phase(const Params& P, LAS unsigned char* lds, int tid, int wid, int lane, int bid) {
    unsigned char* ws_ = P.ws; asm volatile("" : "+s"(ws_));
    asm volatile("" : "+v"(tid)); lane = tid & 63; wid = __builtin_amdgcn_readfirstlane(tid >> 6);
    unsigned char* ar = ws_ + O_AR;
    const bf16_t* Q = (const bf16_t*)(ar + 48 * MiB); const bf16_t* KN = (const bf16_t*)(ar + 96 * MiB); const bf16_t* VT = (const bf16_t*)(ar + 128 * MiB); const bf16_t* KR = (const bf16_t*)(ar + 44 * MiB);
    bf16_t* AO = (bf16_t*)(ws_ + O_XN);
    const int l32 = lane & 31, h2 = lane >> 5;
    constexpr int BUFB = 43008, VOFF = 25600;
    const unsigned kn_off0 = (unsigned)(((tid >> 4) * 1024 + 8 * (tid & 15)) * 2);
    const unsigned kr_off = (unsigned)(((tid >> 3) * 64 + 8 * (tid & 7)) * 2);
    const unsigned vt_off0 = (unsigned)(((tid >> 3) * 16384 + 8 * (tid & 7)) * 2);
    const unsigned kn_l0 = (unsigned)((tid >> 4) * 400 + 16 * (tid & 15));
    const unsigned kr_l = (unsigned)((tid >> 3) * 400 + 256 + 16 * (tid & 7));
    const unsigned vt_l0 = (unsigned)(25600 + (tid >> 3) * 136 + 16 * (tid & 7));
    for (int item = bid; item < 256; item += gridDim.x) {
        const int head = item & 7, pair = item >> 3;
        for (int half = 0; half < 2; ++half) {
            const int qb = half ? 63 - pair : pair;
            const int wrow0 = qb * 256 + wid * 32, qrow = wrow0 + l32;
            bf16x8 Qf[12];
#pragma unroll
            for (int s = 0; s < 12; ++s) Qf[s] = *(const GAS bf16x8*)(Q + (size_t)qrow * 1536 + head * 192 + 16 * s + 8 * h2);
            f32x16 o[4];
#pragma unroll
            for (int d = 0; d < 4; ++d)
#pragma unroll
                for (int r = 0; r < 16; ++r) o[d][r] = 0.f;
            float mrun = -INFINITY, lsum = 0.f;
            const int ntiles = 4 * (qb + 1);
            u32x4 kreg[3], vreg[2];
#define ATT_ISSUE(kt) do { \
    unsigned o0_ = kn_off0, o1_ = kr_off, o2_ = vt_off0; asm volatile("" : "+v"(o0_), "+v"(o1_), "+v"(o2_)); \
    const char* knb = (const char*)(KN + (size_t)(kt) * 65536 + head * 128); const char* krb = (const char*)(KR + (size_t)(kt) * 4096); \
    const char* vtb = (const char*)(VT + (size_t)head * 128 * 16384 + 64 * (kt)); \
    kreg[0] = *(const GAS u32x4*)(knb + o0_); kreg[1] = *(const GAS u32x4*)(knb + 65536 + o0_); kreg[2] = *(const GAS u32x4*)(krb + o1_); \
    vreg[0] = *(const GAS u32x4*)(vtb + o2_); vreg[1] = *(const GAS u32x4*)(vtb + 2097152 + o2_); } while (0)
#define ATT_WRITE(b) do { LAS unsigned char* base = lds + (b) * BUFB; \
    *(LAS u32x4*)(base + kn_l0) = kreg[0]; *(LAS u32x4*)(base + kn_l0 + 12800) = kreg[1]; *(LAS u32x4*)(base + kr_l) = kreg[2]; \
    *(LAS u32x2*)(base + vt_l0) = (u32x2){vreg[0].x, vreg[0].y}; *(LAS u32x2*)(base + vt_l0 + 8) = (u32x2){vreg[0].z, vreg[0].w}; \
    *(LAS u32x2*)(base + vt_l0 + 8704) = (u32x2){vreg[1].x, vreg[1].y}; *(LAS u32x2*)(base + vt_l0 + 8712) = (u32x2){vreg[1].z, vreg[1].w}; } while (0)
            ATT_ISSUE(0); ATT_WRITE(0); __syncthreads();
            for (int kt = 0; kt < ntiles; ++kt) {
                const bool more = (kt + 1 < ntiles);
                if (more) ATT_ISSUE(kt + 1);
                if (64 * kt <= wrow0 + 31) {
                    LAS unsigned char* base = lds + (kt & 1) * BUFB;
                    f32x16 st0, st1;
#pragma unroll
                    for (int r = 0; r < 16; ++r) { st0[r] = 0.f; st1[r] = 0.f; }
                    {
                        const LAS unsigned char* kp = base + l32 * 400 + 16 * h2;
                        bf16x8 ka[2][4];
#define ATT_LDK(bf, gq) do { _Pragma("unroll") for (int sl = 0; sl < 2; ++sl) { ka[bf][2 * sl] = *(const LAS bf16x8*)(kp + 32 * (2 * (gq) + sl)); ka[bf][2 * sl + 1] = *(const LAS bf16x8*)(kp + 12800 + 32 * (2 * (gq) + sl)); } } while (0)
#define ATT_MMK(bf, gq) do { _Pragma("unroll") for (int sl = 0; sl < 2; ++sl) { st0 = MFMA32(ka[bf][2 * sl], Qf[2 * (gq) + sl], st0); st1 = MFMA32(ka[bf][2 * sl + 1], Qf[2 * (gq) + sl], st1); } } while (0)
                        ATT_LDK(0, 0); __builtin_amdgcn_sched_barrier(0);
                        ATT_LDK(1, 1); __builtin_amdgcn_sched_barrier(0);
                        ATT_MMK(0, 0); __builtin_amdgcn_sched_barrier(0);
                        ATT_LDK(0, 2); __builtin_amdgcn_sched_barrier(0);
                        ATT_MMK(1, 1); __builtin_amdgcn_sched_barrier(0);
                        ATT_LDK(1, 3); __builtin_amdgcn_sched_barrier(0);
                        ATT_MMK(0, 2); __builtin_amdgcn_sched_barrier(0);
                        ATT_LDK(0, 4); __builtin_amdgcn_sched_barrier(0);
                        ATT_MMK(1, 3); __builtin_amdgcn_sched_barrier(0);
                        ATT_LDK(1, 5); __builtin_amdgcn_sched_barrier(0);
                        ATT_MMK(0, 4); __builtin_amdgcn_sched_barrier(0);
                        ATT_MMK(1, 5); __builtin_amdgcn_sched_barrier(0);
#undef ATT_LDK
#undef ATT_MMK
                    }
                    if (64 * kt + 63 > wrow0) {
#pragma unroll
                        for (int r = 0; r < 16; ++r) { const int key0 = 64 * kt + crow(r, h2); if (key0 > qrow) st0[r] = -INFINITY; if (key0 + 32 > qrow) st1[r] = -INFINITY; }
                    }
                    float mx = st0[0];
#pragma unroll
                    for (int r = 1; r < 16; ++r) mx = fmaxf(mx, st0[r]);
#pragma unroll
                    for (int r = 0; r < 16; ++r) mx = fmaxf(mx, st1[r]);
                    mx = fmaxf(mx, shx(mx, 32, lane));
                    const float mn = fmaxf(mrun, mx);
                    const float alpha = __builtin_amdgcn_exp2f(mrun - mn);
                    mrun = mn;
                    float psum = 0.f;
#pragma unroll
                    for (int r = 0; r < 16; ++r) { st0[r] = __builtin_amdgcn_exp2f(st0[r] - mn); st1[r] = __builtin_amdgcn_exp2f(st1[r] - mn); psum += st0[r] + st1[r]; }
                    lsum = lsum * alpha + psum;
                    if (__builtin_amdgcn_ballot_w64(alpha != 1.f) != 0ull) {
#pragma unroll
                        for (int d = 0; d < 4; ++d)
#pragma unroll
                            for (int r = 0; r < 16; ++r) o[d][r] *= alpha;
                    }
                    {
                        const LAS unsigned char* vb = base + VOFF + l32 * 136 + 8 * h2;
                        u32x4 va[2][4];
#define ATT_LDV(bf, stp) do { _Pragma("unroll") for (int d = 0; d < 4; ++d) { const LAS unsigned char* vp = vb + d * 4352 + 32 * (stp); \
        const u32x2 lo = *(const LAS u32x2*)vp, hi = *(const LAS u32x2*)(vp + 16); va[bf][d] = (u32x4){lo.x, lo.y, hi.x, hi.y}; } } while (0)
#define ATT_MMV(bf, stv, sp) do { u32x4 pw; pw.x = pk_bf16(stv[8 * (sp)], stv[8 * (sp) + 1]); pw.y = pk_bf16(stv[8 * (sp) + 2], stv[8 * (sp) + 3]); pw.z = pk_bf16(stv[8 * (sp) + 4], stv[8 * (sp) + 5]); pw.w = pk_bf16(stv[8 * (sp) + 6], stv[8 * (sp) + 7]); \
        const bf16x8 pf = __builtin_bit_cast(bf16x8, pw); _Pragma("unroll") for (int d = 0; d < 4; ++d) o[d] = MFMA32(__builtin_bit_cast(bf16x8, va[bf][d]), pf, o[d]); } while (0)
                        ATT_LDV(0, 0); __builtin_amdgcn_sched_barrier(0);
                        ATT_LDV(1, 1); __builtin_amdgcn_sched_barrier(0);
                        ATT_MMV(0, st0, 0); __builtin_amdgcn_sched_barrier(0);
                        ATT_LDV(0, 2); __builtin_amdgcn_sched_barrier(0);
                        ATT_MMV(1, st0, 1); __builtin_amdgcn_sched_barrier(0);
                        ATT_LDV(1, 3); __builtin_amdgcn_sched_barrier(0);
                        ATT_MMV(0, st1, 0); __builtin_amdgcn_sched_barrier(0);
                        ATT_MMV(1, st1, 1); __builtin_amdgcn_sched_barrier(0);
#undef ATT_LDV
#undef ATT_MMV
                    }
                }
                if (more) ATT_WRITE((kt + 1) & 1);
                __syncthreads();
            }
            int t2_ = tid; asm volatile("" : "+v"(t2_));
            const int qrow2 = qb * 256 + (t2_ >> 6) * 32 + (t2_ & 31), h2b = (t2_ >> 5) & 1;
            const float ltot = lsum + shx(lsum, 32, lane);
            const float inv = 1.f / ltot;
#pragma unroll
            for (int d = 0; d < 4; ++d)
#pragma unroll
                for (int rg = 0; rg < 4; ++rg) { f32x4 v = {o[d][4 * rg] * inv, o[d][4 * rg + 1] * inv, o[d][4 * rg + 2] * inv, o[d][4 * rg + 3] * inv};
                    store_bf4(AO + (size_t)qrow2 * 1024 + head * 128 + d * 32 + 8 * rg + 4 * h2b, v); }
        }
    }
#undef ATT_ISSUE
#undef ATT_WRITE
}

DI void s5_precompute(const Params& P, LAS unsigned char* lds, int tid, int bid) {
    unsigned char* ws_ = P.ws; asm volatile("" : "+s"(ws_));
    asm volatile("" : "+v"(tid));
    LAS float* PWr = (LAS float*)lds;
    LAS float* PWi = PWr + 33 * 64;
    LAS float* BBr = PWi + 33 * 64;
    LAS float* BBi = BBr + 1024;
    LAS float* CRe = BBi + 1024;
    LAS float* CIm = CRe + 1024;
    LAS float* KT = CIm + 1024;
    const float* lam_re = P.in[22]; const float* lam_im = P.in[23]; const float* log_dt = P.in[24];
    const float* b_re = P.in[25]; const float* b_im = P.in[26]; const float* c_re = P.in[27]; const float* c_im = P.in[28]; const float* dsk = P.in[29];
    bf16_t* TF = (bf16_t*)(ws_ + O_AR + 40 * MiB); bf16_t* Eb = (bf16_t*)(ws_ + O_AR + 80 * MiB);
    for (int item = bid; item < 256; item += gridDim.x) {
        const int g = item >> 2, q = item & 3;
        __syncthreads();
        const float dt = expf(log_dt[g]);
        for (int e = tid; e < 33 * 64; e += 512) { const int j = e >> 6, p = e & 63; const float lr = lam_re[g * 64 + p], li = lam_im[g * 64 + p];
            const float mag = expf((float)j * (lr * dt)); float sn, cs; sincosf((float)j * (li * dt), &sn, &cs); PWr[e] = mag * cs; PWi[e] = mag * sn; }
        for (int e = tid; e < 1024; e += 512) { const int p = e >> 4; const float lr = lam_re[g * 64 + p], li = lam_im[g * 64 + p];
            const float mag = expf(lr * dt); float sn, cs; sincosf(li * dt, &sn, &cs); const float ar = mag * cs, ai = mag * sn;
            const float den = lr * lr + li * li; const float fre = ((ar - 1.f) * lr + ai * li) / den, fim = (ai * lr - (ar - 1.f) * li) / den;
            const float br = b_re[(size_t)g * 1024 + e], bi = b_im[(size_t)g * 1024 + e];
            BBr[e] = fre * br - fim * bi; BBi[e] = fre * bi + fim * br; }
        for (int e = tid; e < 1024; e += 512) { CRe[e] = c_re[(size_t)g * 1024 + e]; CIm[e] = c_im[(size_t)g * 1024 + e]; }
        __syncthreads();
        {
            const int pr_ = tid & 255, co = pr_ >> 4, ci = pr_ & 15, j0 = (tid >> 8) * 16;
            float a[16];
#pragma unroll
            for (int jj = 0; jj < 16; ++jj) a[jj] = 0.f;
            for (int p = 0; p < 64; ++p) {
                const float cr = CRe[co * 64 + p], cm = CIm[co * 64 + p], br = BBr[p * 16 + ci], bi = BBi[p * 16 + ci];
                const float xr = cr * br - cm * bi, xi = cr * bi + cm * br;
#pragma unroll
                for (int jj = 0; jj < 16; ++jj) a[jj] += xr * PWr[(j0 + jj) * 64 + p] - xi * PWi[(j0 + jj) * 64 + p];
            }
            if (j0 == 0 && co == ci) a[0] += dsk[g * 16 + co];
#pragma unroll
            for (int jj = 0; jj < 16; ++jj) KT[((j0 + jj) * 16 + co) * 16 + ci] = a[jj];
        }
        __syncthreads();
        for (int e = tid; e < 128 * 80; e += 512) { const int rr = e / 80, kc = e - rr * 80, n = 128 * q + rr, l = n >> 4, co = n & 15; float v[8];
            if (kc < 64) { const int lp = kc >> 1;
#pragma unroll
                for (int i = 0; i < 8; ++i) v[i] = (lp <= l) ? KT[((l - lp) * 16 + co) * 16 + 8 * (kc & 1) + i] : 0.f;
            } else {
                const bool im = kc >= 72; const int p0 = 8 * (kc - (im ? 72 : 64));
#pragma unroll
                for (int i = 0; i < 8; ++i) { const int p = p0 + i; const float cr = CRe[co * 64 + p], cm = CIm[co * 64 + p], pr = PWr[(l + 1) * 64 + p], pi = PWi[(l + 1) * 64 + p];
                    v[i] = im ? -(cr * pi + cm * pr) : (cr * pr - cm * pi); }
            }
            u32x4 o; o.x = pk_bf16(v[0], v[1]); o.y = pk_bf16(v[2], v[3]); o.z = pk_bf16(v[4], v[5]); o.w = pk_bf16(v[6], v[7]);
            *(GAS u32x4*)(TF + ((size_t)(g * 512 + n)) * 640 + 8 * kc) = o; }
        for (int e = tid; e < 32 * 64; e += 512) { const int n = 32 * q + (e >> 6), kc = e & 63, p = n & 63, im = n >> 6, lp = kc >> 1; float v[8];
            const float pr = PWr[(31 - lp) * 64 + p], pi = PWi[(31 - lp) * 64 + p];
#pragma unroll
            for (int i = 0; i < 8; ++i) { const int ci = 8 * (kc & 1) + i; const float br = BBr[p * 16 + ci], bi = BBi[p * 16 + ci]; v[i] = im ? (pr * bi + pi * br) : (pr * br - pi * bi); }
            u32x4 o; o.x = pk_bf16(v[0], v[1]); o.y = pk_bf16(v[2], v[3]); o.z = pk_bf16(v[4], v[5]); o.w = pk_bf16(v[6], v[7]);
            *(GAS u32x4*)(Eb + ((size_t)(g * 256 + n)) * 512 + 8 * kc) = o; }
    }
}

DI void s5_scan(const Params& P, int wid, int lane, int bid) {
    unsigned char* ws_ = P.ws; asm volatile("" : "+s"(ws_));
    asm volatile("" : "+v"(lane));
    if (wid != 0) return;
    const float* lam_re = P.in[22]; const float* lam_im = P.in[23]; const float* log_dt = P.in[24];
    const float* XE = (const float*)(ws_ + O_AR + 96 * MiB); bf16_t* UG = (bf16_t*)(ws_ + O_AR);
    for (int g = bid; g < 64; g += gridDim.x) {
        const int p = lane; const float dt = expf(log_dt[g]); const float lr = lam_re[g * 64 + p], li = lam_im[g * 64 + p];
        const float mag = expf(32.f * (lr * dt)); float sn, cs; sincosf(32.f * (li * dt), &sn, &cs); const float ar = mag * cs, ai = mag * sn;
        float cr = 0.f, ci = 0.f;
        const float* xe = XE + (size_t)g * 512 * 128; bf16_t* ug = UG + (size_t)g * 512 * 640;
        for (int c0 = 0; c0 < 512; c0 += 16) {
            float xr[16], xi[16];
#pragma unroll
            for (int i = 0; i < 16; ++i) { xr[i] = ((const GAS float*)xe)[(size_t)(c0 + i) * 128 + p]; xi[i] = ((const GAS float*)xe)[(size_t)(c0 + i) * 128 + 64 + p]; }
#pragma unroll
            for (int i = 0; i < 16; ++i) { ((GAS bf16_t*)ug)[(size_t)(c0 + i) * 640 + 512 + p] = f2bf(cr); ((GAS bf16_t*)ug)[(size_t)(c0 + i) * 640 + 576 + p] = f2bf(ci);
                const float nr = ar * cr - ai * ci + xr[i], ni = ar * ci + ai * cr + xi[i]; cr = nr; ci = ni; }
        }
    }
}

DI void cs_table(const Params& P, int gtid, int nthreads) {
    unsigned char* ws_ = P.ws; asm volatile("" : "+s"(ws_));
    asm volatile("" : "+v"(gtid));
    const int* pos = (const int*)P.in[1]; float* CS = (float*)(ws_ + O_CS);
    for (int e = gtid; e < S * 32; e += nthreads) { const int row = e >> 5, j = e & 31;
        const float invf = exp2f(-(float)j * (13.287712379549449f / 32.f)); const float ang = (float)pos[row] * invf; float sn, cs; sincosf(ang, &sn, &cs);
        *(GAS f32x2*)(CS + (size_t)e * 2) = (f32x2){cs, sn}; }
}


#define XB_TMO      128
#define XB_XCNT(j)  (256  + 64 * (j))
#define XB_XSUB(j)  (1280 + 64 * (j))
#define XB_XGEN(j)  (2304 + 64 * (j))
#define XB_TOP      3328
#define XB_TOPGEN   3392
#define XCD_BAR_WORDS 3456
#define XB_SPIN_CAP (1u << 18)
DI unsigned xb_ld(unsigned* p)              { return __hip_atomic_load(p, __ATOMIC_RELAXED, __HIP_MEMORY_SCOPE_AGENT); }
DI unsigned xb_add(unsigned* p, unsigned v) { return __hip_atomic_fetch_add(p, v, __ATOMIC_RELAXED, __HIP_MEMORY_SCOPE_AGENT); }
DI unsigned xb_xcc_id() { return (unsigned)__builtin_amdgcn_s_getreg((3 << 11) | 20) & 0xFu; }
#define XB_SPIN(cond, bar) do { unsigned _sp = 0; while (cond) { __builtin_amdgcn_s_sleep(1); \
    if ((++_sp & 255u) == 0u) { if (xb_ld(&(bar)[XB_TMO])) break; if (_sp > XB_SPIN_CAP) { atomicAdd(&(bar)[XB_TMO], 1u); break; } } } } while (0)
struct XcdBarrier { unsigned* bar; unsigned x; volatile LAS unsigned* st; };
DI XcdBarrier xcd_barrier_post(unsigned* bar, volatile LAS unsigned* st) {
    XcdBarrier b; b.bar = bar; b.x = xb_xcc_id(); b.st = st;
    if (threadIdx.x == 0) (void)xb_add(&bar[XB_XCNT(b.x)], 1u);
    return b;
}
DI void xcd_barrier_complete(unsigned* bar, unsigned x, unsigned& nloc, unsigned& nx) {
    const unsigned G = gridDim.x * gridDim.y * gridDim.z;
    unsigned sum, cnt, mine, sp = 0u;
    for (;;) {
        sum = 0u; cnt = 0u; mine = 0u;
#pragma unroll
        for (unsigned j = 0; j < 16; ++j) { const unsigned c = xb_ld(&bar[XB_XCNT(j)]); sum += c; cnt += (c > 0u) ? 1u : 0u; mine = (j == x) ? c : mine; }
        if (sum == G) break;
        __builtin_amdgcn_s_sleep(1);
        if ((++sp & 255u) == 0u) { if (xb_ld(&bar[XB_TMO])) break; if (sp > XB_SPIN_CAP) { atomicAdd(&bar[XB_TMO], 1u); break; } }
    }
    nloc = mine > 0u ? mine : 1u; nx = cnt > 0u ? cnt : 1u;
}
DI void xcd_barrier(const XcdBarrier& b) {
    asm volatile("s_waitcnt vmcnt(0)" ::: "memory");
    __syncthreads();
    if (threadIdx.x == 0) {
        unsigned* bar = b.bar;
        __builtin_amdgcn_s_waitcnt(0);
        unsigned nloc = b.st[0], nx = b.st[1];
        if (nloc == 0u) { xcd_barrier_complete(bar, b.x, nloc, nx); b.st[0] = nloc; b.st[1] = nx; }
        const unsigned old = xb_add(&bar[XB_XSUB(b.x)], 1u);
        const unsigned gen = old / nloc;
        if (old + 1u == (gen + 1u) * nloc) {
            __builtin_amdgcn_fence(__ATOMIC_RELEASE, "agent");
            asm volatile("s_waitcnt vmcnt(0)" ::: "memory");
            const unsigned og = xb_add(&bar[XB_TOP], 1u);
            const unsigned tg = og / nx;
            if (og + 1u == (tg + 1u) * nx) xb_add(&bar[XB_TOPGEN], 1u);
            else XB_SPIN(xb_ld(&bar[XB_TOPGEN]) == tg, bar);
            __builtin_amdgcn_fence(__ATOMIC_ACQUIRE, "agent");
            xb_add(&bar[XB_XGEN(b.x)], 1u);
            asm volatile("s_waitcnt vmcnt(0)" ::: "memory");
        } else {
            XB_SPIN(xb_ld(&bar[XB_XGEN(b.x)]) == gen, bar);
            __builtin_amdgcn_fence(__ATOMIC_ACQUIRE, "agent");
            asm volatile("s_waitcnt vmcnt(0)" ::: "memory");
        }
    }
    __syncthreads();
}

__global__ void __launch_bounds__(512, 2) __attribute__((amdgpu_waves_per_eu(2, 2))) mega_fwd(Params P) {
    extern __shared__ __attribute__((aligned(16))) unsigned char smem[];
    LAS unsigned char* lds = (LAS unsigned char*)smem;
    cg::grid_group grid = cg::this_grid();
    __shared__ uint4 xb_words;
    if (threadIdx.x == 0) xb_words = make_uint4(0u, 0u, 0u, 0u);
    __syncthreads();
    const XcdBarrier xb = xcd_barrier_post((unsigned*)(P.ws + O_BAR), (volatile LAS unsigned*)&xb_words);
    const int G = gridDim.x, nthreads = G * 512, NGW = G * 8;
#pragma nounroll
    for (int st = 0; st < NSTEPS; ++st) {
        int nrep = PROBE_REP(st); asm volatile("" : "+s"(nrep));
_Pragma("nounroll") for (int rep = 0; rep < nrep; ++rep) {
        if (rep) __syncthreads();
        int tid = threadIdx.x; asm volatile("" : "+v"(tid));
        int bid = blockIdx.x; asm volatile("" : "+s"(bid));
        unsigned char* ws = P.ws; asm volatile("" : "+s"(ws));
        float* outp_ = P.out; asm volatile("" : "+s"(outp_));
        const float* ng = P.in[2];
        bf16_t* XN = (bf16_t*)(ws + O_XN); const bf16_t* Zb = (const bf16_t*)(ws + O_Z);
        GemmDesc g;
        if (get_gemm(P, st, g)) gemm_phase(lds, P, g, G, bid, tid);
        else switch (st) {
        case 0: conv_layer(P, 0, GW_, NGW, LANE_); cs_table(P, GTID_, nthreads);
                row_pass<RP_BF>(P.in[0], outp_, nullptr, nullptr, ng, XN, GW_, NGW, LANE_); break;
        case 3: gate_phase(P, lds, tid, WID_, LANE_, bid); break;
        case 5: case 11: case 14: case 22: case 30: {
            const int L = (st == 5) ? 0 : (st <= 14 ? 1 : (st == 22 ? 2 : 3)); const bool mlp = (st == 14);
            const float* hin = (st == 5) ? P.in[0] : outp_;
            const float* gpost = ng + (L * 4 + (mlp ? 3 : 1)) * 1024; const float* gpre = mlp ? ng + ((L + 1) * 4) * 1024 : ng + (L * 4 + 2) * 1024;
            row_pass<RP_BF>(hin, outp_, Zb, gpost, gpre, XN, GW_, NGW, LANE_);
            if (mlp) conv_layer(P, L + 1, GW_, NGW, LANE_);
        } break;
        case 8: row_pass<RP_F32>(outp_, outp_, Zb, ng + 3 * 1024, ng + 4 * 1024, ws + O_AR, GW_, NGW, LANE_); conv_layer(P, 1, GW_, NGW, LANE_); break;
        case 9: pool_phase(P, GTID_, nthreads); break;
        case 16: mla_rows(P, GW_, NGW, LANE_); break;
        case 20: attn_phase(P, lds, tid, WID_, LANE_, bid); break;
        case 25: row_pass<RP_S5>(outp_, outp_, Zb, ng + 11 * 1024, ng + 12 * 1024, ws + O_AR, GW_, NGW, LANE_); conv_layer(P, 3, GW_, NGW, LANE_); s5_precompute(P, lds, tid, bid); break;
        case 27: s5_scan(P, WID_, LANE_, bid); break;
        case 33: row_pass<RP_FINAL>(outp_, outp_, Zb, ng + 15 * 1024, nullptr, nullptr, GW_, NGW, LANE_); break;
        default: break;
        }
        }
        if (G == 0) grid.sync();
        if (st != 2 && st != 17 && st != 18 && st != NSTEPS - 1) { xcd_barrier(xb); if (PROBE_SYNC) xcd_barrier(xb); }
    }
}
}

extern "C" void kernel_launch(void* const* d_in, const int* in_sizes, int n_in, void* d_out, int out_size, void* d_ws, size_t ws_size, hipStream_t stream) {
    static int grid = 0;
    if (grid == 0) {
        int dev = 0, cus = 0, per_cu = 0;
        hipGetDevice(&dev);
        hipDeviceGetAttribute(&cus, hipDeviceAttributeMultiprocessorCount, dev);
        hipFuncSetAttribute((const void*)mega_fwd, hipFuncAttributeMaxDynamicSharedMemorySize, LDS_BYTES);
        if (hipOccupancyMaxActiveBlocksPerMultiprocessor(&per_cu, (const void*)mega_fwd, 512, LDS_BYTES) != hipSuccess || per_cu < 1) per_cu = 1;
        (void)hipGetLastError();
        grid = cus * per_cu;
        if (grid <= 0) grid = 256;
    }
    Params p{};
    for (int i = 0; i < 32 && i < n_in; ++i) p.in[i] = (const float*)d_in[i];
    p.out = (float*)d_out; p.ws = (unsigned char*)d_ws;
    hipMemsetAsync((unsigned char*)d_ws + O_BAR, 0, XCD_BAR_WORDS * 4, stream);
    void* args[] = {&p};
    hipError_t e = hipLaunchCooperativeKernel((const void*)mega_fwd, dim3(grid), dim3(512), args, LDS_BYTES, stream);
    if (e != hipSuccess) fprintf(stderr, "cooperative launch failed: %s (grid %d)\n", hipGetErrorString(e), grid);
}
```

```cpp
#include <hip/hip_runtime.h>
#include <hip/hip_cooperative_groups.h>
#include <cstdio>
namespace cg = cooperative_groups;

#define DI __device__ __forceinline__
#define LAS __attribute__((address_space(3)))
#define GAS __attribute__((address_space(1)))
typedef unsigned short bf16_t;
typedef short bf16x8 __attribute__((ext_vector_type(8)));
typedef float f32x2 __attribute__((ext_vector_type(2)));
typedef float f32x4 __attribute__((ext_vector_type(4)));
typedef float f32x16 __attribute__((ext_vector_type(16)));
typedef unsigned u32x2 __attribute__((ext_vector_type(2)));
typedef unsigned u32x4 __attribute__((ext_vector_type(4)));
typedef __bf16 bf16v2 __attribute__((ext_vector_type(2)));

#define LANE_ (tid & 63)
#define WID_ (__builtin_amdgcn_readfirstlane(tid >> 6))
#define GW_ (bid * 8 + WID_)
#define GTID_ (bid * 512 + tid)
#ifndef PROBE_REP
#define PROBE_REP(st) 1
#endif
#ifndef PROBE_SYNC
#define PROBE_SYNC 0
#endif
#define IS_GEMM_STEP(st) ((st)==1||(st)==4||(st)==6||(st)==7||(st)==10||(st)==12||(st)==13||(st)==15||(st)==17||(st)==18||(st)==19||(st)==21||(st)==23||(st)==24||(st)==26||(st)==28||(st)==29||(st)==31||(st)==32)
#define IS_MLP_STEP(st) ((st)==6||(st)==7||(st)==12||(st)==13||(st)==23||(st)==24||(st)==31||(st)==32)
namespace {
constexpr int S = 16384;
constexpr size_t MiB = (size_t)1 << 20;
constexpr size_t O_CS = 0, O_WUP = 4 * MiB, O_WDN = 12 * MiB, O_WMIX = 20 * MiB, O_XN = 28 * MiB, O_Z = 60 * MiB, O_AR = 92 * MiB;
constexpr int LDS_BYTES = 131072;
constexpr size_t O_BAR = 254 * MiB;
constexpr size_t O_STAT = 254 * MiB + 65536;
constexpr int NSTEPS = 34;
constexpr float RMS_EPS = 1e-6f;
constexpr float QSCALE = 0.07216878364870322f * 1.4426950408889634f;

enum { E_Z = 0, E_HID, E_UV, E_POOL, E_LAT, E_Q, E_KN, E_VT, E_XE, E_S5Y, E_GLU };

struct Params { const float* in[32]; float* out; unsigned char* ws; };

DI unsigned pk_bf16(float a, float b) { f32x2 f = {a, b}; bf16v2 h = __builtin_convertvector(f, bf16v2); return __builtin_bit_cast(unsigned, h); }
DI bf16_t f2bf(float x) { return (bf16_t)(pk_bf16(x, 0.f) & 0xffffu); }
DI float bf2f(bf16_t b) { return __uint_as_float(((unsigned)b) << 16); }
DI float bflo(unsigned u) { return __uint_as_float(u << 16); }
DI float bfhi(unsigned u) { return __uint_as_float(u & 0xffff0000u); }
DI float shx(float v, int o, int lane) { return __int_as_float(__builtin_amdgcn_ds_bpermute((lane ^ o) << 2, __float_as_int(v))); }
DI float wave_sum(float v, int lane) {
#pragma unroll
    for (int o = 1; o < 64; o <<= 1) v += shx(v, o, lane);
    return v;
}
DI void store_bf4(bf16_t* p, f32x4 v) { u32x2 w; w.x = pk_bf16(v[0], v[1]); w.y = pk_bf16(v[2], v[3]); *(GAS u32x2*)p = w; }
DI float gelu_tanh(float x) {
    const float u = 0.7978845608028654f * (x + 0.044715f * x * x * x);
    const float e = __expf(-2.f * u);
    return x * __builtin_amdgcn_rcpf(1.f + e);
}

constexpr int BM = 256, BK = 64, HALF = 128, HTB = HALF * BK * 2, NXCD = 8, WGM = 8;
DI int lds_byte(int r, int c) { const int st = (r >> 4) * 2 + (c >> 5), rr = r & 15, cc = c & 31, ob = rr * 64 + cc * 2; return st * 1024 + (ob ^ (((ob >> 9) & 1) << 5)); }
DI void stage_rc(int b, int& R, int& C) { const int st = b / 1024, sb = b % 1024, swz = sb ^ (((sb >> 9) & 1) << 5); R = (st >> 1) * 16 + swz / 64; C = (st & 1) * 32 + (swz % 64) / 2; }

struct GemmDesc { const bf16_t* A; const bf16_t* Bt; long a_gs, b_gs; int K, lda, ldb, nM, nN, ngrp, mode; };
struct Unit { int pm, pn, grp; };

DI bool unit_next(const GemmDesc& g, int i, int G, int c, Unit& u) {
    const int nper = g.nM * g.nN;
    const long L = (long)i * G + c;
    const bool ok = L < (long)nper * g.ngrp;
    const int grp2 = (int)(L / nper), w = (int)(L - (long)grp2 * nper);
    const int nwg = nper, nM = g.nM, nN = g.nN;
    int wgid = w;
    { const int q = nwg / NXCD, r = nwg % NXCD, xcd = wgid % NXCD, off = wgid / NXCD; wgid = (xcd < r ? xcd * (q + 1) : r * (q + 1) + (xcd - r) * q) + off; }
    const int nig = WGM * nN, gid = wgid / nig, fm = gid * WGM, gsz = (nM - fm) < WGM ? (nM - fm) : WGM;
    const int gszc = gsz > 0 ? gsz : 1;
    const int pm1 = fm + ((wgid % nig) % gszc), pn1 = (wgid % nig) / gszc;
    const int pm2 = w % nM, pn2 = w / nM;
    const bool single = (g.ngrp == 1);
    Unit r; r.pm = single ? pm1 : pm2; r.pn = single ? pn1 : pn2; r.grp = single ? 0 : grp2;
    u = r;
    return ok;
}

DI int perm32(int rho) { const int n = rho >> 4, i = rho & 15; return 8 * (i >> 2) + 4 * n + (i & 3); }
DI void store_bf8(bf16_t* p, f32x4 a, f32x4 b) { u32x4 w; w.x = pk_bf16(a[0], a[1]); w.y = pk_bf16(a[2], a[3]); w.z = pk_bf16(b[0], b[1]); w.w = pk_bf16(b[2], b[3]); *(GAS u32x4*)p = w; }
#define EPI_LOOP(...) \
    _Pragma("unroll") for (int ai = 0; ai < 2; ++ai) _Pragma("unroll") for (int m = 0; m < 4; ++m) { const int row = row0 + ai * HALF + m * 16; \
        _Pragma("unroll") for (int bj = 0; bj < 2; ++bj) { const int col = col0 + bj * HALF; f32x4 v0 = acc[ai][bj][m][0], v1 = acc[ai][bj][m][1]; __VA_ARGS__ } }

DI void epilogue(const Params& P, const GemmDesc& g, const f32x4 (&acc)[2][2][4][2], const Unit& u, int wr, int wc, int fr, int fq) {
    unsigned char* ws_ = P.ws; asm volatile("" : "+s"(ws_));
    unsigned char* ws = ws_;
    const int row0 = u.pm * BM + wr * 64 + fr, col0 = u.pn * BM + wc * 32 + 8 * fq;
    bf16_t* Zb = (bf16_t*)(ws + O_Z);
    bf16_t* AR = (bf16_t*)(ws + O_AR);
    switch (g.mode) {
    case E_Z: { EPI_LOOP( store_bf8(Zb + (size_t)row * 1024 + col, v0, v1); ) } break;
    case E_HID: { EPI_LOOP( _Pragma("unroll") for (int j = 0; j < 4; ++j) { const float t0 = fmaxf(v0[j], 0.f), t1 = fmaxf(v1[j], 0.f); v0[j] = t0 * t0; v1[j] = t1 * t1; } store_bf8(AR + (size_t)row * 4096 + col, v0, v1); ) } break;
    case E_UV: { const float* bin = P.in[6]; float* STAT = (float*)(ws + O_AR + 96 * MiB); const int lane_ = fr + 16 * fq;
#pragma unroll
        for (int ai = 0; ai < 2; ++ai)
#pragma unroll
            for (int m = 0; m < 4; ++m) { const int row = row0 + ai * HALF + m * 16; float s1 = 0.f, s2 = 0.f;
#pragma unroll
                for (int bj = 0; bj < 2; ++bj) { const int col = col0 + bj * HALF; f32x4 v0 = acc[ai][bj][m][0], v1 = acc[ai][bj][m][1];
                    const f32x4 b0 = *(const GAS f32x4*)(bin + col); const f32x4 b1 = *(const GAS f32x4*)(bin + col + 4);
#pragma unroll
                    for (int j = 0; j < 4; ++j) { v0[j] = gelu_tanh(v0[j] + b0[j]); v1[j] = gelu_tanh(v1[j] + b1[j]); s1 += v0[j] + v1[j]; s2 += v0[j] * v0[j] + v1[j] * v1[j]; }
                    bf16_t* dst = (col < 1024) ? (AR + (size_t)row * 1024 + col) : (AR + 16 * MiB + (size_t)row * 1024 + (col - 1024)); store_bf8(dst, v0, v1); }
                if (col0 >= 1024) {
                    s1 += shx(s1, 16, lane_); s2 += shx(s2, 16, lane_); s1 += shx(s1, 32, lane_); s2 += shx(s2, 32, lane_);
                    if (fq == 0) *(GAS f32x2*)(STAT + ((size_t)row * 16 + (u.pn - 4) * 4 + wc) * 2) = (f32x2){s1, s2}; }
            }
    } break;
    case E_POOL: { const float* sc = P.in[13];
        EPI_LOOP( const int cgc = 256 * u.grp + col; const f32x4 s0 = *(const GAS f32x4*)(sc + cgc); const f32x4 s1 = *(const GAS f32x4*)(sc + cgc + 4); store_bf8(Zb + (size_t)row * 1024 + cgc, v0 * s0, v1 * s1); ) } break;
    case E_LAT: { EPI_LOOP( store_bf8(AR + (size_t)row * 768 + col, v0, v1); ) } break;
    case E_Q: { const float* CS = (const float*)(ws + O_CS); bf16_t* Qb = AR + 24 * MiB;
        EPI_LOOP( const int w = col % 192;
                  if (w >= 128) { const int j = (w - 128) >> 1; const f32x4 c0 = *(const GAS f32x4*)(CS + ((size_t)row * 32 + j) * 2); const f32x4 c1 = *(const GAS f32x4*)(CS + ((size_t)row * 32 + j) * 2 + 4);
                      const float a0 = v0[0] * c0[0] - v0[1] * c0[1]; const float a1 = v0[0] * c0[1] + v0[1] * c0[0]; const float a2 = v0[2] * c0[2] - v0[3] * c0[3]; const float a3 = v0[2] * c0[3] + v0[3] * c0[2];
                      const float e0 = v1[0] * c1[0] - v1[1] * c1[1]; const float e1 = v1[0] * c1[1] + v1[1] * c1[0]; const float e2 = v1[2] * c1[2] - v1[3] * c1[3]; const float e3 = v1[2] * c1[3] + v1[3] * c1[2];
                      v0[0] = a0; v0[1] = a1; v0[2] = a2; v0[3] = a3; v1[0] = e0; v1[1] = e1; v1[2] = e2; v1[3] = e3; }
                  store_bf8(Qb + (size_t)row * 1536 + col, v0 * QSCALE, v1 * QSCALE); ) } break;
    case E_KN: { bf16_t* KN = AR + 48 * MiB; EPI_LOOP( store_bf8(KN + (size_t)row * 1024 + col, v0, v1); ) } break;
    case E_VT: { bf16_t* VT = AR + 64 * MiB; EPI_LOOP( store_bf8(VT + (size_t)row * 16384 + col, v0, v1); ) } break;
    case E_XE: { float* XE = (float*)(ws + O_AR + 96 * MiB);
        EPI_LOOP( if (col < 128) { float* xp = XE + ((size_t)(u.grp * 512 + row)) * 128 + col; *(GAS f32x4*)xp = v0; *(GAS f32x4*)(xp + 4) = v1; } ) } break;
    case E_S5Y: { bf16_t* Y5 = AR + 56 * MiB;
        EPI_LOOP( const int l = col >> 4, c = col & 15; const int token = row * 32 + l; _Pragma("unroll") for (int j = 0; j < 4; ++j) { v0[j] = gelu_tanh(v0[j]); v1[j] = gelu_tanh(v1[j]); }
                  store_bf8(Y5 + (size_t)token * 1024 + u.grp * 16 + c, v0, v1); ) } break;
    case E_GLU: {
#pragma unroll
        for (int ai = 0; ai < 2; ++ai)
#pragma unroll
            for (int m = 0; m < 4; ++m) { const int row = row0 + ai * HALF + m * 16; const int oc = u.pn * 128 + wc * 32 + 8 * fq;
                const f32x4 a0 = acc[ai][0][m][0], a1 = acc[ai][0][m][1], b0 = acc[ai][1][m][0], b1 = acc[ai][1][m][1]; f32x4 v0, v1;
#pragma unroll
                for (int j = 0; j < 4; ++j) { v0[j] = a0[j] * __builtin_amdgcn_rcpf(1.f + __expf(-b0[j])); v1[j] = a1[j] * __builtin_amdgcn_rcpf(1.f + __expf(-b1[j])); }
                store_bf8(Zb + (size_t)row * 1024 + oc, v0, v1); }
    } break;
    default: break;
    }
}

DI void gemm_phase(LAS unsigned char* lds, const Params& P, const GemmDesc g, const int G, const int cidx, int tid) {
    asm volatile("" : "+v"(tid));
    const int wid = __builtin_amdgcn_readfirstlane(tid >> 6), lane = tid & 63, wr = wid >> 2, wc = wid & 3, fr = lane & 15, fq = lane >> 4;
    const int K = g.K, nt = K / BK;
    unsigned voffA[2], voffB[2];
#pragma unroll
    for (int i = 0; i < 2; ++i) { int R, C; stage_rc(tid * 16 + i * 8192, R, C); const int Rb = (R & ~31) + perm32(R & 31); voffA[i] = (unsigned)(R * g.lda + C) * 2u; voffB[i] = (unsigned)(Rb * g.ldb + C) * 2u; }
    const size_t kstep = (size_t)(BK * 2);
    const size_t hstepA = (size_t)HALF * g.lda * 2, hstepB = (size_t)HALF * g.ldb * 2;
    const unsigned ldsw = (unsigned)wid * 1024u;
    const int aoff = lds_byte(wr * 64 + fr, fq * 8), boff = lds_byte(wc * 32 + fr, fq * 8);
#define PG8_SA(b, h) (((b) * 2 + (h)) * HTB)
#define PG8_SB(b, h) ((4 + (b) * 2 + (h)) * HTB)
#define PG8_STAGE(bufoff, gbase, voff) do { _Pragma("unroll") for (int _i = 0; _i < 2; ++_i) \
        __builtin_amdgcn_global_load_lds((const unsigned*)((const char*)(gbase) + (voff)[_i]), (LAS unsigned*)(lds + (bufoff) + ldsw + _i * 8192), 16, 0, 0); } while (0)
#define PG8_LDA(dst, b, h) do { _Pragma("unroll") for (int m = 0; m < 4; ++m) _Pragma("unroll") for (int k = 0; k < 2; ++k) dst[m][k] = *(const LAS bf16x8*)(lds + PG8_SA(b, h) + aoff + m * 2048 + k * 1024); } while (0)
#define PG8_LDB(dst, b, h) do { _Pragma("unroll") for (int n = 0; n < 2; ++n) _Pragma("unroll") for (int k = 0; k < 2; ++k) dst[n][k] = *(const LAS bf16x8*)(lds + PG8_SB(b, h) + boff + n * 2048 + k * 1024); } while (0)
#define PG8_MMA(ai, bj, At, Bt) do { __builtin_amdgcn_s_setprio(1); _Pragma("unroll") for (int m = 0; m < 4; ++m) _Pragma("unroll") for (int n = 0; n < 2; ++n) _Pragma("unroll") for (int k = 0; k < 2; ++k) \
        acc[ai][bj][m][n] = __builtin_amdgcn_mfma_f32_16x16x32_bf16(Bt[n][k], At[m][k], acc[ai][bj][m][n], 0, 0, 0); __builtin_amdgcn_s_setprio(0); } while (0)
#define PG8_WAIT_V(n) asm volatile("s_waitcnt vmcnt(" #n ")" ::: "memory")
#define PG8_WAIT_L(n) asm volatile("s_waitcnt lgkmcnt(" #n ")" ::: "memory")
#define PG8_BAR __builtin_amdgcn_s_barrier()
#define PG8_SCHED __builtin_amdgcn_sched_barrier(0)
    Unit cur, nxt; int ui = 0;
    if (!unit_next(g, 0, G, cidx, cur)) return;
    f32x4 acc[2][2][4][2];
#pragma unroll
    for (int a = 0; a < 2; ++a)
#pragma unroll
        for (int b = 0; b < 2; ++b)
#pragma unroll
            for (int m = 0; m < 4; ++m)
#pragma unroll
                for (int n = 0; n < 2; ++n) acc[a][b][m][n] = (f32x4){0.f, 0.f, 0.f, 0.f};
    bf16x8 At[4][2], B0[2][2], B1[2][2];
    const char* cA = (const char*)g.A + ((size_t)cur.grp * g.a_gs + (size_t)cur.pm * BM * g.lda) * 2;
    const char* cB = (const char*)g.Bt + ((size_t)cur.grp * g.b_gs + (size_t)cur.pn * BM * g.ldb) * 2;
    PG8_STAGE(PG8_SB(0, 0), cB, voffB); PG8_STAGE(PG8_SB(0, 1), cB + hstepB, voffB); PG8_STAGE(PG8_SA(0, 0), cA, voffA); PG8_STAGE(PG8_SA(0, 1), cA + hstepA, voffA);
    if (wr == 1) PG8_BAR;
    PG8_WAIT_V(2); PG8_BAR;
    PG8_STAGE(PG8_SB(1, 0), cB + kstep, voffB); PG8_STAGE(PG8_SA(1, 0), cA + kstep, voffA); PG8_STAGE(PG8_SB(1, 1), cB + hstepB + kstep, voffB);
    PG8_WAIT_V(6); PG8_BAR;
    for (;;) {
        const bool has_next = unit_next(g, ui + 1, G, cidx, nxt);
        const char* nA = has_next ? (const char*)g.A + ((size_t)nxt.grp * g.a_gs + (size_t)nxt.pm * BM * g.lda) * 2 : cA;
        const char* nB = has_next ? (const char*)g.Bt + ((size_t)nxt.grp * g.b_gs + (size_t)nxt.pn * BM * g.ldb) * 2 : cB;
        for (int t = 0; t < nt; t += 2) {
            const bool last = (t == nt - 2);
            const char* a1 = cA + (size_t)(t + 1) * kstep;
            const char* a2 = last ? nA : cA + (size_t)(t + 2) * kstep; const char* b2 = last ? nB : cB + (size_t)(t + 2) * kstep;
            const char* a3 = a2 + kstep; const char* b3 = b2 + kstep;
            PG8_LDB(B0, 0, 0); PG8_LDB(B1, 0, 1); PG8_SCHED; PG8_LDA(At, 0, 0); PG8_STAGE(PG8_SA(1, 1), a1 + hstepA, voffA);
            PG8_WAIT_V(8); PG8_WAIT_L(0); PG8_BAR; PG8_MMA(0, 0, At, B0); PG8_MMA(0, 1, At, B1); PG8_BAR; PG8_SCHED;
            PG8_LDA(At, 0, 1); PG8_STAGE(PG8_SB(0, 0), b2, voffB); PG8_STAGE(PG8_SB(0, 1), b2 + hstepB, voffB); PG8_STAGE(PG8_SA(0, 0), a2, voffA);
            PG8_WAIT_V(8); PG8_WAIT_L(0); PG8_BAR; PG8_MMA(1, 0, At, B0); PG8_MMA(1, 1, At, B1); PG8_BAR; PG8_SCHED;
            PG8_LDB(B0, 1, 0); PG8_LDB(B1, 1, 1); PG8_SCHED; PG8_LDA(At, 1, 0); PG8_STAGE(PG8_SA(0, 1), a2 + hstepA, voffA);
            PG8_WAIT_V(8); PG8_WAIT_L(0); PG8_BAR; PG8_MMA(0, 0, At, B0); PG8_MMA(0, 1, At, B1); PG8_BAR; PG8_SCHED;
            PG8_LDA(At, 1, 1); PG8_STAGE(PG8_SB(1, 0), b3, voffB); PG8_STAGE(PG8_SB(1, 1), b3 + hstepB, voffB); PG8_STAGE(PG8_SA(1, 0), a3, voffA);
            PG8_WAIT_V(8); PG8_WAIT_L(0); PG8_BAR; PG8_MMA(1, 0, At, B0); PG8_MMA(1, 1, At, B1); PG8_BAR; PG8_SCHED;
        }
        if (wr == 0) PG8_BAR;
        epilogue(P, g, acc, cur, wr, wc, fr, fq);
        if (!has_next) break;
#pragma unroll
        for (int a = 0; a < 2; ++a)
#pragma unroll
            for (int b = 0; b < 2; ++b)
#pragma unroll
                for (int m = 0; m < 4; ++m)
#pragma unroll
                    for (int n = 0; n < 2; ++n) acc[a][b][m][n] = (f32x4){0.f, 0.f, 0.f, 0.f};
        cur = nxt; cA = nA; cB = nB; ++ui;
        if (wr == 1) PG8_BAR;
    }
    PG8_WAIT_V(0);
    PG8_BAR;
}

DI bool get_gemm(const Params& P, int st, GemmDesc& g) {
    unsigned char* ws_ = P.ws; asm volatile("" : "+s"(ws_));
    unsigned char* ws = ws_;
    const bf16_t* XN = (const bf16_t*)(ws + O_XN);
    const bf16_t* WMIX = (const bf16_t*)(ws + O_WMIX);
    const bf16_t* AR = (const bf16_t*)(ws + O_AR);
    g.a_gs = 0; g.b_gs = 0; g.ngrp = 1; g.nM = 64; g.K = 1024; g.lda = 1024; g.ldb = 1024; g.A = XN; g.Bt = WMIX; g.nN = 4; g.mode = E_Z;
    switch (st) {
    case 1: g.nN = 8; g.mode = E_UV; return true;
    case 4: g.A = AR + 32 * MiB; g.Bt = WMIX + 2 * MiB; return true;
    case 6: case 12: case 23: case 31: g.Bt = (const bf16_t*)(ws + O_WUP); g.nN = 16; g.mode = E_HID; return true;
    case 7: case 13: case 24: case 32: g.A = AR; g.Bt = (const bf16_t*)(ws + O_WDN); g.K = 4096; g.lda = 4096; g.ldb = 4096; return true;
    case 10: g.A = AR + 32 * MiB; g.K = 256; g.ldb = 256; g.nN = 1; g.ngrp = 4; g.a_gs = 256; g.b_gs = 65536; g.mode = E_POOL; return true;
    case 15: g.nN = 3; g.mode = E_LAT; return true;
    case 17: g.A = AR + 12 * MiB; g.Bt = WMIX + 1 * MiB; g.K = 384; g.lda = 384; g.ldb = 384; g.nN = 6; g.mode = E_Q; return true;
    case 18: g.A = AR + 18 * MiB; g.Bt = WMIX + 2 * MiB; g.K = 256; g.lda = 256; g.ldb = 256; g.nN = 4; g.mode = E_KN; return true;
    case 19: g.A = WMIX + (5 * MiB) / 2; g.Bt = AR + 18 * MiB; g.K = 256; g.lda = 256; g.ldb = 256; g.nM = 4; g.nN = 64; g.mode = E_VT; return true;
    case 21: g.Bt = WMIX + 3 * MiB; return true;
    case 26: g.A = AR; g.Bt = AR + 40 * MiB; g.K = 512; g.lda = 640; g.ldb = 512; g.nM = 2; g.nN = 1; g.ngrp = 64; g.a_gs = 512 * 640; g.b_gs = 256 * 512; g.mode = E_XE; return true;
    case 28: g.A = AR; g.Bt = AR + 20 * MiB; g.K = 640; g.lda = 640; g.ldb = 640; g.nM = 2; g.nN = 2; g.ngrp = 64; g.a_gs = 512 * 640; g.b_gs = 512 * 640; g.mode = E_S5Y; return true;
    case 29: g.A = AR + 56 * MiB; g.nN = 8; g.mode = E_GLU; return true;
    default: return false;
    }
}

enum { RP_BF = 0, RP_F32 = 1, RP_S5 = 2, RP_FINAL = 3 };
template <int MODE>
DI void row_pass(const float* hin, float* hout, const bf16_t* z, const float* gpost, const float* gpre, void* outp, int gw, int NGW, int lane) {
    asm volatile("" : "+v"(lane));
    for (int rowa = gw; rowa < S; rowa += 2 * NGW) {
        f32x4 h[2][4];
#pragma unroll
        for (int q = 0; q < 2; ++q) { const int row = rowa + q * NGW;
#pragma unroll
            for (int j = 0; j < 4; ++j) { const int cb = (MODE == RP_S5) ? 16 * lane + 4 * j : 4 * lane + 256 * j; h[q][j] = *(const GAS f32x4*)(hin + (size_t)row * 1024 + cb); } }
        if (z) {
            f32x4 zz[2][4]; float ss[2] = {0.f, 0.f};
#pragma unroll
            for (int q = 0; q < 2; ++q) { const int row = rowa + q * NGW;
#pragma unroll
                for (int j = 0; j < 4; ++j) { const int cb = (MODE == RP_S5) ? 16 * lane + 4 * j : 4 * lane + 256 * j; const u32x2 w = *(const GAS u32x2*)(z + (size_t)row * 1024 + cb);
                    zz[q][j] = (f32x4){bflo(w.x), bfhi(w.x), bflo(w.y), bfhi(w.y)}; ss[q] += zz[q][j][0] * zz[q][j][0] + zz[q][j][1] * zz[q][j][1] + zz[q][j][2] * zz[q][j][2] + zz[q][j][3] * zz[q][j][3]; } }
#pragma unroll
            for (int q = 0; q < 2; ++q) { const int row = rowa + q * NGW;
                const float rz = rsqrtf(wave_sum(ss[q], lane) * (1.f / 1024.f) + RMS_EPS);
#pragma unroll
                for (int j = 0; j < 4; ++j) { const int cb = (MODE == RP_S5) ? 16 * lane + 4 * j : 4 * lane + 256 * j; const f32x4 gp = *(const GAS f32x4*)(gpost + cb); h[q][j] += zz[q][j] * rz * gp;
                    *(GAS f32x4*)(hout + (size_t)row * 1024 + cb) = h[q][j]; } }
        }
        if (MODE != RP_FINAL) {
#pragma unroll
            for (int q = 0; q < 2; ++q) { const int row = rowa + q * NGW;
                float s2 = 0.f;
#pragma unroll
                for (int j = 0; j < 4; ++j) s2 += h[q][j][0] * h[q][j][0] + h[q][j][1] * h[q][j][1] + h[q][j][2] * h[q][j][2] + h[q][j][3] * h[q][j][3];
                const float rn = rsqrtf(wave_sum(s2, lane) * (1.f / 1024.f) + RMS_EPS);
#pragma unroll
                for (int j = 0; j < 4; ++j) { const int cb = (MODE == RP_S5) ? 16 * lane + 4 * j : 4 * lane + 256 * j; const f32x4 gq = *(const GAS f32x4*)(gpre + cb); const f32x4 xn = h[q][j] * rn * gq;
                    if (MODE == RP_BF) store_bf4((bf16_t*)outp + (size_t)row * 1024 + cb, xn);
                    if (MODE == RP_F32) *(GAS f32x4*)((float*)outp + (size_t)row * 1024 + cb) = xn;
                    if (MODE == RP_S5) store_bf4((bf16_t*)outp + ((size_t)(lane * 512 + (row >> 5))) * 640 + (row & 31) * 16 + 4 * j, xn); } }
        }
    }
}

enum { MAP_ID = 0, MAP_UQ = 1, MAP_GLUA = 2, MAP_GLUB = 3 };
DI int dstrow(int mode, int n) {
    if (mode == MAP_UQ) { const int hd = n / 192, w = n - hd * 192; if (w < 128) return n; const int r = w - 128; return hd * 192 + 128 + 2 * (r & 31) + (r >> 5); }
    if (mode == MAP_GLUA) return (n >> 7) * 256 + (n & 127);
    if (mode == MAP_GLUB) return (n >> 7) * 256 + 128 + (n & 127);
    return n;
}
DI void convT(const float* src, int K, int N, bf16_t* dst, int ldT, int mapmode, int gw, int NGW, int lane) {
    asm volatile("" : "+v"(lane));
    const int nnb = N >> 4, nitems = nnb * (K >> 5);
    for (int it = gw; it < nitems; it += NGW) {
        const int kb = it / nnb, nb = it - kb * nnb;
        const int n = nb * 16 + (lane >> 2), k = kb * 32 + 8 * (lane & 3);
        const float* s = src + (size_t)k * N + n;
        float v[8];
#pragma unroll
        for (int i = 0; i < 8; ++i) v[i] = ((const GAS float*)s)[(size_t)i * N];
        u32x4 o; o.x = pk_bf16(v[0], v[1]); o.y = pk_bf16(v[2], v[3]); o.z = pk_bf16(v[4], v[5]); o.w = pk_bf16(v[6], v[7]);
        *(GAS u32x4*)(dst + (size_t)dstrow(mapmode, n) * ldT + k) = o;
    }
}
DI void conv_layer(const Params& P, int L, int gw, int NGW, int lane) {
    unsigned char* ws_ = P.ws; asm volatile("" : "+s"(ws_));
    unsigned char* ws = ws_;
    bf16_t* WMIX = (bf16_t*)(ws + O_WMIX);
    convT(P.in[3] + (size_t)L * 1024 * 4096, 1024, 4096, (bf16_t*)(ws + O_WUP), 1024, MAP_ID, gw, NGW, lane);
    convT(P.in[4] + (size_t)L * 1024 * 4096, 4096, 1024, (bf16_t*)(ws + O_WDN), 4096, MAP_ID, gw, NGW, lane);
    if (L == 0) {
        convT(P.in[5], 1024, 2048, WMIX, 1024, MAP_ID, gw, NGW, lane);
        convT(P.in[11], 1024, 1024, WMIX + 2 * MiB, 1024, MAP_ID, gw, NGW, lane);
        const float* wsrc = P.in[9]; bf16_t* wd = WMIX + 3 * MiB;
        for (int e = gw * 64 + lane; e < 8 * 128 * 128 / 4; e += NGW * 64) { const int s0 = (e * 4) & 127, t = ((e * 4) >> 7) & 127; f32x4 w = *(const f32x4*)(wsrc + (size_t)e * 4);
#pragma unroll
            for (int j = 0; j < 4; ++j) if (s0 + j > t) w[j] = 0.f;
            store_bf4(wd + (size_t)e * 4, w); }
    } else if (L == 1) {
        for (int gg = 0; gg < 4; ++gg) convT(P.in[12] + gg * 65536, 256, 256, WMIX + gg * 65536, 256, MAP_ID, gw, NGW, lane);
    } else if (L == 2) {
        convT(P.in[14], 1024, 384, WMIX, 1024, MAP_ID, gw, NGW, lane);
        convT(P.in[17], 1024, 320, WMIX + 384 * 1024, 1024, MAP_ID, gw, NGW, lane);
        convT(P.in[16], 384, 1536, WMIX + 1 * MiB, 384, MAP_UQ, gw, NGW, lane);
        convT(P.in[19], 256, 1024, WMIX + 2 * MiB, 256, MAP_ID, gw, NGW, lane);
        convT(P.in[20], 256, 1024, WMIX + (5 * MiB) / 2, 256, MAP_ID, gw, NGW, lane);
        convT(P.in[21], 1024, 1024, WMIX + 3 * MiB, 1024, MAP_ID, gw, NGW, lane);
    } else {
        convT(P.in[30], 1024, 1024, WMIX, 1024, MAP_GLUA, gw, NGW, lane);
        convT(P.in[31], 1024, 1024, WMIX, 1024, MAP_GLUB, gw, NGW, lane);
    }
}

DI void lnv_phase(const Params& P, int gw, int NGW, int lane) {
    unsigned char* ws_ = P.ws; asm volatile("" : "+s"(ws_));
    asm volatile("" : "+v"(lane));
    bf16_t* V = (bf16_t*)(ws_ + O_AR + 32 * MiB);
    const float* gv = P.in[7]; const float* bv = P.in[8];
    for (int row = gw; row < S; row += NGW) {
        f32x4 x[4]; float s = 0.f;
#pragma unroll
        for (int j = 0; j < 4; ++j) { const u32x2 w = *(const u32x2*)(V + (size_t)row * 1024 + 4 * lane + 256 * j); x[j] = (f32x4){bflo(w.x), bfhi(w.x), bflo(w.y), bfhi(w.y)}; s += x[j][0] + x[j][1] + x[j][2] + x[j][3]; }
        const float mu = wave_sum(s, lane) * (1.f / 1024.f); float s2 = 0.f;
#pragma unroll
        for (int j = 0; j < 4; ++j) { x[j] = x[j] - mu; s2 += x[j][0] * x[j][0] + x[j][1] * x[j][1] + x[j][2] * x[j][2] + x[j][3] * x[j][3]; }
        const float rs = rsqrtf(wave_sum(s2, lane) * (1.f / 1024.f) + RMS_EPS);
#pragma unroll
        for (int j = 0; j < 4; ++j) { const int cb = 4 * lane + 256 * j; const f32x4 g4 = *(const f32x4*)(gv + cb), b4 = *(const f32x4*)(bv + cb); store_bf4(V + (size_t)row * 1024 + cb, x[j] * rs * g4 + b4); }
    }
}

DI void gate_phase(const Params& P, LAS unsigned char* lds, int tid, int wid, int lane, int bid) {
    unsigned char* ws_ = P.ws; asm volatile("" : "+s"(ws_));
    asm volatile("" : "+v"(tid)); lane = tid & 63; wid = __builtin_amdgcn_readfirstlane(tid >> 6);
    LAS bf16_t* Wt = (LAS bf16_t*)lds;
    LAS bf16_t* Vt = Wt + 128 * 136;
    const bf16_t* Wsb = (const bf16_t*)(ws_ + O_WMIX + 6 * MiB);
    const bf16_t* U = (const bf16_t*)(ws_ + O_AR);
    const bf16_t* V = (const bf16_t*)(ws_ + O_AR + 32 * MiB);
    bf16_t* Y = (bf16_t*)(ws_ + O_AR + 64 * MiB);
    const float* bs = P.in[10]; const float* gv = P.in[7]; const float* bv = P.in[8]; const float* STAT = (const float*)(ws_ + O_AR + 96 * MiB);
    LAS float* mus = (LAS float*)(lds + 69632); LAS float* rss = mus + 128;
    const int r16 = lane & 15, quad = lane >> 4;
    for (int item = bid; item < 1024; item += gridDim.x) {
        const int hd = item & 7, c = item >> 3;
        __syncthreads();
        if (tid < 128) { const GAS f32x4* pp = (const GAS f32x4*)(STAT + (size_t)(c * 128 + tid) * 32); float a1 = 0.f, a2 = 0.f;
#pragma unroll
            for (int i = 0; i < 8; ++i) { const f32x4 t4 = pp[i]; a1 += t4[0] + t4[2]; a2 += t4[1] + t4[3]; }
            const float mu = a1 * (1.f / 1024.f); mus[tid] = mu; rss[tid] = rsqrtf(fmaxf(a2 * (1.f / 1024.f) - mu * mu, 0.f) + RMS_EPS); }
#pragma unroll
        for (int i = 0; i < 4; ++i) { const int cid = tid + 512 * i, t = cid >> 4, sc = cid & 15;
            const u32x4 w = *(const GAS u32x4*)(Wsb + ((size_t)(hd * 128 + t)) * 128 + 8 * sc); *(LAS u32x4*)(Wt + t * 136 + 8 * sc) = w; }
        __syncthreads();
#pragma unroll
        for (int i = 0; i < 4; ++i) { const int cid = tid + 512 * i, s = cid >> 4, dc = cid & 15;
            const int grow = c * 128 + s, gcol = hd * 128 + 8 * dc;
            const u32x4 w = *(const GAS u32x4*)(V + (size_t)grow * 1024 + gcol);
            const float mu = mus[s], rs = rss[s];
            const f32x4 g0 = *(const GAS f32x4*)(gv + gcol), g1 = *(const GAS f32x4*)(gv + gcol + 4), b0 = *(const GAS f32x4*)(bv + gcol), b1 = *(const GAS f32x4*)(bv + gcol + 4);
            float y[8];
#pragma unroll
            for (int e = 0; e < 8; ++e) { const float x = (e & 1) ? bfhi(w[e >> 1]) : bflo(w[e >> 1]); y[e] = (x - mu) * rs * ((e < 4) ? g0[e & 3] : g1[e & 3]) + ((e < 4) ? b0[e & 3] : b1[e & 3]); }
#pragma unroll
            for (int e = 0; e < 8; ++e) Vt[(8 * dc + e) * 136 + s] = f2bf(y[e]); }
        __syncthreads();
        const int t = 16 * wid + r16;
        const int nks = (16 * wid + 15) / 32 + 1;
        bf16x8 bw[4];
#pragma unroll
        for (int ks = 0; ks < 4; ++ks) bw[ks] = *(const LAS bf16x8*)(Wt + t * 136 + 32 * ks + 8 * quad);
        const int token = c * 128 + t;
        const float bias = bs[hd * 128 + t];
#pragma unroll
        for (int dt = 0; dt < 8; ++dt) {
            f32x4 acc = {0.f, 0.f, 0.f, 0.f};
#pragma unroll
            for (int ks = 0; ks < 4; ++ks) if (ks < nks) {
                const bf16x8 a = *(const LAS bf16x8*)(Vt + (16 * dt + r16) * 136 + 32 * ks + 8 * quad);
                acc = __builtin_amdgcn_mfma_f32_16x16x32_bf16(a, bw[ks], acc, 0, 0, 0); }
            const int col = hd * 128 + 16 * dt + 4 * quad;
            const u32x2 uu = *(const GAS u32x2*)(U + (size_t)token * 1024 + col);
            f32x4 y; y[0] = (acc[0] + bias) * bflo(uu.x); y[1] = (acc[1] + bias) * bfhi(uu.x); y[2] = (acc[2] + bias) * bflo(uu.y); y[3] = (acc[3] + bias) * bfhi(uu.y);
            store_bf4(Y + (size_t)token * 1024 + col, y);
        }
    }
}

DI void pool_phase(const Params& P, int gtid, int nthreads) {
    unsigned char* ws_ = P.ws; asm volatile("" : "+s"(ws_));
    asm volatile("" : "+v"(gtid));
    const float* ZF = (const float*)(ws_ + O_AR);
    bf16_t* Pb = (bf16_t*)(ws_ + O_AR + 64 * MiB);
    for (int e = gtid; e < 1024 * 256; e += nthreads) {
        const int cgi = e & 255, tb = e >> 8, col = 4 * cgi, w = 2 << (cgi >> 6), t0 = 16 * tb;
        f32x4 W = {0.f, 0.f, 0.f, 0.f};
        for (int j = 1; j < w; ++j) if (t0 - j >= 0) W += *(const GAS f32x4*)(ZF + (size_t)(t0 - j) * 1024 + col);
        for (int i = 0; i < 16; ++i) { const int t = t0 + i; const f32x4 z = *(const GAS f32x4*)(ZF + (size_t)t * 1024 + col); W += z;
            const float cnt = (float)((t + 1 < w) ? (t + 1) : w); const f32x4 o = W / cnt - z; store_bf4(Pb + (size_t)t * 1024 + col, o);
            if (t - w + 1 >= 0) W -= *(const GAS f32x4*)(ZF + (size_t)(t - w + 1) * 1024 + col); }
    }
}

DI void mla_rows(const Params& P, int gw, int NGW, int lane) {
    unsigned char* ws_ = P.ws; asm volatile("" : "+s"(ws_));
    asm volatile("" : "+v"(lane));
    unsigned char* ar = ws_ + O_AR;
    const bf16_t* LAT = (const bf16_t*)ar; bf16_t* QL = (bf16_t*)(ar + 24 * MiB); bf16_t* Cb = (bf16_t*)(ar + 36 * MiB); bf16_t* KR = (bf16_t*)(ar + 44 * MiB);
    const float* CS = (const float*)(ws_ + O_CS); const float* gq = P.in[15]; const float* gkv = P.in[18];
    for (int row = gw; row < S; row += NGW) {
        const bf16_t* lat = LAT + (size_t)row * 768;
        float q[6]; float ss = 0.f;
#pragma unroll
        for (int i = 0; i < 3; ++i) { const unsigned w = *(const GAS unsigned*)(lat + 2 * lane + 128 * i); q[2 * i] = bflo(w); q[2 * i + 1] = bfhi(w); ss += q[2 * i] * q[2 * i] + q[2 * i + 1] * q[2 * i + 1]; }
        ss = wave_sum(ss, lane); const float rq = rsqrtf(ss * (1.f / 384.f) + RMS_EPS);
#pragma unroll
        for (int i = 0; i < 3; ++i) { const f32x2 g2 = *(const f32x2*)(gq + 2 * lane + 128 * i); *(GAS unsigned*)(QL + (size_t)row * 384 + 2 * lane + 128 * i) = pk_bf16(q[2 * i] * rq * g2.x, q[2 * i + 1] * rq * g2.y); }
        float cc[4]; float s2 = 0.f;
#pragma unroll
        for (int i = 0; i < 2; ++i) { const unsigned w = *(const GAS unsigned*)(lat + 384 + 2 * lane + 128 * i); cc[2 * i] = bflo(w); cc[2 * i + 1] = bfhi(w); s2 += cc[2 * i] * cc[2 * i] + cc[2 * i + 1] * cc[2 * i + 1]; }
        s2 = wave_sum(s2, lane); const float rc = rsqrtf(s2 * (1.f / 256.f) + RMS_EPS);
#pragma unroll
        for (int i = 0; i < 2; ++i) { const f32x2 g2 = *(const f32x2*)(gkv + 2 * lane + 128 * i); *(GAS unsigned*)(Cb + (size_t)row * 256 + 2 * lane + 128 * i) = pk_bf16(cc[2 * i] * rc * g2.x, cc[2 * i + 1] * rc * g2.y); }
        if (lane < 32) { const float x1 = bf2f(lat[640 + lane]), x2 = bf2f(lat[672 + lane]); const f32x2 cs = *(const f32x2*)(CS + ((size_t)row * 32 + lane) * 2);
            *(GAS unsigned*)(KR + (size_t)row * 64 + 2 * lane) = pk_bf16(x1 * cs.x - x2 * cs.y, x1 * cs.y + x2 * cs.x); }
    }
}

#define MFMA32(a, b, c) __builtin_amdgcn_mfma_f32_32x32x16_bf16((a), (b), (c), 0, 0, 0)
DI int crow(int reg, int h) { return (reg & 3) + 8 * (reg >> 2) + 4 * h; }

DI void attn_phase(const Params& P, LAS unsigned char* lds, int tid, int wid, int lane, int bid) {
    unsigned char* ws_ = P.ws; asm volatile("" : "+s"(ws_));
    asm volatile("" : "+v"(tid)); lane = tid & 63; wid = __builtin_amdgcn_readfirstlane(tid >> 6);
    unsigned char* ar = ws_ + O_AR;
    const bf16_t* Q = (const bf16_t*)(ar + 48 * MiB); const bf16_t* KN = (const bf16_t*)(ar + 96 * MiB); const bf16_t* VT = (const bf16_t*)(ar + 128 * MiB); const bf16_t* KR = (const bf16_t*)(ar + 44 * MiB);
    bf16_t* AO = (bf16_t*)(ws_ + O_XN);
    const int l32 = lane & 31, h2 = lane >> 5;
    constexpr int BUFB = 43008, VOFF = 25600;
    const unsigned kn_off0 = (unsigned)(((tid >> 4) * 1024 + 8 * (tid & 15)) * 2);
    const unsigned kr_off = (unsigned)(((tid >> 3) * 64 + 8 * (tid & 7)) * 2);
    const unsigned vt_off0 = (unsigned)(((tid >> 3) * 16384 + 8 * (tid & 7)) * 2);
    const unsigned kn_l0 = (unsigned)((tid >> 4) * 400 + 16 * (tid & 15));
    const unsigned kr_l = (unsigned)((tid >> 3) * 400 + 256 + 16 * (tid & 7));
    const unsigned vt_l0 = (unsigned)(25600 + (tid >> 3) * 136 + 16 * (tid & 7));
    for (int item = bid; item < 256; item += gridDim.x) {
        const int head = item & 7, pair = item >> 3;
        for (int half = 0; half < 2; ++half) {
            const int qb = half ? 63 - pair : pair;
            const int wrow0 = qb * 256 + wid * 32, qrow = wrow0 + l32;
            bf16x8 Qf[12];
#pragma unroll
            for (int s = 0; s < 12; ++s) Qf[s] = *(const GAS bf16x8*)(Q + (size_t)qrow * 1536 + head * 192 + 16 * s + 8 * h2);
            f32x16 o[4];
#pragma unroll
            for (int d = 0; d < 4; ++d)
#pragma unroll
                for (int r = 0; r < 16; ++r) o[d][r] = 0.f;
            float mrun = -INFINITY, lsum = 0.f;
            const int ntiles = 4 * (qb + 1);
            u32x4 kreg[3], vreg[2];
#define ATT_ISSUE(kt) do { \
    unsigned o0_ = kn_off0, o1_ = kr_off, o2_ = vt_off0; asm volatile("" : "+v"(o0_), "+v"(o1_), "+v"(o2_)); \
    const char* knb = (const char*)(KN + (size_t)(kt) * 65536 + head * 128); const char* krb = (const char*)(KR + (size_t)(kt) * 4096); \
    const char* vtb = (const char*)(VT + (size_t)head * 128 * 16384 + 64 * (kt)); \
    kreg[0] = *(const GAS u32x4*)(knb + o0_); kreg[1] = *(const GAS u32x4*)(knb + 65536 + o0_); kreg[2] = *(const GAS u32x4*)(krb + o1_); \
    vreg[0] = *(const GAS u32x4*)(vtb + o2_); vreg[1] = *(const GAS u32x4*)(vtb + 2097152 + o2_); } while (0)
#define ATT_WRITE(b) do { LAS unsigned char* base = lds + (b) * BUFB; \
    *(LAS u32x4*)(base + kn_l0) = kreg[0]; *(LAS u32x4*)(base + kn_l0 + 12800) = kreg[1]; *(LAS u32x4*)(base + kr_l) = kreg[2]; \
    *(LAS u32x2*)(base + vt_l0) = (u32x2){vreg[0].x, vreg[0].y}; *(LAS u32x2*)(base + vt_l0 + 8) = (u32x2){vreg[0].z, vreg[0].w}; \
    *(LAS u32x2*)(base + vt_l0 + 8704) = (u32x2){vreg[1].x, vreg[1].y}; *(LAS u32x2*)(base + vt_l0 + 8712) = (u32x2){vreg[1].z, vreg[1].w}; } while (0)
            ATT_ISSUE(0); ATT_WRITE(0); __syncthreads();
            for (int kt = 0; kt < ntiles; ++kt) {
                const bool more = (kt + 1 < ntiles);
                if (more) ATT_ISSUE(kt + 1);
                if (64 * kt <= wrow0 + 31) {
                    LAS unsigned char* base = lds + (kt & 1) * BUFB;
                    f32x16 st0, st1;
#pragma unroll
                    for (int r = 0; r < 16; ++r) { st0[r] = 0.f; st1[r] = 0.f; }
                    {
                        const LAS unsigned char* kp = base + l32 * 400 + 16 * h2;
                        bf16x8 ka[2][4];
#define ATT_LDK(bf, gq) do { _Pragma("unroll") for (int sl = 0; sl < 2; ++sl) { ka[bf][2 * sl] = *(const LAS bf16x8*)(kp + 32 * (2 * (gq) + sl)); ka[bf][2 * sl + 1] = *(const LAS bf16x8*)(kp + 12800 + 32 * (2 * (gq) + sl)); } } while (0)
#define ATT_MMK(bf, gq) do { _Pragma("unroll") for (int sl = 0; sl < 2; ++sl) { st0 = MFMA32(ka[bf][2 * sl], Qf[2 * (gq) + sl], st0); st1 = MFMA32(ka[bf][2 * sl + 1], Qf[2 * (gq) + sl], st1); } } while (0)
                        ATT_LDK(0, 0); __builtin_amdgcn_sched_barrier(0);
                        ATT_LDK(1, 1); __builtin_amdgcn_sched_barrier(0);
                        ATT_MMK(0, 0); __builtin_amdgcn_sched_barrier(0);
                        ATT_LDK(0, 2); __builtin_amdgcn_sched_barrier(0);
                        ATT_MMK(1, 1); __builtin_amdgcn_sched_barrier(0);
                        ATT_LDK(1, 3); __builtin_amdgcn_sched_barrier(0);
                        ATT_MMK(0, 2); __builtin_amdgcn_sched_barrier(0);
                        ATT_LDK(0, 4); __builtin_amdgcn_sched_barrier(0);
                        ATT_MMK(1, 3); __builtin_amdgcn_sched_barrier(0);
                        ATT_LDK(1, 5); __builtin_amdgcn_sched_barrier(0);
                        ATT_MMK(0, 4); __builtin_amdgcn_sched_barrier(0);
                        ATT_MMK(1, 5); __builtin_amdgcn_sched_barrier(0);
#undef ATT_LDK
#undef ATT_MMK
                    }
                    if (64 * kt + 63 > wrow0) {
#pragma unroll
                        for (int r = 0; r < 16; ++r) { const int key0 = 64 * kt + crow(r, h2); if (key0 > qrow) st0[r] = -INFINITY; if (key0 + 32 > qrow) st1[r] = -INFINITY; }
                    }
                    float mx = st0[0];
#pragma unroll
                    for (int r = 1; r < 16; ++r) mx = fmaxf(mx, st0[r]);
#pragma unroll
                    for (int r = 0; r < 16; ++r) mx = fmaxf(mx, st1[r]);
                    mx = fmaxf(mx, shx(mx, 32, lane));
                    const float mn = fmaxf(mrun, mx);
                    const float alpha = __builtin_amdgcn_exp2f(mrun - mn);
                    mrun = mn;
                    float psum = 0.f;
#pragma unroll
                    for (int r = 0; r < 16; ++r) { st0[r] = __builtin_amdgcn_exp2f(st0[r] - mn); st1[r] = __builtin_amdgcn_exp2f(st1[r] - mn); psum += st0[r] + st1[r]; }
                    lsum = lsum * alpha + psum;
                    if (__builtin_amdgcn_ballot_w64(alpha != 1.f) != 0ull) {
#pragma unroll
                        for (int d = 0; d < 4; ++d)
#pragma unroll
                            for (int r = 0; r < 16; ++r) o[d][r] *= alpha;
                    }
                    {
                        const LAS unsigned char* vb = base + VOFF + l32 * 136 + 8 * h2;
                        u32x4 va[2][4];
#define ATT_LDV(bf, stp) do { _Pragma("unroll") for (int d = 0; d < 4; ++d) { const LAS unsigned char* vp = vb + d * 4352 + 32 * (stp); \
        const u32x2 lo = *(const LAS u32x2*)vp, hi = *(const LAS u32x2*)(vp + 16); va[bf][d] = (u32x4){lo.x, lo.y, hi.x, hi.y}; } } while (0)
#define ATT_MMV(bf, stv, sp) do { u32x4 pw; pw.x = pk_bf16(stv[8 * (sp)], stv[8 * (sp) + 1]); pw.y = pk_bf16(stv[8 * (sp) + 2], stv[8 * (sp) + 3]); pw.z = pk_bf16(stv[8 * (sp) + 4], stv[8 * (sp) + 5]); pw.w = pk_bf16(stv[8 * (sp) + 6], stv[8 * (sp) + 7]); \
        const bf16x8 pf = __builtin_bit_cast(bf16x8, pw); _Pragma("unroll") for (int d = 0; d < 4; ++d) o[d] = MFMA32(__builtin_bit_cast(bf16x8, va[bf][d]), pf, o[d]); } while (0)
                        ATT_LDV(0, 0); __builtin_amdgcn_sched_barrier(0);
                        ATT_LDV(1, 1); __builtin_amdgcn_sched_barrier(0);
                        ATT_MMV(0, st0, 0); __builtin_amdgcn_sched_barrier(0);
                        ATT_LDV(0, 2); __builtin_amdgcn_sched_barrier(0);
                        ATT_MMV(1, st0, 1); __builtin_amdgcn_sched_barrier(0);
                        ATT_LDV(1, 3); __builtin_amdgcn_sched_barrier(0);
                        ATT_MMV(0, st1, 0); __builtin_amdgcn_sched_barrier(0);
                        ATT_MMV(1, st1, 1); __builtin_amdgcn_sched_barrier(0);
#undef ATT_LDV
#undef ATT_MMV
                    }
                }
                if (more) ATT_WRITE((kt + 1) & 1);
                __syncthreads();
            }
            int t2_ = tid; asm volatile("" : "+v"(t2_));
            const int qrow2 = qb * 256 + (t2_ >> 6) * 32 + (t2_ & 31), h2b = (t2_ >> 5) & 1;
            const float ltot = lsum + shx(lsum, 32, lane);
            const float inv = 1.f / ltot;
#pragma unroll
            for (int d = 0; d < 4; ++d)
#pragma unroll
                for (int rg = 0; rg < 4; ++rg) { f32x4 v = {o[d][4 * rg] * inv, o[d][4 * rg + 1] * inv, o[d][4 * rg + 2] * inv, o[d][4 * rg + 3] * inv};
                    store_bf4(AO + (size_t)qrow2 * 1024 + head * 128 + d * 32 + 8 * rg + 4 * h2b, v); }
        }
    }
#undef ATT_ISSUE
#undef ATT_WRITE
}

DI void s5_precompute(const Params& P, LAS unsigned char* lds, int tid, int bid) {
    unsigned char* ws_ = P.ws; asm volatile("" : "+s"(ws_));
    asm volatile("" : "+v"(tid));
    LAS float* PWr = (LAS float*)lds;
    LAS float* PWi = PWr + 33 * 64;
    LAS float* BBr = PWi + 33 * 64;
    LAS float* BBi = BBr + 1024;
    LAS float* CRe = BBi + 1024;
    LAS float* CIm = CRe + 1024;
    LAS float* KT = CIm + 1024;
    const float* lam_re = P.in[22]; const float* lam_im = P.in[23]; const float* log_dt = P.in[24];
    const float* b_re = P.in[25]; const float* b_im = P.in[26]; const float* c_re = P.in[27]; const float* c_im = P.in[28]; const float* dsk = P.in[29];
    bf16_t* TF = (bf16_t*)(ws_ + O_AR + 40 * MiB); bf16_t* Eb = (bf16_t*)(ws_ + O_AR + 80 * MiB);
    for (int item = bid; item < 256; item += gridDim.x) {
        const int g = item >> 2, q = item & 3;
        __syncthreads();
        const float dt = expf(log_dt[g]);
        for (int e = tid; e < 33 * 64; e += 512) { const int j = e >> 6, p = e & 63; const float lr = lam_re[g * 64 + p], li = lam_im[g * 64 + p];
            const float mag = expf((float)j * (lr * dt)); float sn, cs; sincosf((float)j * (li * dt), &sn, &cs); PWr[e] = mag * cs; PWi[e] = mag * sn; }
        for (int e = tid; e < 1024; e += 512) { const int p = e >> 4; const float lr = lam_re[g * 64 + p], li = lam_im[g * 64 + p];
            const float mag = expf(lr * dt); float sn, cs; sincosf(li * dt, &sn, &cs); const float ar = mag * cs, ai = mag * sn;
            const float den = lr * lr + li * li; const float fre = ((ar - 1.f) * lr + ai * li) / den, fim = (ai * lr - (ar - 1.f) * li) / den;
            const float br = b_re[(size_t)g * 1024 + e], bi = b_im[(size_t)g * 1024 + e];
            BBr[e] = fre * br - fim * bi; BBi[e] = fre * bi + fim * br; }
        for (int e = tid; e < 1024; e += 512) { CRe[e] = c_re[(size_t)g * 1024 + e]; CIm[e] = c_im[(size_t)g * 1024 + e]; }
        __syncthreads();
        {
            const int pr_ = tid & 255, co = pr_ >> 4, ci = pr_ & 15, j0 = (tid >> 8) * 16;
            float a[16];
#pragma unroll
            for (int jj = 0; jj < 16; ++jj) a[jj] = 0.f;
            for (int p = 0; p < 64; ++p) {
                const float cr = CRe[co * 64 + p], cm = CIm[co * 64 + p], br = BBr[p * 16 + ci], bi = BBi[p * 16 + ci];
                const float xr = cr * br - cm * bi, xi = cr * bi + cm * br;
#pragma unroll
                for (int jj = 0; jj < 16; ++jj) a[jj] += xr * PWr[(j0 + jj) * 64 + p] - xi * PWi[(j0 + jj) * 64 + p];
            }
            if (j0 == 0 && co == ci) a[0] += dsk[g * 16 + co];
#pragma unroll
            for (int jj = 0; jj < 16; ++jj) KT[((j0 + jj) * 16 + co) * 16 + ci] = a[jj];
        }
        __syncthreads();
        for (int e = tid; e < 128 * 80; e += 512) { const int rr = e / 80, kc = e - rr * 80, n = 128 * q + rr, l = n >> 4, co = n & 15; float v[8];
            if (kc < 64) { const int lp = kc >> 1;
#pragma unroll
                for (int i = 0; i < 8; ++i) v[i] = (lp <= l) ? KT[((l - lp) * 16 + co) * 16 + 8 * (kc & 1) + i] : 0.f;
            } else {
                const bool im = kc >= 72; const int p0 = 8 * (kc - (im ? 72 : 64));
#pragma unroll
                for (int i = 0; i < 8; ++i) { const int p = p0 + i; const float cr = CRe[co * 64 + p], cm = CIm[co * 64 + p], pr = PWr[(l + 1) * 64 + p], pi = PWi[(l + 1) * 64 + p];
                    v[i] = im ? -(cr * pi + cm * pr) : (cr * pr - cm * pi); }
            }
            u32x4 o; o.x = pk_bf16(v[0], v[1]); o.y = pk_bf16(v[2], v[3]); o.z = pk_bf16(v[4], v[5]); o.w = pk_bf16(v[6], v[7]);
            *(GAS u32x4*)(TF + ((size_t)(g * 512 + n)) * 640 + 8 * kc) = o; }
        for (int e = tid; e < 32 * 64; e += 512) { const int n = 32 * q + (e >> 6), kc = e & 63, p = n & 63, im = n >> 6, lp = kc >> 1; float v[8];
            const float pr = PWr[(31 - lp) * 64 + p], pi = PWi[(31 - lp) * 64 + p];
#pragma unroll
            for (int i = 0; i < 8; ++i) { const int ci = 8 * (kc & 1) + i; const float br = BBr[p * 16 + ci], bi = BBi[p * 16 + ci]; v[i] = im ? (pr * bi + pi * br) : (pr * br - pi * bi); }
            u32x4 o; o.x = pk_bf16(v[0], v[1]); o.y = pk_bf16(v[2], v[3]); o.z = pk_bf16(v[4], v[5]); o.w = pk_bf16(v[6], v[7]);
            *(GAS u32x4*)(Eb + ((size_t)(g * 256 + n)) * 512 + 8 * kc) = o; }
    }
}

DI void s5_scan(const Params& P, int wid, int lane, int bid) {
    unsigned char* ws_ = P.ws; asm volatile("" : "+s"(ws_));
    asm volatile("" : "+v"(lane));
    if (wid != 0) return;
    const float* lam_re = P.in[22]; const float* lam_im = P.in[23]; const float* log_dt = P.in[24];
    const float* XE = (const float*)(ws_ + O_AR + 96 * MiB); bf16_t* UG = (bf16_t*)(ws_ + O_AR);
    for (int g = bid; g < 64; g += gridDim.x) {
        const int p = lane; const float dt = expf(log_dt[g]); const float lr = lam_re[g * 64 + p], li = lam_im[g * 64 + p];
        const float mag = expf(32.f * (lr * dt)); float sn, cs; sincosf(32.f * (li * dt), &sn, &cs); const float ar = mag * cs, ai = mag * sn;
        float cr = 0.f, ci = 0.f;
        const float* xe = XE + (size_t)g * 512 * 128; bf16_t* ug = UG + (size_t)g * 512 * 640;
        for (int c0 = 0; c0 < 512; c0 += 16) {
            float xr[16], xi[16];
#pragma unroll
            for (int i = 0; i < 16; ++i) { xr[i] = ((const GAS float*)xe)[(size_t)(c0 + i) * 128 + p]; xi[i] = ((const GAS float*)xe)[(size_t)(c0 + i) * 128 + 64 + p]; }
#pragma unroll
            for (int i = 0; i < 16; ++i) { ((GAS bf16_t*)ug)[(size_t)(c0 + i) * 640 + 512 + p] = f2bf(cr); ((GAS bf16_t*)ug)[(size_t)(c0 + i) * 640 + 576 + p] = f2bf(ci);
                const float nr = ar * cr - ai * ci + xr[i], ni = ar * ci + ai * cr + xi[i]; cr = nr; ci = ni; }
        }
    }
}

DI void cs_table(const Params& P, int gtid, int nthreads) {
    unsigned char* ws_ = P.ws; asm volatile("" : "+s"(ws_));
    asm volatile("" : "+v"(gtid));
    const int* pos = (const int*)P.in[1]; float* CS = (float*)(ws_ + O_CS);
    for (int e = gtid; e < S * 32; e += nthreads) { const int row = e >> 5, j = e & 31;
        const float invf = exp2f(-(float)j * (13.287712379549449f / 32.f)); const float ang = (float)pos[row] * invf; float sn, cs; sincosf(ang, &sn, &cs);
        *(GAS f32x2*)(CS + (size_t)e * 2) = (f32x2){cs, sn}; }
}


#define XB_TMO      128
#define XB_XCNT(j)  (256  + 64 * (j))
#define XB_XSUB(j)  (1280 + 64 * (j))
#define XB_XGEN(j)  (2304 + 64 * (j))
#define XB_TOP      3328
#define XB_TOPGEN   3392
#define XCD_BAR_WORDS 3456
#define XB_SPIN_CAP (1u << 18)
DI unsigned xb_ld(unsigned* p)              { return __hip_atomic_load(p, __ATOMIC_RELAXED, __HIP_MEMORY_SCOPE_AGENT); }
DI unsigned xb_add(unsigned* p, unsigned v) { return __hip_atomic_fetch_add(p, v, __ATOMIC_RELAXED, __HIP_MEMORY_SCOPE_AGENT); }
DI unsigned xb_xcc_id() { return (unsigned)__builtin_amdgcn_s_getreg((3 << 11) | 20) & 0xFu; }
#define XB_SPIN(cond, bar) do { unsigned _sp = 0; while (cond) { __builtin_amdgcn_s_sleep(1); \
    if ((++_sp & 255u) == 0u) { if (xb_ld(&(bar)[XB_TMO])) break; if (_sp > XB_SPIN_CAP) { atomicAdd(&(bar)[XB_TMO], 1u); break; } } } } while (0)
struct XcdBarrier { unsigned* bar; unsigned x; volatile LAS unsigned* st; };
DI XcdBarrier xcd_barrier_post(unsigned* bar, volatile LAS unsigned* st) {
    XcdBarrier b; b.bar = bar; b.x = xb_xcc_id(); b.st = st;
    if (threadIdx.x == 0) (void)xb_add(&bar[XB_XCNT(b.x)], 1u);
    return b;
}
DI void xcd_barrier_complete(unsigned* bar, unsigned x, unsigned& nloc, unsigned& nx) {
    const unsigned G = gridDim.x * gridDim.y * gridDim.z;
    unsigned sum, cnt, mine, sp = 0u;
    for (;;) {
        sum = 0u; cnt = 0u; mine = 0u;
#pragma unroll
        for (unsigned j = 0; j < 16; ++j) { const unsigned c = xb_ld(&bar[XB_XCNT(j)]); sum += c; cnt += (c > 0u) ? 1u : 0u; mine = (j == x) ? c : mine; }
        if (sum == G) break;
        __builtin_amdgcn_s_sleep(1);
        if ((++sp & 255u) == 0u) { if (xb_ld(&bar[XB_TMO])) break; if (sp > XB_SPIN_CAP) { atomicAdd(&bar[XB_TMO], 1u); break; } }
    }
    nloc = mine > 0u ? mine : 1u; nx = cnt > 0u ? cnt : 1u;
}
DI void xcd_barrier(const XcdBarrier& b) {
    asm volatile("s_waitcnt vmcnt(0)" ::: "memory");
    __syncthreads();
    if (threadIdx.x == 0) {
        unsigned* bar = b.bar;
        __builtin_amdgcn_s_waitcnt(0);
        unsigned nloc = b.st[0], nx = b.st[1];
        if (nloc == 0u) { xcd_barrier_complete(bar, b.x, nloc, nx); b.st[0] = nloc; b.st[1] = nx; }
        const unsigned old = xb_add(&bar[XB_XSUB(b.x)], 1u);
        const unsigned gen = old / nloc;
        if (old + 1u == (gen + 1u) * nloc) {
            __builtin_amdgcn_fence(__ATOMIC_RELEASE, "agent");
            asm volatile("s_waitcnt vmcnt(0)" ::: "memory");
            const unsigned og = xb_add(&bar[XB_TOP], 1u);
            const unsigned tg = og / nx;
            if (og + 1u == (tg + 1u) * nx) xb_add(&bar[XB_TOPGEN], 1u);
            else XB_SPIN(xb_ld(&bar[XB_TOPGEN]) == tg, bar);
            __builtin_amdgcn_fence(__ATOMIC_ACQUIRE, "agent");
            xb_add(&bar[XB_XGEN(b.x)], 1u);
            asm volatile("s_waitcnt vmcnt(0)" ::: "memory");
        } else {
            XB_SPIN(xb_ld(&bar[XB_XGEN(b.x)]) == gen, bar);
            __builtin_amdgcn_fence(__ATOMIC_ACQUIRE, "agent");
            asm volatile("s_waitcnt vmcnt(0)" ::: "memory");
        }
    }
    __syncthreads();
}

__global__ void __launch_bounds__(512, 2) __attribute__((amdgpu_waves_per_eu(2, 2))) mega_fwd(Params P) {
    extern __shared__ __attribute__((aligned(16))) unsigned char smem[];
    LAS unsigned char* lds = (LAS unsigned char*)smem;
    cg::grid_group grid = cg::this_grid();
    __shared__ uint4 xb_words;
    if (threadIdx.x == 0) xb_words = make_uint4(0u, 0u, 0u, 0u);
    __syncthreads();
    const XcdBarrier xb = xcd_barrier_post((unsigned*)(P.ws + O_BAR), (volatile LAS unsigned*)&xb_words);
    const int G = gridDim.x, nthreads = G * 512, NGW = G * 8;
#pragma nounroll
    for (int st = 0; st < NSTEPS; ++st) {
        int nrep = PROBE_REP(st); asm volatile("" : "+s"(nrep));
_Pragma("nounroll") for (int rep = 0; rep < nrep; ++rep) {
        if (rep) __syncthreads();
        int tid = threadIdx.x; asm volatile("" : "+v"(tid));
        int bid = blockIdx.x; asm volatile("" : "+s"(bid));
        unsigned char* ws = P.ws; asm volatile("" : "+s"(ws));
        float* outp_ = P.out; asm volatile("" : "+s"(outp_));
        const float* ng = P.in[2];
        bf16_t* XN = (bf16_t*)(ws + O_XN); const bf16_t* Zb = (const bf16_t*)(ws + O_Z);
        GemmDesc g;
        if (get_gemm(P, st, g)) gemm_phase(lds, P, g, G, bid, tid);
        else switch (st) {
        case 0: conv_layer(P, 0, GW_, NGW, LANE_); cs_table(P, GTID_, nthreads);
                row_pass<RP_BF>(P.in[0], outp_, nullptr, nullptr, ng, XN, GW_, NGW, LANE_); break;
        case 3: gate_phase(P, lds, tid, WID_, LANE_, bid); break;
        case 5: case 11: case 14: case 22: case 30: {
            const int L = (st == 5) ? 0 : (st <= 14 ? 1 : (st == 22 ? 2 : 3)); const bool mlp = (st == 14);
            const float* hin = (st == 5) ? P.in[0] : outp_;
            const float* gpost = ng + (L * 4 + (mlp ? 3 : 1)) * 1024; const float* gpre = mlp ? ng + ((L + 1) * 4) * 1024 : ng + (L * 4 + 2) * 1024;
            row_pass<RP_BF>(hin, outp_, Zb, gpost, gpre, XN, GW_, NGW, LANE_);
            if (mlp) conv_layer(P, L + 1, GW_, NGW, LANE_);
        } break;
        case 8: row_pass<RP_F32>(outp_, outp_, Zb, ng + 3 * 1024, ng + 4 * 1024, ws + O_AR, GW_, NGW, LANE_); conv_layer(P, 1, GW_, NGW, LANE_); break;
        case 9: pool_phase(P, GTID_, nthreads); break;
        case 16: mla_rows(P, GW_, NGW, LANE_); break;
        case 20: attn_phase(P, lds, tid, WID_, LANE_, bid); break;
        case 25: row_pass<RP_S5>(outp_, outp_, Zb, ng + 11 * 1024, ng + 12 * 1024, ws + O_AR, GW_, NGW, LANE_); conv_layer(P, 3, GW_, NGW, LANE_); s5_precompute(P, lds, tid, bid); break;
        case 27: s5_scan(P, WID_, LANE_, bid); break;
        case 33: row_pass<RP_FINAL>(outp_, outp_, Zb, ng + 15 * 1024, nullptr, nullptr, GW_, NGW, LANE_); break;
        default: break;
        }
        }
        if (G == 0) grid.sync();
        if (st != 2 && st != 17 && st != 18 && st != NSTEPS - 1) { xcd_barrier(xb); if (PROBE_SYNC) xcd_barrier(xb); }
    }
}
}

extern "C" void kernel_launch(void* const* d_in, const int* in_sizes, int n_in, void* d_out, int out_size, void* d_ws, size_t ws_size, hipStream_t stream) {
    static int grid = 0;
    if (grid == 0) {
        int dev = 0, cus = 0, per_cu = 0;
        hipGetDevice(&dev);
        hipDeviceGetAttribute(&cus, hipDeviceAttributeMultiprocessorCount, dev);
        hipFuncSetAttribute((const void*)mega_fwd, hipFuncAttributeMaxDynamicSharedMemorySize, LDS_BYTES);
        if (hipOccupancyMaxActiveBlocksPerMultiprocessor(&per_cu, (const void*)mega_fwd, 512, LDS_BYTES) != hipSuccess || per_cu < 1) per_cu = 1;
        (void)hipGetLastError();
        grid = cus * per_cu;
        if (grid <= 0) grid = 256;
    }
    Params p{};
    for (int i = 0; i < 32 && i < n_in; ++i) p.in[i] = (const float*)d_in[i];
    p.out = (float*)d_out; p.ws = (unsigned char*)d_ws;
    hipMemsetAsync((unsigned char*)d_ws + O_BAR, 0, XCD_BAR_WORDS * 4, stream);
    void* args[] = {&p};
    hipError_t e = hipLaunchCooperativeKernel((const void*)mega_fwd, dim3(grid), dim3(512), args, LDS_BYTES, stream);
    if (e != hipSuccess) fprintf(stderr, "cooperative launch failed: %s (grid %d)\n", hipGetErrorString(e), grid);
}
```
